# Optimizing an MI355X kernel written in HIP

```python
import math
import jax
import jax.numpy as jnp
from jax import lax
import numpy as np

D_MODEL = 1024
BATCH = 8
SEQ = 2048
DEPTH = 4

GRID_W = 64
CTX_LEN = 256
Q_BLOCK = 128
N_MIXERS = 4
ROPE_THETA = 10000.0
EPS = 1e-6
NEG_INF = -1e30

GQA_HEADS = 8
GQA_KV_HEADS = 2
GQA_HEAD_DIM = 128
MLA_HEADS = 8
MLA_Q_LORA = 384
MLA_KV_LORA = 256
MLA_NOPE = 128
MLA_ROPE = 64
MLA_V = 128
WIN_HEADS = 16
WIN_KV_HEADS = 2
WIN_HEAD_DIM = 64
WINDOW = 128
DIFF_HEADS = 8
DIFF_HEAD_DIM = 64
DIFF_V_DIM = 2 * DIFF_HEAD_DIM
DENSE_FF = 3584
N_EXPERTS = 8
TOP_K = 2
EXPERT_FF = 3584

N_GQA = (DEPTH + 3) // 4
N_MLA = (DEPTH + 2) // 4
N_WIN = (DEPTH + 1) // 4
N_DIFF = DEPTH // 4
N_DENSE = (DEPTH + 1) // 2
N_MOE = DEPTH // 2

kernel_name = "hybrid_interleaved_diffusion_backbone"


def rms_norm(x, g):
    xf = x.astype(jnp.float32)
    y = xf * lax.rsqrt(jnp.mean(xf * xf, axis=-1, keepdims=True) + EPS)
    return (y * g.astype(jnp.float32)).astype(x.dtype)


def modulate(h, shift, scale):
    return h * (1.0 + scale) + shift


def axial_rope_tables(rows, rot_dim):
    quarter = rot_dim // 4
    inv_freq = ROPE_THETA ** (-jnp.arange(quarter, dtype=jnp.float32) / quarter)
    row = jnp.repeat(jnp.arange(rows, dtype=jnp.float32), GRID_W)
    col = jnp.tile(jnp.arange(GRID_W, dtype=jnp.float32), rows)
    ang = jnp.concatenate([row[:, None] * inv_freq, col[:, None] * inv_freq], axis=-1)
    return jnp.cos(ang), jnp.sin(ang)


def apply_rope(x, cos, sin):
    half = x.shape[-1] // 2
    shape = (1, x.shape[1]) + (1,) * (x.ndim - 3) + (half,)
    cs, sn = cos.reshape(shape), sin.reshape(shape)
    xf = x.astype(jnp.float32)
    x1, x2 = xf[..., :half], xf[..., half:]
    return jnp.concatenate([x1 * cs - x2 * sn, x1 * sn + x2 * cs], axis=-1).astype(x.dtype)


def attend(q, k, v, scale, mask=None, sink=None):
    s = jnp.einsum('bqhgd,bkhd->bhgqk', q, k).astype(jnp.float32) * scale
    if mask is not None:
        s = jnp.where(mask, s, NEG_INF)
    if sink is None:
        p = jax.nn.softmax(s, axis=-1)
    else:
        sk = sink.astype(jnp.float32)[None, :, :, None, None]
        m = jnp.maximum(jnp.max(s, axis=-1, keepdims=True), sk)
        e = jnp.exp(s - m)
        p = e / (jnp.sum(e, axis=-1, keepdims=True) + jnp.exp(sk - m))
    return jnp.einsum('bhgqk,bkhd->bqhgd', p.astype(v.dtype), v)


def sweep_query_blocks(fn, *qs):
    B, S = qs[0].shape[:2]
    nb = S // Q_BLOCK
    blocks = tuple(jnp.moveaxis(q.reshape((B, nb, Q_BLOCK) + q.shape[2:]), 1, 0) for q in qs)
    out = lax.map(lambda a: fn(a[0], *a[1:]), (jnp.arange(nb),) + blocks)
    out = jnp.moveaxis(out, 0, 1)
    return out.reshape((B, S) + out.shape[3:])


def gqa_project(h, w_qkv, q_gain, k_gain, n_kv, group, hd):
    B, T, _ = h.shape
    qkv = h @ w_qkv
    nq, nk = n_kv * group * hd, n_kv * hd
    q = qkv[..., :nq].reshape(B, T, n_kv, group, hd)
    k = qkv[..., nq:nq + nk].reshape(B, T, n_kv, hd)
    v = qkv[..., nq + nk:].reshape(B, T, n_kv, hd)
    return rms_norm(q, q_gain), rms_norm(k, k_gain), v


def gqa_axial(h_lat, h_ctx, w_qkv, q_gain, k_gain, w_o, rope, need_ctx):
    B, S, _ = h_lat.shape
    G = GQA_HEADS // GQA_KV_HEADS
    scale = GQA_HEAD_DIM ** -0.5
    q_l, k_l, v_l = gqa_project(h_lat, w_qkv, q_gain, k_gain, GQA_KV_HEADS, G, GQA_HEAD_DIM)
    q_l, k_l = apply_rope(q_l, *rope), apply_rope(k_l, *rope)
    q_c, k_c, v_c = gqa_project(h_ctx, w_qkv, q_gain, k_gain, GQA_KV_HEADS, G, GQA_HEAD_DIM)
    k_all = jnp.concatenate([k_c, k_l], axis=1)
    v_all = jnp.concatenate([v_c, v_l], axis=1)
    o_l = sweep_query_blocks(lambda i, qb: attend(qb, k_all, v_all, scale), q_l)
    o_l = o_l.reshape(B, S, -1) @ w_o
    o_c = attend(q_c, k_c, v_c, scale).reshape(B, h_ctx.shape[1], -1) @ w_o if need_ctx else None
    return o_l, o_c


def mla(h_lat, h_ctx, w_down, qa_gain, kva_gain, w_uq, w_ukv, q_gain, k_gain, w_o, rope, need_ctx):
    def project(h, rope_tab):
        B, T, _ = h.shape
        dn = h @ w_down
        cq = rms_norm(dn[..., :MLA_Q_LORA], qa_gain)
        ckv = rms_norm(dn[..., MLA_Q_LORA:MLA_Q_LORA + MLA_KV_LORA], kva_gain)
        k_pe = rms_norm(dn[..., MLA_Q_LORA + MLA_KV_LORA:], k_gain[MLA_NOPE:])
        q = (cq @ w_uq).reshape(B, T, MLA_HEADS, MLA_NOPE + MLA_ROPE)
        q_nope = rms_norm(q[..., :MLA_NOPE], q_gain[:MLA_NOPE])
        q_pe = rms_norm(q[..., MLA_NOPE:], q_gain[MLA_NOPE:])
        kv = (ckv @ w_ukv).reshape(B, T, MLA_HEADS, MLA_NOPE + MLA_V)
        k_nope = rms_norm(kv[..., :MLA_NOPE], k_gain[:MLA_NOPE])
        v = kv[..., MLA_NOPE:]
        if rope_tab is not None:
            q_pe, k_pe = apply_rope(q_pe, *rope_tab), apply_rope(k_pe, *rope_tab)
        q = jnp.concatenate([q_nope, q_pe], axis=-1)[:, :, :, None, :]
        k = jnp.concatenate([k_nope, jnp.broadcast_to(k_pe[:, :, None, :], (B, T, MLA_HEADS, MLA_ROPE))], axis=-1)
        return q, k, v

    B, S, _ = h_lat.shape
    scale = (MLA_NOPE + MLA_ROPE) ** -0.5
    q_l, k_l, v_l = project(h_lat, rope)
    q_c, k_c, v_c = project(h_ctx, None)
    k_all = jnp.concatenate([k_c, k_l], axis=1)
    v_all = jnp.concatenate([v_c, v_l], axis=1)
    o_l = sweep_query_blocks(lambda i, qb: attend(qb, k_all, v_all, scale), q_l)
    o_l = o_l.reshape(B, S, -1) @ w_o
    o_c = attend(q_c, k_c, v_c, scale).reshape(B, h_ctx.shape[1], -1) @ w_o if need_ctx else None
    return o_l, o_c


def window_gqa(h_lat, h_ctx, w_qkv, q_gain, k_gain, sink, w_o, rope, need_ctx):
    B, S, _ = h_lat.shape
    G = WIN_HEADS // WIN_KV_HEADS
    scale = WIN_HEAD_DIM ** -0.5
    sink = sink.reshape(WIN_KV_HEADS, G)
    q_l, k_l, v_l = gqa_project(h_lat, w_qkv, q_gain, k_gain, WIN_KV_HEADS, G, WIN_HEAD_DIM)
    q_l, k_l = apply_rope(q_l, *rope), apply_rope(k_l, *rope)
    q_c, k_c, v_c = gqa_project(h_ctx, w_qkv, q_gain, k_gain, WIN_KV_HEADS, G, WIN_HEAD_DIM)
    pad = ((0, 0), (Q_BLOCK, Q_BLOCK), (0, 0), (0, 0))
    k_pad, v_pad = jnp.pad(k_l, pad), jnp.pad(v_l, pad)
    q_off = jnp.arange(Q_BLOCK)
    k_off = jnp.arange(3 * Q_BLOCK) - Q_BLOCK
    band = jnp.abs(q_off[:, None] - k_off[None, :]) <= WINDOW
    ctx_mask = jnp.ones((Q_BLOCK, k_c.shape[1]), dtype=bool)

    def block(i, qb):
        kpos = i * Q_BLOCK + k_off
        valid = band & ((kpos >= 0) & (kpos < S))[None, :]
        kb = lax.dynamic_slice_in_dim(k_pad, i * Q_BLOCK, 3 * Q_BLOCK, axis=1)
        vb = lax.dynamic_slice_in_dim(v_pad, i * Q_BLOCK, 3 * Q_BLOCK, axis=1)
        k_all = jnp.concatenate([k_c, kb], axis=1)
        v_all = jnp.concatenate([v_c, vb], axis=1)
        mask = jnp.concatenate([ctx_mask, valid], axis=1)
        return attend(qb, k_all, v_all, scale, mask=mask, sink=sink)

    o_l = sweep_query_blocks(block, q_l).reshape(B, S, -1) @ w_o
    o_c = attend(q_c, k_c, v_c, scale, sink=sink).reshape(B, h_ctx.shape[1], -1) @ w_o if need_ctx else None
    return o_l, o_c


def diff_attention(h_lat, h_ctx, w_qkv, q_gain, k_gain, lam_p, subln, w_o, rope, lam_init, need_ctx):
    nq = DIFF_HEADS * 2 * DIFF_HEAD_DIM

    def project(h):
        B, T, _ = h.shape
        qkv = h @ w_qkv
        q = qkv[..., :nq].reshape(B, T, DIFF_HEADS, 2, DIFF_HEAD_DIM)
        k = qkv[..., nq:2 * nq].reshape(B, T, DIFF_HEADS, 2, DIFF_HEAD_DIM)
        v = qkv[..., 2 * nq:].reshape(B, T, DIFF_HEADS, DIFF_V_DIM)
        return rms_norm(q, q_gain), rms_norm(k, k_gain), v

    lp = lam_p.astype(jnp.float32)
    lam = jnp.exp(jnp.sum(lp[0] * lp[1])) - jnp.exp(jnp.sum(lp[2] * lp[3])) + lam_init
    scale = DIFF_HEAD_DIM ** -0.5

    def diff_attend(q, k, v):
        s = jnp.einsum('bqhmd,bkhmd->bhmqk', q, k).astype(jnp.float32) * scale
        p = jax.nn.softmax(s, axis=-1)
        p = p[:, :, 0] - lam * p[:, :, 1]
        return jnp.einsum('bhqk,bkhd->bqhd', p.astype(v.dtype), v)

    def finish(o):
        B, T = o.shape[:2]
        return (rms_norm(o, subln) * (1.0 - lam_init)).reshape(B, T, -1) @ w_o

    q_l, k_l, v_l = project(h_lat)
    q_l, k_l = apply_rope(q_l, *rope), apply_rope(k_l, *rope)
    q_c, k_c, v_c = project(h_ctx)
    k_all = jnp.concatenate([k_c, k_l], axis=1)
    v_all = jnp.concatenate([v_c, v_l], axis=1)
    o_l = finish(sweep_query_blocks(lambda i, qb: diff_attend(qb, k_all, v_all), q_l))
    o_c = finish(diff_attend(q_c, k_c, v_c)) if need_ctx else None
    return o_l, o_c


def swiglu(h, w13, w2):
    a = h @ w13
    g, u = jnp.split(a, 2, axis=-1)
    return (jax.nn.silu(g) * u) @ w2


def moe_swiglu(h, router, w13, w2):
    logits = (h @ router).astype(jnp.float32)
    top_v, top_i = lax.top_k(logits, TOP_K)
    gates = jax.nn.softmax(top_v, axis=-1)
    combine = jnp.sum(jax.nn.one_hot(top_i, N_EXPERTS, dtype=jnp.float32) * gates[..., None], axis=-2)
    out = jnp.zeros_like(h)
    for e in range(N_EXPERTS):
        out = out + combine[..., e:e + 1].astype(h.dtype) * swiglu(h, w13[e], w2[e])
    return out


def channel_mixer(h, i, ffn_w13, ffn_w2, moe_router, moe_w13, moe_w2):
    j = i // 2
    if i % 2 == 0:
        return swiglu(h, ffn_w13[j], ffn_w2[j])
    return moe_swiglu(h, moe_router[j], moe_w13[j], moe_w2[j])


def setup_inputs(seed: int = 0) -> dict:
    key = jax.random.key(seed)
    ks = iter(jax.random.split(key, 40))
    D = D_MODEL

    def nrm(shape, s):
        return jax.random.normal(next(ks), shape, jnp.float32) * s

    def w(shape):
        return nrm(shape, shape[-2] ** -0.5)

    def gain(shape):
        return 1.0 + nrm(shape, 0.02)

    return {
        "x": nrm((BATCH, SEQ, D), 1.0),
        "c": nrm((BATCH, D), 1.0),
        "ctx": nrm((BATCH, CTX_LEN, D), 1.0),
        "c_ctx": nrm((D,), 1.0),
        "ada_w": nrm((DEPTH, D, 6 * D), 0.5 * D ** -0.5),
        "ada_b": nrm((DEPTH, 6 * D), 0.02),
        "norm_mix": gain((DEPTH, D)),
        "norm_ffn": gain((DEPTH, D)),
        "gqa_wqkv": w((N_GQA, D, (GQA_HEADS + 2 * GQA_KV_HEADS) * GQA_HEAD_DIM)),
        "gqa_q_gain": gain((N_GQA, GQA_HEAD_DIM)),
        "gqa_k_gain": gain((N_GQA, GQA_HEAD_DIM)),
        "gqa_wo": w((N_GQA, GQA_HEADS * GQA_HEAD_DIM, D)),
        "mla_wdown": w((N_MLA, D, MLA_Q_LORA + MLA_KV_LORA + MLA_ROPE)),
        "mla_qa_gain": gain((N_MLA, MLA_Q_LORA)),
        "mla_kva_gain": gain((N_MLA, MLA_KV_LORA)),
        "mla_wuq": w((N_MLA, MLA_Q_LORA, MLA_HEADS * (MLA_NOPE + MLA_ROPE))),
        "mla_wukv": w((N_MLA, MLA_KV_LORA, MLA_HEADS * (MLA_NOPE + MLA_V))),
        "mla_q_gain": gain((N_MLA, MLA_NOPE + MLA_ROPE)),
        "mla_k_gain": gain((N_MLA, MLA_NOPE + MLA_ROPE)),
        "mla_wo": w((N_MLA, MLA_HEADS * MLA_V, D)),
        "win_wqkv": w((N_WIN, D, (WIN_HEADS + 2 * WIN_KV_HEADS) * WIN_HEAD_DIM)),
        "win_q_gain": gain((N_WIN, WIN_HEAD_DIM)),
        "win_k_gain": gain((N_WIN, WIN_HEAD_DIM)),
        "win_sink": nrm((N_WIN, WIN_HEADS), 0.5),
        "win_wo": w((N_WIN, WIN_HEADS * WIN_HEAD_DIM, D)),
        "diff_wqkv": w((N_DIFF, D, 2 * DIFF_HEADS * 2 * DIFF_HEAD_DIM + DIFF_HEADS * DIFF_V_DIM)),
        "diff_q_gain": gain((N_DIFF, DIFF_HEAD_DIM)),
        "diff_k_gain": gain((N_DIFF, DIFF_HEAD_DIM)),
        "diff_lambda": nrm((N_DIFF, 4, DIFF_HEAD_DIM), 0.1),
        "diff_subln": gain((N_DIFF, DIFF_V_DIM)),
        "diff_wo": w((N_DIFF, DIFF_HEADS * DIFF_V_DIM, D)),
        "ffn_w13": w((N_DENSE, D, 2 * DENSE_FF)),
        "ffn_w2": w((N_DENSE, DENSE_FF, D)),
        "moe_router": w((N_MOE, D, N_EXPERTS)),
        "moe_w13": w((N_MOE, N_EXPERTS, D, 2 * EXPERT_FF)),
        "moe_w2": w((N_MOE, N_EXPERTS, EXPERT_FF, D)),
    }


def reference(x, c, ctx, c_ctx, ada_w, ada_b, norm_mix, norm_ffn,
              gqa_wqkv, gqa_q_gain, gqa_k_gain, gqa_wo,
              mla_wdown, mla_qa_gain, mla_kva_gain, mla_wuq, mla_wukv, mla_q_gain, mla_k_gain, mla_wo,
              win_wqkv, win_q_gain, win_k_gain, win_sink, win_wo,
              diff_wqkv, diff_q_gain, diff_k_gain, diff_lambda, diff_subln, diff_wo,
              ffn_w13, ffn_w2, moe_router, moe_w13, moe_w2):
    S = x.shape[1]
    rows = S // GRID_W
    rope_gqa = axial_rope_tables(rows, GQA_HEAD_DIM)
    rope_mla = axial_rope_tables(rows, MLA_ROPE)
    rope_win = axial_rope_tables(rows, WIN_HEAD_DIM)
    rope_diff = axial_rope_tables(rows, DIFF_HEAD_DIM)
    silu_c = jax.nn.silu(c)
    silu_cc = jax.nn.silu(c_ctx)

    for i in range(DEPTH):
        need_ctx = i < DEPTH - 1
        j = i // N_MIXERS
        kind = i % N_MIXERS
        mod_l = (silu_c @ ada_w[i] + ada_b[i])[:, None, :]
        mod_c = silu_cc @ ada_w[i] + ada_b[i]
        sh_a, sc_a, g_a, sh_f, sc_f, g_f = jnp.split(mod_l, 6, axis=-1)
        csh_a, csc_a, cg_a, csh_f, csc_f, cg_f = jnp.split(mod_c, 6, axis=-1)

        h_l = modulate(rms_norm(x, norm_mix[i]), sh_a, sc_a)
        h_c = modulate(rms_norm(ctx, norm_mix[i]), csh_a, csc_a)
        if kind == 0:
            o_l, o_c = gqa_axial(h_l, h_c, gqa_wqkv[j], gqa_q_gain[j], gqa_k_gain[j], gqa_wo[j],
                                 rope_gqa, need_ctx)
        elif kind == 1:
            o_l, o_c = mla(h_l, h_c, mla_wdown[j], mla_qa_gain[j], mla_kva_gain[j], mla_wuq[j],
                           mla_wukv[j], mla_q_gain[j], mla_k_gain[j], mla_wo[j], rope_mla, need_ctx)
        elif kind == 2:
            o_l, o_c = window_gqa(h_l, h_c, win_wqkv[j], win_q_gain[j], win_k_gain[j], win_sink[j],
                                  win_wo[j], rope_win, need_ctx)
        else:
            lam_init = 0.8 - 0.6 * math.exp(-0.3 * i)
            o_l, o_c = diff_attention(h_l, h_c, diff_wqkv[j], diff_q_gain[j], diff_k_gain[j],
                                      diff_lambda[j], diff_subln[j], diff_wo[j], rope_diff,
                                      lam_init, need_ctx)
        x = x + g_a * o_l
        if need_ctx:
            ctx = ctx + cg_a * o_c

        h_l = modulate(rms_norm(x, norm_ffn[i]), sh_f, sc_f)
        x = x + g_f * channel_mixer(h_l, i, ffn_w13, ffn_w2, moe_router, moe_w13, moe_w2)
        if need_ctx:
            h_c = modulate(rms_norm(ctx, norm_ffn[i]), csh_f, csc_f)
            ctx = ctx + cg_f * channel_mixer(h_c, i, ffn_w13, ffn_w2, moe_router, moe_w13, moe_w2)
    return x
```

```cpp
#include <hip/hip_runtime.h>
#include <cstdio>
#include <cstdint>

#define GAS __attribute__((address_space(1)))
#define LAS __attribute__((address_space(3)))
typedef unsigned short bf16_t;
typedef short bf16x8 __attribute__((ext_vector_type(8)));
typedef short s16x4 __attribute__((ext_vector_type(4)));
typedef float f32x4 __attribute__((ext_vector_type(4)));
typedef _Float16 f16_t;
typedef _Float16 f16x4 __attribute__((ext_vector_type(4)));
typedef _Float16 f16x8 __attribute__((ext_vector_type(8)));
typedef float f32x8 __attribute__((ext_vector_type(8)));
typedef float f32x2 __attribute__((ext_vector_type(2)));
typedef float f32x16 __attribute__((ext_vector_type(16)));
typedef unsigned u32x4 __attribute__((ext_vector_type(4)));
typedef unsigned u32x2 __attribute__((ext_vector_type(2)));

__device__ __forceinline__ unsigned cvt_pk_bf16(float lo, float hi) { unsigned r; asm volatile("v_cvt_pk_bf16_f32 %0, %1, %2" : "=v"(r) : "v"(lo), "v"(hi)); return r; }
__device__ __forceinline__ float bf_lo(unsigned w) { return __uint_as_float(w << 16); }
__device__ __forceinline__ float bf_hi(unsigned w) { return __uint_as_float(w & 0xffff0000u); }

typedef int v8i_t __attribute__((ext_vector_type(8)));
typedef int v4i_t __attribute__((ext_vector_type(4)));
__device__ __forceinline__ v8i_t cat8(bf16x8 lo, bf16x8 hi) { const v4i_t a = __builtin_bit_cast(v4i_t, lo), b = __builtin_bit_cast(v4i_t, hi); return __builtin_shufflevector(a, b, 0, 1, 2, 3, 4, 5, 6, 7); }
constexpr float F8_ACT_MUL = 8.0f, F8_W_MUL = 64.0f;
#define F8_SCL_A 124
#define F8_SCL_W 121
__device__ __forceinline__ unsigned pk4_fp8(float a, float b, float c, float d) { unsigned w = 0u; w = __builtin_amdgcn_cvt_pk_fp8_f32(a, b, w, false); w = __builtin_amdgcn_cvt_pk_fp8_f32(c, d, w, true); return w; }
__device__ __forceinline__ int opaque_tid() { int t = threadIdx.x; asm volatile("" : "+v"(t)); return t; }

namespace pg8 {
#define PG8_LAS __attribute__((address_space(3)))
constexpr int BM = 256, BK = 64, HALF = 128, HTB = HALF * BK * 2  , STAGE_BYTES = 8 * HTB;

__host__ __device__ __forceinline__ int lds_byte(int r, int c) { const int st = (r >> 4) * 2 + (c >> 5), rr = r & 15, cc = c & 31, ob = rr * 64 + cc * 2; return st * 1024 + (ob ^ (((ob >> 9) & 1) << 5)); }
__host__ __device__ __forceinline__ void stage_rc(int b, int& R, int& C) { const int st = b / 1024, sb = b % 1024, swz = sb ^ (((sb >> 9) & 1) << 5); R = (st >> 1) * 16 + swz / 64; C = (st & 1) * 32 + (swz % 64) / 2; }
__host__ __device__ __forceinline__ int perm32(int rho) { const int n = rho >> 4, i = rho & 15; return 8 * (i >> 2) + 4 * n + (i & 3); }

struct Unit { int pm, pn, om, on, kb, ks, ov; };
__device__ __forceinline__ bf16x8 emu8v(bf16x8 v) { u32x4 w = __builtin_bit_cast(u32x4, v); w.x = (w.x + 0x00080008u) & 0xFFF0FFF0u; w.y = (w.y + 0x00080008u) & 0xFFF0FFF0u; w.z = (w.z + 0x00080008u) & 0xFFF0FFF0u; w.w = (w.w + 0x00080008u) & 0xFFF0FFF0u; return __builtin_bit_cast(bf16x8, w); }
struct Gemm { const bf16_t* A; const bf16_t* Bt; int K, KL; int emu = 0; int sa = F8_SCL_A; };

#ifndef GROWS
#define GROWS 8
#endif
struct Sched {
    int nN, ntiles, G, c, mode, amode, KS, KL;
    const LAS int* tb;
    int lbase, lend, ovs;
    __device__ __forceinline__ bool next(int i, Unit& u) const {
        int L, kso = 0, ov = 0;
        if (ovs) { const int Lo = i * G + c; if (Lo >= (lend - lbase) * ovs) return false; ov = Lo / ovs; kso = Lo - ov * ovs; L = lbase + ov; }
        else { L = lbase + i * G + c; if (L >= lend) return false; }
        const int ksn = ovs ? 1 : KS;
        const int nig = GROWS * nN * ksn, gid = L / nig, fm = gid * GROWS, gsz = (ntiles - fm) < GROWS ? (ntiles - fm) : GROWS, rem = L - gid * nig;
        const int t = fm + rem % gsz, q = rem / gsz, ks = q / nN, pn = q - ks * nN;
        u.ks = ovs ? kso : ks; u.kb = u.ks * KL; u.ov = ov;
        if (mode == 0) { u.pm = t; u.pn = pn; u.om = t; u.on = pn; }
        else if (mode == 1) { const int tt = t + (t >> 3) + 1; u.pm = tt; u.pn = pn; u.om = tt; u.on = pn; }
        else { int e = 0;
#pragma unroll
            for (int k = 1; k < 8; ++k) e += (t >= __builtin_amdgcn_readfirstlane(tb[k])) ? 1 : 0;
            const int rt = t - __builtin_amdgcn_readfirstlane(tb[e]); u.pm = amode ? t : e * 72 + rt; u.pn = e * nN + pn; u.om = t; u.on = pn; }
        return true;
    }
    __device__ __forceinline__ void a_ready(const Unit&) const {}
    __device__ __forceinline__ void done(const Unit&) const {}
};

struct EpiStore {
    static constexpr bool PERM = true, AFTER_DRAIN = false, ALIGN = true;
    bf16_t* O; int ldc; size_t ks_stride;
    __device__ __forceinline__ void operator()(const f32x4 (&acc)[2][2][4][2], const Unit& u, int wr, int wc, int fr, int fq) const {
        const int row0 = u.om * BM + wr * 64 + fr, col0 = u.on * BM + wc * 32 + 8 * fq;
        bf16_t* Ok = O + (size_t)u.ks * ks_stride;
#pragma unroll
        for (int ai = 0; ai < 2; ++ai)
#pragma unroll
            for (int m = 0; m < 4; ++m) { bf16_t* rowp = Ok + (size_t)(row0 + ai * HALF + m * 16) * ldc + col0;
#pragma unroll
                for (int bj = 0; bj < 2; ++bj) { const f32x4 v0 = acc[ai][bj][m][0], v1 = acc[ai][bj][m][1];
                    u32x4 w; w.x = cvt_pk_bf16(v0[0], v0[1]); w.y = cvt_pk_bf16(v0[2], v0[3]); w.z = cvt_pk_bf16(v1[0], v1[1]); w.w = cvt_pk_bf16(v1[2], v1[3]);
                    *(u32x4*)(rowp + bj * HALF) = w; } }
    }
};
template <int HD> struct EpiQKV {
    static constexpr bool PERM = true, AFTER_DRAIN = false, ALIGN = true;
    bf16_t* O; int ldc; const float* qg; const float* kg; float qscale; const float* cs; const float* sn; int nq_cols, nqk_cols; PG8_LAS float* xch;
    __device__ __forceinline__ void operator()(const f32x4 (&acc)[2][2][4][2], const Unit& u, int wr, int wc, int fr, int fq) const {
        const int colt = u.on * BM; const bool nrm0 = colt < nqk_cols, nrm1 = colt + HALF < nqk_cols;
        const int b9 = u.om / 9, t9 = u.om - b9 * 9; const bool lat = t9 != 0;
        int p0 = (HD == 128) ? (16 * wc + 4 * fq) : (16 * (wc & 1) + 4 * fq);
        asm volatile("" : "+v"(p0));
        f32x4 tc[2][4], ts[2][4];
        f32x4 G1, G2; float SC = 1.0f;
        if (nrm0) {
            { const bool isq = colt < nq_cols; const float* g = isq ? qg : kg; SC = isq ? qscale : 1.0f;
                G1 = *(const f32x4*)(g + p0); G2 = *(const f32x4*)(g + p0 + HD / 2); }
#pragma unroll
            for (int ai = 0; ai < 2; ++ai) { float s[4][2];
#pragma unroll
                for (int m = 0; m < 4; ++m)
#pragma unroll
                    for (int bj = 0; bj < 2; ++bj) { const f32x4 a = acc[ai][bj][m][0], b = acc[ai][bj][m][1];
                        s[m][bj] = (a[0] * a[0] + a[1] * a[1]) + (a[2] * a[2] + a[3] * a[3]) + (b[0] * b[0] + b[1] * b[1]) + (b[2] * b[2] + b[3] * b[3]); }
#pragma unroll
                for (int m = 0; m < 4; ++m)
#pragma unroll
                    for (int bj = 0; bj < 2; ++bj) s[m][bj] += __shfl_xor(s[m][bj], 16);
#pragma unroll
                for (int m = 0; m < 4; ++m)
#pragma unroll
                    for (int bj = 0; bj < 2; ++bj) s[m][bj] += __shfl_xor(s[m][bj], 32);
                if (fq == 0) {
#pragma unroll
                    for (int m = 0; m < 4; ++m)
#pragma unroll
                        for (int bj = 0; bj < 2; ++bj) xch[((ai * 2 + bj) * 128 + wr * 64 + m * 16 + fr) * 4 + wc] = s[m][bj];
                } }
            if (lat) {
#pragma unroll
                for (int ai = 0; ai < 2; ++ai)
#pragma unroll
                    for (int m = 0; m < 4; ++m) { const size_t to = (size_t)((t9 - 1) * 256 + ai * HALF + wr * 64 + m * 16 + fr) * (HD / 2) + p0; tc[ai][m] = *(const f32x4*)(cs + to); ts[ai][m] = *(const f32x4*)(sn + to); }
            }
            asm volatile("s_waitcnt lgkmcnt(0)" ::: "memory"); __builtin_amdgcn_s_barrier(); asm volatile("" ::: "memory");
        }
        const int row0 = u.om * BM + wr * 64 + fr, col0 = colt + wc * 32 + 8 * fq;
#pragma unroll
        for (int bj = 0; bj < 2; ++bj) {
            const bool nrm = bj == 0 ? nrm0 : nrm1;
            if (nrm) {
#pragma unroll
                for (int ai = 0; ai < 2; ++ai)
#pragma unroll
                    for (int m = 0; m < 4; ++m) { bf16_t* rowp = O + (size_t)(row0 + ai * HALF + m * 16) * ldc + col0 + bj * HALF;
                        const f32x4 v0 = acc[ai][bj][m][0], v1 = acc[ai][bj][m][1];
                        const f32x4 pp = *(const PG8_LAS f32x4*)(xch + ((ai * 2 + bj) * 128 + wr * 64 + m * 16 + fr) * 4);
                        const float ss = (HD == 128) ? ((pp[0] + pp[1]) + (pp[2] + pp[3])) : ((wc < 2) ? (pp[0] + pp[1]) : (pp[2] + pp[3]));
                        const float rs = __builtin_amdgcn_rsqf(ss * (1.0f / HD) + 1e-6f) * SC;
                        const f32x4 g1 = G1 * rs, g2 = G2 * rs;
                        float x1[4] = {v0[0] * g1[0], v0[2] * g1[1], v1[0] * g1[2], v1[2] * g1[3]};
                        float x2[4] = {v0[1] * g2[0], v0[3] * g2[1], v1[1] * g2[2], v1[3] * g2[3]};
                        if (lat) { const f32x4 c = tc[ai][m], sv = ts[ai][m];
#pragma unroll
                            for (int i = 0; i < 4; ++i) { const float a = x1[i], b = x2[i]; x1[i] = a * c[i] - b * sv[i]; x2[i] = a * sv[i] + b * c[i]; } }
                        u32x4 w; w.x = cvt_pk_bf16(x1[0], x2[0]); w.y = cvt_pk_bf16(x1[1], x2[1]); w.z = cvt_pk_bf16(x1[2], x2[2]); w.w = cvt_pk_bf16(x1[3], x2[3]);
                        *(u32x4*)rowp = w; }
            } else {
#pragma unroll
                for (int ai = 0; ai < 2; ++ai)
#pragma unroll
                    for (int m = 0; m < 4; ++m) { bf16_t* rowp = O + (size_t)(row0 + ai * HALF + m * 16) * ldc + col0 + bj * HALF;
                        const f32x4 v0 = acc[ai][bj][m][0], v1 = acc[ai][bj][m][1];
                        u32x4 w; w.x = cvt_pk_bf16(v0[0], v0[1]); w.y = cvt_pk_bf16(v0[2], v0[3]); w.z = cvt_pk_bf16(v1[0], v1[1]); w.w = cvt_pk_bf16(v1[2], v1[3]);
                        *(u32x4*)rowp = w; }
            }
        }
    }
};
constexpr float SW_G = 1.4426950408889634f, SW_U = 8.0f / 1.4426950408889634f;
__device__ __forceinline__ float swiglu8(float gp, float up) { return fminf(fmaxf(gp * up * __builtin_amdgcn_rcpf(1.0f + __builtin_amdgcn_exp2f(-gp)), -448.f), 448.f); }
__device__ __forceinline__ float silu_mul(float g, float u) { return g * u * __builtin_amdgcn_rcpf(1.0f + __builtin_amdgcn_exp2f(-1.4426950408889634f * g)); }
struct EpiSlab {
    static constexpr bool PERM = false, AFTER_DRAIN = false, ALIGN = true;
    float* slab;
    __device__ __forceinline__ void operator()(const f32x4 (&acc)[2][2][4][2], const Unit& u, int wr, int wc, int fr, int fq) const {
        float* base = slab + (size_t)(u.ks * 128 + u.ov) * 65536 + (size_t)(wr * 64 + fr) * 256 + wc * 32 + 4 * fq;
#pragma unroll
        for (int ai = 0; ai < 2; ++ai)
#pragma unroll
            for (int m = 0; m < 4; ++m)
#pragma unroll
                for (int bj = 0; bj < 2; ++bj)
#pragma unroll
                    for (int n = 0; n < 2; ++n) *(f32x4*)(base + (size_t)(ai * HALF + m * 16) * 256 + bj * HALF + n * 16) = acc[ai][bj][m][n];
    }
};
#ifndef SWIGLU_ALIGN
#define SWIGLU_ALIGN true
#endif
struct EpiSwiGLU8 {
    static constexpr bool PERM = true, AFTER_DRAIN = false, ALIGN = true;
    unsigned char* O; int ldc;
    __device__ __forceinline__ void operator()(const f32x4 (&acc)[2][2][4][2], const Unit& u, int wr, int wc, int fr, int fq) const {
        const int row0 = u.om * BM + wr * 64 + fr, col0 = u.on * HALF + wc * 32 + 8 * fq;
#pragma unroll
        for (int ai = 0; ai < 2; ++ai)
#pragma unroll
            for (int m = 0; m < 4; ++m) { unsigned char* rowp = O + (size_t)(row0 + ai * HALF + m * 16) * ldc + col0;
                const f32x4 g0 = acc[ai][0][m][0], g1 = acc[ai][0][m][1], u0 = acc[ai][1][m][0], u1 = acc[ai][1][m][1];
                float v[8];
#pragma unroll
                for (int i = 0; i < 4; ++i) { v[i] = swiglu8(g0[i], u0[i]); v[4 + i] = swiglu8(g1[i], u1[i]); }
                u32x2 w; w.x = pk4_fp8(v[0], v[1], v[2], v[3]); w.y = pk4_fp8(v[4], v[5], v[6], v[7]);
                *(u32x2*)rowp = w; }
    }
};
#ifndef RESGATE_ALIGN
#define RESGATE_ALIGN false
#endif
struct EpiResGate {
    static constexpr bool PERM = true, AFTER_DRAIN = false, ALIGN = RESGATE_ALIGN;
    f16_t* X; const float* mod;
    __device__ __forceinline__ void operator()(const f32x4 (&acc)[2][2][4][2], const Unit& u, int wr, int wc, int fr, int fq) const {
        const int b = u.om / 9, mr = (u.om - b * 9 == 0) ? 8 : b;
        const float* gp = mod + (size_t)mr * 6144;
        const int row0 = u.om * BM + wr * 64 + fr, col0 = u.on * BM + wc * 32 + 8 * fq;
        f32x4 gv[2][2];
#pragma unroll
        for (int bj = 0; bj < 2; ++bj)
#pragma unroll
            for (int n = 0; n < 2; ++n) gv[bj][n] = *(const f32x4*)(gp + col0 + bj * HALF + n * 4);
#pragma unroll
        for (int ai = 0; ai < 2; ++ai)
#pragma unroll
            for (int m = 0; m < 4; ++m) { f16_t* rowp = X + (size_t)(row0 + ai * HALF + m * 16) * 1024 + col0;
#pragma unroll
                for (int bj = 0; bj < 2; ++bj) { f16x8* p = (f16x8*)(rowp + bj * HALF); const f32x8 x = __builtin_convertvector(*p, f32x8);
                    const f32x4 lo = (f32x4){x[0], x[1], x[2], x[3]} + gv[bj][0] * acc[ai][bj][m][0], hi = (f32x4){x[4], x[5], x[6], x[7]} + gv[bj][1] * acc[ai][bj][m][1];
                    *p = __builtin_convertvector((f32x8){lo[0], lo[1], lo[2], lo[3], hi[0], hi[1], hi[2], hi[3]}, f16x8); }
                if (m & 1) asm volatile("" ::: "memory"); }
    }
};

template <class Epi, class Sched, bool ALIGN_EPI = false, bool SP2 = false, bool F8 = false>
__device__ __forceinline__ void gemm_phase(PG8_LAS unsigned char* lds, const Gemm g, const Sched& S, const Epi& E) {
    const int tid = opaque_tid(), wid = __builtin_amdgcn_readfirstlane(tid >> 6), lane = tid & 63, wr = wid >> 2, wc = wid & 3, fr = lane & 15, fq = lane >> 4;
    const int RS = F8 ? g.K : 2 * g.K, nt = F8 ? g.KL / 128 : g.KL / BK;
    unsigned voffA[2], voffB[2];
#pragma unroll
    for (int i = 0; i < 2; ++i) { int R, C; stage_rc(tid * 16 + i * 8192, R, C); const int Rb = Epi::PERM ? ((R & ~31) + perm32(R & 31)) : R;
        voffA[i] = (unsigned)(R * RS + C * 2); voffB[i] = (unsigned)(Rb * RS + C * 2); }
    const size_t kstep = (size_t)(BK * 2);
    const size_t hstep = (size_t)HALF * RS;
    const size_t tstep = 2 * hstep;
    const unsigned ldsw = (unsigned)wid * 1024u;
    const int aoff = lds_byte(wr * 64 + fr, fq * 8), boff = lds_byte(wc * 32 + fr, fq * 8);
#define PG8_SA(b, h) (((b) * 2 + (h)) * HTB)
#define PG8_SB(b, h) ((4 + (b) * 2 + (h)) * HTB)
#define PG8_STAGE(bufoff, gbase, voff) do { _Pragma("unroll") for (int _i = 0; _i < 2; ++_i) \
        __builtin_amdgcn_global_load_lds((const unsigned*)((const char*)(gbase) + (voff)[_i]), (PG8_LAS unsigned*)(lds + (bufoff) + ldsw + _i * 8192), 16, 0, 0); } while (0)
#define PG8_LDA(dst, b, h) do { if constexpr (F8) { _Pragma("unroll") for (int m = 0; m < 4; ++m) dst##8[m] = cat8(*(const PG8_LAS bf16x8*)(lds + PG8_SA(b, h) + aoff + m * 2048), *(const PG8_LAS bf16x8*)(lds + PG8_SA(b, h) + aoff + m * 2048 + 1024)); } \
    else { _Pragma("unroll") for (int m = 0; m < 4; ++m) _Pragma("unroll") for (int k = 0; k < 2; ++k) dst[m][k] = *(const PG8_LAS bf16x8*)(lds + PG8_SA(b, h) + aoff + m * 2048 + k * 1024); } } while (0)
#define PG8_LDB(dst, b, h) do { if constexpr (F8) { _Pragma("unroll") for (int n = 0; n < 2; ++n) dst##8[n] = cat8(*(const PG8_LAS bf16x8*)(lds + PG8_SB(b, h) + boff + n * 2048), *(const PG8_LAS bf16x8*)(lds + PG8_SB(b, h) + boff + n * 2048 + 1024)); } \
    else { _Pragma("unroll") for (int n = 0; n < 2; ++n) _Pragma("unroll") for (int k = 0; k < 2; ++k) dst[n][k] = *(const PG8_LAS bf16x8*)(lds + PG8_SB(b, h) + boff + n * 2048 + k * 1024); } } while (0)
#define PG8_MMA(ai, bj, At, Bt, FST) do { __builtin_amdgcn_s_setprio(1); if constexpr (F8) { if (FST) { _Pragma("unroll") for (int m = 0; m < 4; ++m) _Pragma("unroll") for (int n = 0; n < 2; ++n) \
        asm volatile("v_mfma_scale_f32_16x16x128_f8f6f4 %0, %1, %2, 0, %3, %4 op_sel_hi:[0,0,0]" : "=&v"(acc[ai][bj][m][n]) : "v"(Bt##8[n]), "v"(At##8[m]), "v"(f8sw), "v"(f8sa)); } else { \
        _Pragma("unroll") for (int m = 0; m < 4; ++m) _Pragma("unroll") for (int n = 0; n < 2; ++n) \
        asm volatile("v_mfma_scale_f32_16x16x128_f8f6f4 %0, %1, %2, %0, %3, %4 op_sel_hi:[0,0,0]" : "+v"(acc[ai][bj][m][n]) : "v"(Bt##8[n]), "v"(At##8[m]), "v"(f8sw), "v"(f8sa)); } } else { \
        if (FST) { _Pragma("unroll") for (int m = 0; m < 4; ++m) _Pragma("unroll") for (int n = 0; n < 2; ++n) { \
            acc[ai][bj][m][n] = g.emu ? __builtin_amdgcn_mfma_f32_16x16x32_bf16(emu8v(Bt[n][0]), emu8v(At[m][0]), (f32x4){0.f, 0.f, 0.f, 0.f}, 0, 0, 0) : __builtin_amdgcn_mfma_f32_16x16x32_bf16(Bt[n][0], At[m][0], (f32x4){0.f, 0.f, 0.f, 0.f}, 0, 0, 0); \
            acc[ai][bj][m][n] = g.emu ? __builtin_amdgcn_mfma_f32_16x16x32_bf16(emu8v(Bt[n][1]), emu8v(At[m][1]), acc[ai][bj][m][n], 0, 0, 0) : __builtin_amdgcn_mfma_f32_16x16x32_bf16(Bt[n][1], At[m][1], acc[ai][bj][m][n], 0, 0, 0); } } else \
        _Pragma("unroll") for (int m = 0; m < 4; ++m) _Pragma("unroll") for (int n = 0; n < 2; ++n) _Pragma("unroll") for (int k = 0; k < 2; ++k) \
        acc[ai][bj][m][n] = g.emu ? __builtin_amdgcn_mfma_f32_16x16x32_bf16(emu8v(Bt[n][k]), emu8v(At[m][k]), acc[ai][bj][m][n], 0, 0, 0) : __builtin_amdgcn_mfma_f32_16x16x32_bf16(Bt[n][k], At[m][k], acc[ai][bj][m][n], 0, 0, 0); } __builtin_amdgcn_s_setprio(0); } while (0)
#define PG8_WAIT_V(n) asm volatile("s_waitcnt vmcnt(" #n ")" ::: "memory")
#define PG8_WAIT_L(n) asm volatile("s_waitcnt lgkmcnt(" #n ")" ::: "memory")
#define PG8_BAR __builtin_amdgcn_s_barrier()
#define PG8_SCHED __builtin_amdgcn_sched_barrier(0)
    Unit cur, nxt; int ui = 0;
    if (!S.next(0, cur)) return;
    f32x4 acc[2][2][4][2];
#pragma unroll
    for (int a = 0; a < 2; ++a)
#pragma unroll
        for (int b = 0; b < 2; ++b)
#pragma unroll
            for (int m = 0; m < 4; ++m)
#pragma unroll
                for (int n = 0; n < 2; ++n) acc[a][b][m][n] = (f32x4){0.f, 0.f, 0.f, 0.f};
    const int f8sw = F8_SCL_W, f8sa = g.sa;
    bf16x8 At[4][2], B0[2][2], B1[2][2]; v8i_t At8[4], B08[2], B18[2];
    const char* cA = (const char*)g.A + (size_t)cur.pm * tstep + cur.kb; const char* cB = (const char*)g.Bt + (size_t)cur.pn * tstep + cur.kb;
    S.a_ready(cur);
    if constexpr (SP2) {
        PG8_STAGE(PG8_SB(0, 0), cB, voffB); PG8_STAGE(PG8_SB(0, 1), cB + hstep, voffB); PG8_STAGE(PG8_SA(0, 0), cA, voffA); PG8_STAGE(PG8_SA(0, 1), cA + hstep, voffA);
        if (wr == 1) PG8_BAR;
        PG8_WAIT_V(2); PG8_BAR;
        PG8_STAGE(PG8_SB(1, 0), cB + kstep, voffB); PG8_STAGE(PG8_SA(1, 0), cA + kstep, voffA); PG8_STAGE(PG8_SB(1, 1), cB + hstep + kstep, voffB);
        PG8_WAIT_V(6); PG8_BAR;
    } else {
        PG8_STAGE(PG8_SB(0, 0), cB, voffB); PG8_STAGE(PG8_SA(0, 0), cA, voffA); PG8_STAGE(PG8_SB(0, 1), cB + hstep, voffB); PG8_STAGE(PG8_SA(0, 1), cA + hstep, voffA);
        if (wr == 1) PG8_BAR;
        PG8_WAIT_V(4); PG8_BAR;
        PG8_STAGE(PG8_SB(1, 0), cB + kstep, voffB); PG8_STAGE(PG8_SA(1, 0), cA + kstep, voffA); PG8_STAGE(PG8_SB(1, 1), cB + hstep + kstep, voffB);
        PG8_WAIT_V(6); PG8_BAR;
    }
    for (;;) {
        bool has_next = false;
        const char* nA = cA; const char* nB = cB;
#define PG8_NEXT() do { has_next = S.next(ui + 1, nxt); nA = has_next ? (const char*)g.A + (size_t)nxt.pm * tstep + nxt.kb : cA; nB = has_next ? (const char*)g.Bt + (size_t)nxt.pn * tstep + nxt.kb : cB; } while (0)
        if (!F8 || nt < 4) PG8_NEXT();
        for (int t = 0; t < nt; t += 2) {
            const bool last = (t == nt - 2); const bool first_ = (t == 0);
            const char* a1 = cA + (size_t)(t + 1) * kstep;
            const char* a2 = last ? nA : cA + (size_t)(t + 2) * kstep; const char* b2 = last ? nB : cB + (size_t)(t + 2) * kstep;
            const char* a3 = a2 + kstep; const char* b3 = b2 + kstep;
            if (last && has_next) S.a_ready(nxt);
            if constexpr (SP2) {
            PG8_LDB(B0, 0, 0); PG8_LDB(B1, 0, 1); PG8_SCHED; PG8_LDA(At, 0, 0); PG8_STAGE(PG8_SA(1, 1), a1 + hstep, voffA);
            PG8_WAIT_V(8); PG8_WAIT_L(0); PG8_BAR; PG8_MMA(0, 0, At, B0, first_); if (F8 && nt >= 4 && first_) PG8_NEXT(); PG8_MMA(0, 1, At, B1, first_); PG8_BAR; PG8_SCHED;
            PG8_LDA(At, 0, 1); PG8_STAGE(PG8_SB(0, 0), b2, voffB); PG8_STAGE(PG8_SB(0, 1), b2 + hstep, voffB); PG8_STAGE(PG8_SA(0, 0), a2, voffA);
            PG8_WAIT_V(8); PG8_WAIT_L(0); PG8_BAR; PG8_MMA(1, 0, At, B0, first_); PG8_MMA(1, 1, At, B1, first_); PG8_BAR; PG8_SCHED;
            PG8_LDB(B0, 1, 0); PG8_LDB(B1, 1, 1); PG8_SCHED; PG8_LDA(At, 1, 0); PG8_STAGE(PG8_SA(0, 1), a2 + hstep, voffA);
            PG8_WAIT_V(8); PG8_WAIT_L(0); PG8_BAR; PG8_MMA(0, 0, At, B0, false); PG8_MMA(0, 1, At, B1, false); PG8_BAR; PG8_SCHED;
            PG8_LDA(At, 1, 1); PG8_STAGE(PG8_SB(1, 0), b3, voffB); PG8_STAGE(PG8_SB(1, 1), b3 + hstep, voffB); PG8_STAGE(PG8_SA(1, 0), a3, voffA);
            PG8_WAIT_V(8); PG8_WAIT_L(0); PG8_BAR; PG8_MMA(1, 0, At, B0, false); PG8_MMA(1, 1, At, B1, false); PG8_BAR; PG8_SCHED;
            } else {
            PG8_LDB(B0, 0, 0); PG8_SCHED; PG8_LDA(At, 0, 0); PG8_STAGE(PG8_SA(1, 1), a1 + hstep, voffA);
            PG8_WAIT_L(8); PG8_BAR; PG8_WAIT_L(0); PG8_MMA(0, 0, At, B0, first_); if (F8 && nt >= 4 && first_) PG8_NEXT(); PG8_BAR; PG8_SCHED;
            PG8_LDB(B1, 0, 1); PG8_STAGE(PG8_SB(0, 0), b2, voffB);
            PG8_BAR; PG8_WAIT_L(0); PG8_MMA(0, 1, At, B1, first_); PG8_BAR;
            PG8_LDA(At, 0, 1); PG8_STAGE(PG8_SA(0, 0), a2, voffA);
            PG8_BAR; PG8_WAIT_L(0); PG8_MMA(1, 0, At, B0, first_); PG8_BAR; PG8_SCHED;
            PG8_STAGE(PG8_SB(0, 1), b2 + hstep, voffB);
            PG8_WAIT_V(6); PG8_BAR; PG8_MMA(1, 1, At, B1, first_); PG8_BAR;
            PG8_LDB(B0, 1, 0); PG8_SCHED; PG8_LDA(At, 1, 0); PG8_STAGE(PG8_SA(0, 1), a2 + hstep, voffA);
            PG8_WAIT_L(8); PG8_BAR; PG8_WAIT_L(0); PG8_MMA(0, 0, At, B0, false); PG8_BAR; PG8_SCHED;
            PG8_LDB(B1, 1, 1); PG8_STAGE(PG8_SB(1, 0), b3, voffB);
            PG8_BAR; PG8_WAIT_L(0); PG8_MMA(0, 1, At, B1, false); PG8_BAR;
            PG8_LDA(At, 1, 1); PG8_STAGE(PG8_SA(1, 0), a3, voffA);
            PG8_BAR; PG8_WAIT_L(0); PG8_MMA(1, 0, At, B0, false); PG8_BAR; PG8_SCHED;
            PG8_STAGE(PG8_SB(1, 1), b3 + hstep, voffB);
            PG8_WAIT_V(6); PG8_BAR; PG8_MMA(1, 1, At, B1, false); PG8_BAR;
            }
        }
        if constexpr (F8) asm volatile("s_nop 15\n\ts_nop 15" ::: "memory");
        if constexpr (ALIGN_EPI) { if (wr == 0) PG8_BAR; }
#ifdef EPI_DBL
        if constexpr (F8 && ALIGN_EPI) { E(acc, cur, wr, wc, fr, fq); asm volatile("" ::: "memory");
            _Pragma("unroll") for (int a = 0; a < 2; ++a) _Pragma("unroll") for (int b = 0; b < 2; ++b) _Pragma("unroll") for (int m = 0; m < 4; ++m) _Pragma("unroll") for (int n = 0; n < 2; ++n) asm volatile("" : "+v"(acc[a][b][m][n])); }
#endif
        if constexpr (!Epi::AFTER_DRAIN) { E(acc, cur, wr, wc, fr, fq); S.done(cur); }
        if (!has_next) break;
        if constexpr (false)
#pragma unroll
        for (int a = 0; a < 2; ++a)
#pragma unroll
            for (int b = 0; b < 2; ++b)
#pragma unroll
                for (int m = 0; m < 4; ++m)
#pragma unroll
                    for (int n = 0; n < 2; ++n) acc[a][b][m][n] = (f32x4){0.f, 0.f, 0.f, 0.f};
        cur = nxt; cA = nA; cB = nB; ++ui;
        if constexpr (ALIGN_EPI) { if (wr == 1) PG8_BAR; }
    }
    PG8_WAIT_V(0);
    if constexpr (!ALIGN_EPI) { if (wr == 0) PG8_BAR; }
    PG8_BAR;
    if constexpr (Epi::AFTER_DRAIN) { E.fused(acc, cur, wr, wc, fr, fq, lds, wid, lane); S.done(cur); }
#undef PG8_SA
#undef PG8_SB
#undef PG8_STAGE
#undef PG8_LDA
#undef PG8_LDB
#undef PG8_MMA
#undef PG8_NEXT
#undef PG8_WAIT_V
#undef PG8_WAIT_L
#undef PG8_BAR
#undef PG8_SCHED
}
}

#ifndef DBG_BREAK
#define DBG_BREAK 0
#endif
namespace att {
#ifndef OSTAGE
#define OSTAGE 1
#endif
constexpr int NW = 8, QBLK = 32, KVBLK = 64;
constexpr float THR_L2 = 11.5f;
#define SBAR() __builtin_amdgcn_sched_barrier(0)
__device__ __forceinline__ int crow(int r, int hi) { return (r & 3) + 8 * (r >> 2) + 4 * hi; }
template <int DQK> __device__ __forceinline__ int ksw(int row) { return (DQK == 128) ? (row & 15) : ((row >> 1) & 7); }
template <int DQK> __device__ __forceinline__ int kswz(int row, int colB) { return row * (DQK * 2) + (colB ^ (ksw<DQK>(row) << 4)); }
template <int DQK> constexpr int NKB = (DQK == 128) ? 8 : 4;
#define KADDR(kbarr, d0) ((DQK == 128) ? (kbarr)[(d0) & (NKB<DQK> - 1)] : (kbarr)[(d0) & 3] + ((d0) >> 2) * 128)
template <int DV> __device__ __forceinline__ int v_st(int k, int c) { const int kk = (k & ~0xC) | ((k & 4) << 1) | ((k & 8) >> 1); return ((kk >> 3) * (DV / 32) + (c >> 5)) * 512 + ((kk & 7) * 32 + (c & 31)) * 2; }
__device__ __forceinline__ int v_rd_base(int lane) { return ((lane & 3) << 3) | (((lane >> 2) & 3) << 6) | (((lane >> 4) & 1) << 5) | (((lane >> 5) & 1) << 8); }
template <int DV> constexpr int v_rd_off(int d0, int ks, int half) { return d0 * 512 + ks * (2 * (DV / 32) * 512) + half * ((DV / 32) * 512); }
template <int OFF> __device__ __forceinline__ s16x4 tr_read(int vb) {
    s16x4 r; asm volatile("ds_read_b64_tr_b16 %0, %1 offset:%2" : "=&v"(r) : "v"(vb), "i"(OFF) : "memory"); return r;
}
__device__ __forceinline__ void band_mask(f32x16& p0, f32x16& p1, int d  , int hi) {
#pragma unroll
    for (int r = 0; r < 16; ++r) { const int d0 = d + crow(r, hi), d1 = d0 + 32;
        if (d0 < -128 || d0 > 128) p0[r] = -1e30f; if (d1 < -128 || d1 > 128) p1[r] = -1e30f; }
}
__device__ __forceinline__ void partialSM(f32x16& p0, f32x16& p1, float& m_reg, float& mn, float& alpha) {
    float ma = fmaxf(p0[0], p0[1]), mb = fmaxf(p0[2], p0[3]), mc = fmaxf(p1[0], p1[1]), md = fmaxf(p1[2], p1[3]);
#pragma unroll
    for (int r = 4; r < 16; r += 4) { ma = fmaxf(fmaxf(ma, p0[r]), p0[r + 1]); mb = fmaxf(fmaxf(mb, p0[r + 2]), p0[r + 3]); mc = fmaxf(fmaxf(mc, p1[r]), p1[r + 1]); md = fmaxf(fmaxf(md, p1[r + 2]), p1[r + 3]); }
    float pmax = fmaxf(fmaxf(ma, mb), fmaxf(mc, md));
    { auto rr = __builtin_amdgcn_permlane32_swap(__float_as_uint(pmax), __float_as_uint(pmax), false, false);
      pmax = fmaxf(__uint_as_float(rr[0]), __uint_as_float(rr[1])); }
    if (__builtin_expect(__all(pmax - m_reg <= THR_L2), 1)) { mn = m_reg; alpha = 1.f; }
    else { mn = fmaxf(m_reg, pmax); alpha = __builtin_amdgcn_exp2f(m_reg - mn); m_reg = mn; }
#pragma unroll
    for (int r = 0; r < 16; ++r) p0[r] = p0[r] - mn;
#pragma unroll
    for (int r = 0; r < 16; ++r) p1[r] = p1[r] - mn;
#pragma unroll
    for (int r = 0; r < 16; ++r) p0[r] = __builtin_amdgcn_exp2f(p0[r]);
}
__device__ __forceinline__ void finishSM(f32x16& p0, f32x16& p1, float alpha, float& l_reg, bf16x8& pa0, bf16x8& pa1, bf16x8& pa2, bf16x8& pa3) {
#pragma unroll
    for (int r = 0; r < 16; ++r) p1[r] = __builtin_amdgcn_exp2f(p1[r]);
    float sa = p0[0] + p0[1], sb = p0[2] + p0[3], sc = p1[0] + p1[1], sd = p1[2] + p1[3];
#pragma unroll
    for (int r = 4; r < 16; r += 4) { sa += p0[r] + p0[r + 1]; sb += p0[r + 2] + p0[r + 3]; sc += p1[r] + p1[r + 1]; sd += p1[r + 2] + p1[r + 3]; }
    float ps = (sa + sb) + (sc + sd);
    { auto rr = __builtin_amdgcn_permlane32_swap(__float_as_uint(ps), __float_as_uint(ps), false, false);
      ps = __uint_as_float(rr[0]) + __uint_as_float(rr[1]); }
    l_reg = l_reg * alpha + ps;
#define PK4(P, BASE, OUT) do { unsigned a0 = cvt_pk_bf16(P[BASE + 0], P[BASE + 1]), a1 = cvt_pk_bf16(P[BASE + 2], P[BASE + 3]);   \
    unsigned b0 = cvt_pk_bf16(P[BASE + 4], P[BASE + 5]), b1 = cvt_pk_bf16(P[BASE + 6], P[BASE + 7]);                              \
    auto r0 = __builtin_amdgcn_permlane32_swap(a0, b0, false, false); auto r1 = __builtin_amdgcn_permlane32_swap(a1, b1, false, false); \
    u32x4 w = {r0[0], r1[0], r0[1], r1[1]}; OUT = *reinterpret_cast<bf16x8*>(&w); } while (0)
    PK4(p0, 0, pa0); PK4(p0, 8, pa1); PK4(p1, 0, pa2); PK4(p1, 8, pa3);
#undef PK4
}
template <int DQK, int QSP, int BOFF> __device__ __forceinline__ void qkt(f32x16& p0, f32x16& p1, const int (&kb)[NKB<DQK>], const bf16x8 (&qr)[DQK / 16 - QSP], const LAS char* qsp) {
    p0 = f32x16{}; p1 = f32x16{};
#pragma unroll
    for (int d0 = 0; d0 < DQK / 16; ++d0) {
        const bf16x8 b0 = *reinterpret_cast<const LAS bf16x8*>((uintptr_t)(unsigned)(KADDR(kb, d0) + BOFF));
        const bf16x8 b1 = *reinterpret_cast<const LAS bf16x8*>((uintptr_t)(unsigned)(KADDR(kb, d0) + BOFF + 32 * DQK * 2));
        bf16x8 qf;
        if constexpr (QSP > 0) { if (d0 >= DQK / 16 - QSP) qf = *reinterpret_cast<const volatile LAS bf16x8*>(qsp + (d0 - (DQK / 16 - QSP)) * 1024); else qf = qr[d0 < DQK / 16 - QSP ? d0 : 0]; }
        else qf = qr[d0];
        p0 = __builtin_amdgcn_mfma_f32_32x32x16_bf16(b0, qf, p0, 0, 0, 0);
        p1 = __builtin_amdgcn_mfma_f32_32x32x16_bf16(b1, qf, p1, 0, 0, 0); }
}
#ifndef PV_BUILTIN
#define PV_BUILTIN 1
#endif
typedef short v4i16_t __attribute__((ext_vector_type(4)));
template <int OFF> __device__ __forceinline__ s16x4 tr_read_b(int vb) {
    return __builtin_bit_cast(s16x4, __builtin_amdgcn_ds_read_tr16_b64_v4i16((LAS v4i16_t*)(uintptr_t)(unsigned)(vb + OFF)));
}
template <int DV, int D0, bool BI> __device__ __forceinline__ void pv_one(f32x16& od, int vb, bf16x8 pa0, bf16x8 pa1, bf16x8 pa2, bf16x8 pa3) {
  s16x4 l0, h0, l1, h1, l2, h2, l3, h3;
  if constexpr (BI && PV_BUILTIN) {
    l0 = tr_read_b<v_rd_off<DV>(D0, 0, 0)>(vb); h0 = tr_read_b<v_rd_off<DV>(D0, 0, 1)>(vb); l1 = tr_read_b<v_rd_off<DV>(D0, 1, 0)>(vb); h1 = tr_read_b<v_rd_off<DV>(D0, 1, 1)>(vb);
    l2 = tr_read_b<v_rd_off<DV>(D0, 2, 0)>(vb); h2 = tr_read_b<v_rd_off<DV>(D0, 2, 1)>(vb); l3 = tr_read_b<v_rd_off<DV>(D0, 3, 0)>(vb); h3 = tr_read_b<v_rd_off<DV>(D0, 3, 1)>(vb);
  } else {
    l0 = tr_read<v_rd_off<DV>(D0, 0, 0)>(vb); h0 = tr_read<v_rd_off<DV>(D0, 0, 1)>(vb); l1 = tr_read<v_rd_off<DV>(D0, 1, 0)>(vb); h1 = tr_read<v_rd_off<DV>(D0, 1, 1)>(vb);
    l2 = tr_read<v_rd_off<DV>(D0, 2, 0)>(vb); h2 = tr_read<v_rd_off<DV>(D0, 2, 1)>(vb); l3 = tr_read<v_rd_off<DV>(D0, 3, 0)>(vb); h3 = tr_read<v_rd_off<DV>(D0, 3, 1)>(vb);
    asm volatile("s_waitcnt lgkmcnt(0)" ::: "memory"); SBAR();
  }
#define PKV(L, H) (bf16x8){L[0], L[1], L[2], L[3], H[0], H[1], H[2], H[3]}
    od = __builtin_amdgcn_mfma_f32_32x32x16_bf16(pa0, PKV(l0, h0), od, 0, 0, 0);
    od = __builtin_amdgcn_mfma_f32_32x32x16_bf16(pa1, PKV(l1, h1), od, 0, 0, 0);
    od = __builtin_amdgcn_mfma_f32_32x32x16_bf16(pa2, PKV(l2, h2), od, 0, 0, 0);
    od = __builtin_amdgcn_mfma_f32_32x32x16_bf16(pa3, PKV(l3, h3), od, 0, 0, 0);
#undef PKV
}
template <int DV, bool BI = true> __device__ __forceinline__ void pv_all(f32x16 (&o)[DV / 32], int vb, bf16x8 pa0, bf16x8 pa1, bf16x8 pa2, bf16x8 pa3) {
    pv_one<DV, 0, BI>(o[0], vb, pa0, pa1, pa2, pa3); pv_one<DV, 1, BI>(o[1], vb, pa0, pa1, pa2, pa3);
    if constexpr (DV == 128) { pv_one<DV, 2, BI>(o[2], vb, pa0, pa1, pa2, pa3); pv_one<DV, 3, BI>(o[3], vb, pa0, pa1, pa2, pa3); }
}

template <int DQK, int DV, bool MASK, int SDEPTH, int QSP, int ldq, int ldk, int ldv, int ldo, bool O8 = false>
__device__ __forceinline__ void attn_unit(const bf16_t* __restrict__ Qb, const bf16_t* __restrict__ Kh, const bf16_t* __restrict__ Vh,
                                          bf16_t* __restrict__ Ob, int NT, int lo, float m_init, float l_init, int qpos0, LAS char* lds) {
    constexpr int SHM_K = KVBLK * DQK * 2, SHM_V = KVBLK * DV * 2, NKP = DQK / 64, NVP = DV / 64, LPT = NKP + NVP, ND0 = DQK / 16, NDV = DV / 32;
    const int tid = opaque_tid(), wid = tid >> 6, lane = tid & 63, r32 = lane & 31, hi = lane >> 5;
    LAS char* V_lds = lds; LAS char* K_lds = lds + 2 * SHM_V;
    LAS float* ws = (LAS float*)(lds + 2 * SHM_V + 2 * SHM_K) + wid * 64; LAS float* li_l = ws; LAS float* al_l = ws + 32;
    float m_reg = m_init, l_reg = l_init; f32x16 o[NDV]; bf16x8 qr[ND0 - QSP];
    LAS char* qsp = lds + 2 * SHM_V + 2 * SHM_K + 2048 + wid * (QSP * 1024) + lane * 16;
#pragma unroll
    for (int d = 0; d < NDV; ++d) o[d] = f32x16{};
    const bf16_t* Qw = Qb + (long)(wid * QBLK + r32) * ldq + hi * 8;
#pragma unroll
    for (int d0 = 0; d0 < ND0; ++d0) { const bf16x8 qv = *reinterpret_cast<const bf16x8*>(Qw + d0 * 16); if (d0 < ND0 - QSP) qr[d0 < ND0 - QSP ? d0 : 0] = qv; else *reinterpret_cast<LAS bf16x8*>(qsp + (d0 - (ND0 - QSP)) * 1024) = qv; }
    const int srow = tid >> 3, sc0 = (tid & 7) * 8;
    const int koff0 = srow * ldk + sc0, voff0 = srow * ldv + sc0, vst0 = v_st<DV>(srow, sc0);
    int kst[NKP];
#pragma unroll
    for (int q = 0; q < NKP; ++q) kst[q] = kswz<DQK>(srow, sc0 * 2 + 128 * q);
    const int vb0 = (int)(uintptr_t)V_lds + v_rd_base(lane);
    int kb[NKB<DQK>];
#pragma unroll
    for (int x = 0; x < NKB<DQK>; ++x) kb[x] = (int)(uintptr_t)K_lds + r32 * (DQK * 2) + ((x * 32 + hi * 16) ^ (ksw<DQK>(r32) << 4));
    struct { bf16x8 k[NKP], v[NVP]; } sr_[SDEPTH];
#define KT(j) ((j) < 4 ? (j) : (j) + lo)
#define SLOAD(i, j) do { const int kt_ = __builtin_amdgcn_readfirstlane(KT(j)); const bf16_t* Vt_ = Vh + (long)kt_ * (KVBLK * (long)ldv); const bf16_t* Kt_ = Kh + (long)kt_ * (KVBLK * (long)ldk); \
    _Pragma("unroll") for (int q_ = 0; q_ < NVP; ++q_) sr_[i].v[q_] = *reinterpret_cast<const bf16x8*>(Vt_ + voff0 + 64 * q_); \
    _Pragma("unroll") for (int q_ = 0; q_ < NKP; ++q_) sr_[i].k[q_] = *reinterpret_cast<const bf16x8*>(Kt_ + koff0 + 64 * q_); } while (0)
#define SWRITE(b, i) do { \
    _Pragma("unroll") for (int q_ = 0; q_ < NVP; ++q_) *(LAS bf16x8*)(V_lds + (b) * SHM_V + vst0 + 1024 * q_) = sr_[i].v[q_]; \
    _Pragma("unroll") for (int q_ = 0; q_ < NKP; ++q_) *(LAS bf16x8*)(K_lds + (b) * SHM_K + kst[q_]) = sr_[i].k[q_]; } while (0)
#define SWAIT() asm volatile("s_waitcnt vmcnt(%0)" :: "n"(SDEPTH == 2 ? LPT : 0) : "memory")
#define RESC(a) do { if (__any((a) < 1.f)) { if (hi == 0) al_l[r32] = (a); asm volatile("s_waitcnt lgkmcnt(0)" ::: "memory"); \
    _Pragma("unroll") for (int d = 0; d < NDV; ++d) _Pragma("unroll") for (int r = 0; r < 16; ++r) o[d][r] *= al_l[crow(r, hi)]; } } while (0)
#define MASKT(P0, P1, j) do { if constexpr (MASK && DBG_BREAK != 4) { if ((j) >= 4) band_mask(P0, P1, (KT(j) - 4) * KVBLK - (qpos0 + wid * QBLK + r32), hi); } } while (0)
    f32x16 pA0, pA1, pB0, pB1; float mnA, mnB, alA, alB; bf16x8 pa0, pa1, pa2, pa3;
    constexpr int SE = 0, SO = SDEPTH - 1;
    SLOAD(SE, 0); asm volatile("s_waitcnt vmcnt(0)" ::: "memory"); SWRITE(0, SE); __syncthreads();
    qkt<DQK, QSP, 0>(pA0, pA1, kb, qr, qsp); MASKT(pA0, pA1, 0); partialSM(pA0, pA1, m_reg, mnA, alA);
    SLOAD(SO, 1); if (SDEPTH == 2 && 2 < NT) SLOAD(SE, 2);
    SWAIT(); SWRITE(1, SO); __syncthreads();
    for (int j = 1; j + 1 < NT; j += 2) {
        SBAR(); qkt<DQK, QSP, SHM_K>(pB0, pB1, kb, qr, qsp); MASKT(pB0, pB1, j);
        finishSM(pA0, pA1, alA, l_reg, pa0, pa1, pa2, pa3); SBAR();
        SLOAD(SO, j + SDEPTH); SBAR();
        pv_all<DV, (DQK != 192)>(o, vb0, pa0, pa1, pa2, pa3); partialSM(pB0, pB1, m_reg, mnB, alB);
        __syncthreads(); SWAIT(); SWRITE(0, SE);
        RESC(alB); __syncthreads();
        SBAR(); qkt<DQK, QSP, 0>(pA0, pA1, kb, qr, qsp); MASKT(pA0, pA1, j + 1);
        finishSM(pB0, pB1, alB, l_reg, pa0, pa1, pa2, pa3); SBAR();
        if (SDEPTH == 1 || j + 3 < NT) SLOAD(SE, j + 1 + SDEPTH); SBAR();
        pv_all<DV, (DQK != 192)>(o, vb0 + SHM_V, pa0, pa1, pa2, pa3); partialSM(pA0, pA1, m_reg, mnA, alA);
        __syncthreads(); SWAIT(); SWRITE(1, SO);
        RESC(alA); __syncthreads();
    }
    SBAR(); qkt<DQK, QSP, SHM_K>(pB0, pB1, kb, qr, qsp); MASKT(pB0, pB1, NT - 1);
    finishSM(pA0, pA1, alA, l_reg, pa0, pa1, pa2, pa3); SBAR();
    pv_all<DV, (DQK != 192)>(o, vb0, pa0, pa1, pa2, pa3); partialSM(pB0, pB1, m_reg, mnB, alB);
    __syncthreads(); RESC(alB);
    finishSM(pB0, pB1, alB, l_reg, pa0, pa1, pa2, pa3); SBAR();
    pv_all<DV, (DQK != 192)>(o, vb0 + SHM_V, pa0, pa1, pa2, pa3);
    if (hi == 0) li_l[r32] = l_reg; asm volatile("s_waitcnt lgkmcnt(0)" ::: "memory");
    float rli[16];
#pragma unroll
    for (int r = 0; r < 16; ++r) rli[r] = __builtin_amdgcn_rcpf(li_l[crow(r, hi)]);
    if constexpr (O8) {
        unsigned char* Ow8 = (unsigned char*)Ob + (long)(wid * QBLK) * ldo;
        if constexpr (OSTAGE && DQK != 192) {
            LAS unsigned char* stg8 = (LAS unsigned char*)(lds + 2 * SHM_V + 2 * SHM_K + 2048) + wid * (QBLK * DV);
#pragma unroll
            for (int r = 0; r < 16; ++r) { const int orow = crow(r, hi);
#pragma unroll
                for (int d0 = 0; d0 < NDV; ++d0) { const float x = fminf(fmaxf(o[d0][r] * rli[r] * 64.0f, -448.f), 448.f); stg8[orow * DV + d0 * 32 + r32] = (unsigned char)(__builtin_amdgcn_cvt_pk_fp8_f32(x, x, 0, false) & 0xffu); } }
            asm volatile("s_waitcnt lgkmcnt(0)" ::: "memory");
#pragma unroll
            for (int i = 0; i < QBLK * DV / 16 / 64; ++i) { const int c = i * 64 + lane, row = c / (DV / 16), ch = c % (DV / 16);
                const u32x4 v = *(const LAS u32x4*)(stg8 + row * DV + ch * 16); *(u32x4*)(Ow8 + (long)row * ldo + ch * 16) = v; }
        } else {
#pragma unroll
            for (int r = 0; r < 16; ++r) { const int orow = crow(r, hi);
#pragma unroll
                for (int d0 = 0; d0 < NDV; ++d0) { const float x = fminf(fmaxf(o[d0][r] * rli[r] * 64.0f, -448.f), 448.f); Ow8[(long)orow * ldo + d0 * 32 + r32] = (unsigned char)(__builtin_amdgcn_cvt_pk_fp8_f32(x, x, 0, false) & 0xffu); } }
        }
    } else {
    bf16_t* Ow = Ob + (long)(wid * QBLK) * ldo;
    if constexpr (OSTAGE && DQK != 192) {
        LAS bf16_t* stg = (LAS bf16_t*)(lds + 2 * SHM_V + 2 * SHM_K + 2048) + wid * (QBLK * DV);
#pragma unroll
        for (int r = 0; r < 16; ++r) { const int orow = crow(r, hi);
#pragma unroll
            for (int d0 = 0; d0 < NDV; ++d0) stg[orow * DV + d0 * 32 + r32] = (bf16_t)(cvt_pk_bf16(o[d0][r] * rli[r], 0.f) & 0xffffu); }
        asm volatile("s_waitcnt lgkmcnt(0)" ::: "memory");
#pragma unroll
        for (int i = 0; i < QBLK * DV / 8 / 64; ++i) { const int c = i * 64 + lane, row = c / (DV / 8), ch = c % (DV / 8);
            const u32x4 v = *(const LAS u32x4*)(stg + row * DV + ch * 8); *(u32x4*)(Ow + (long)row * ldo + ch * 8) = v; }
    } else {
#pragma unroll
    for (int r = 0; r < 16; ++r) { const int orow = crow(r, hi);
#pragma unroll
        for (int d0 = 0; d0 < NDV; ++d0) Ow[(long)orow * ldo + d0 * 32 + r32] = (bf16_t)(cvt_pk_bf16(o[d0][r] * rli[r], 0.f) & 0xffffu); }
    }
    }
    __syncthreads();
#undef KT
#undef SLOAD
#undef SWRITE
#undef SWAIT
#undef RESC
#undef MASKT
}

template <int DQK, int QSP> __device__ __forceinline__ void qkt_rt(f32x16& p0, f32x16& p1, const int (&kb)[NKB<DQK>], int boff, const bf16x8 (&qr)[DQK / 16 - QSP], const LAS char* qsp) {
    p0 = f32x16{}; p1 = f32x16{};
    int kbb[NKB<DQK>];
#pragma unroll
    for (int x = 0; x < NKB<DQK>; ++x) kbb[x] = kb[x] + boff;
#pragma unroll
    for (int d0 = 0; d0 < DQK / 16; ++d0) {
        const bf16x8 b0 = *reinterpret_cast<const LAS bf16x8*>((uintptr_t)(unsigned)(KADDR(kbb, d0)));
        const bf16x8 b1 = *reinterpret_cast<const LAS bf16x8*>((uintptr_t)(unsigned)(KADDR(kbb, d0) + 32 * DQK * 2));
        bf16x8 qf;
        if constexpr (QSP > 0) { if (d0 >= DQK / 16 - QSP) qf = *reinterpret_cast<const volatile LAS bf16x8*>(qsp + (d0 - (DQK / 16 - QSP)) * 1024); else qf = qr[d0 < DQK / 16 - QSP ? d0 : 0]; }
        else qf = qr[d0];
        p0 = __builtin_amdgcn_mfma_f32_32x32x16_bf16(b0, qf, p0, 0, 0, 0);
        p1 = __builtin_amdgcn_mfma_f32_32x32x16_bf16(b1, qf, p1, 0, 0, 0); }
}
template <int DQK, int DV, bool MASK, int QSP, int ldq, int ldk, int ldv, int ldo>
__device__ __forceinline__ void attn_unit3(const bf16_t* __restrict__ Qb, const bf16_t* __restrict__ Kh, const bf16_t* __restrict__ Vh,
                                           bf16_t* __restrict__ Ob, int NT, int lo, float m_init, float l_init, int qpos0, LAS char* lds) {
    constexpr int SHM_K = KVBLK * DQK * 2, SHM_V = KVBLK * DV * 2, NKP = DQK / 64, NVP = DV / 64, ND0 = DQK / 16, NDV = DV / 32;
    const int tid = opaque_tid(), wid = tid >> 6, lane = tid & 63, r32 = lane & 31, hi = lane >> 5;
    LAS char* V_lds = lds; LAS char* K_lds = lds + 3 * SHM_V;
    LAS float* ws = (LAS float*)(lds + 3 * SHM_V + 3 * SHM_K) + wid * 64; LAS float* li_l = ws; LAS float* al_l = ws + 32;
    float m_reg = m_init, l_reg = l_init; f32x16 o[NDV]; bf16x8 qr[ND0 - QSP];
    LAS char* qsp = lds + 3 * SHM_V + 3 * SHM_K + 2048 + wid * (QSP * 1024) + lane * 16;
#pragma unroll
    for (int d = 0; d < NDV; ++d) o[d] = f32x16{};
    const bf16_t* Qw = Qb + (long)(wid * QBLK + r32) * ldq + hi * 8;
#pragma unroll
    for (int d0 = 0; d0 < ND0; ++d0) { const bf16x8 qv = *reinterpret_cast<const bf16x8*>(Qw + d0 * 16); if (d0 < ND0 - QSP) qr[d0 < ND0 - QSP ? d0 : 0] = qv; else *reinterpret_cast<LAS bf16x8*>(qsp + (d0 - (ND0 - QSP)) * 1024) = qv; }
    const int srow = tid >> 3, sc0 = (tid & 7) * 8;
    const int koff0 = srow * ldk + sc0, voff0 = srow * ldv + sc0, vst0 = (int)(uintptr_t)V_lds + v_st<DV>(srow, sc0);
    int kst[NKP];
#pragma unroll
    for (int q = 0; q < NKP; ++q) kst[q] = (int)(uintptr_t)K_lds + kswz<DQK>(srow, sc0 * 2 + 128 * q);
    const int vb0 = (int)(uintptr_t)V_lds + v_rd_base(lane);
    int kb[NKB<DQK>];
#pragma unroll
    for (int x = 0; x < NKB<DQK>; ++x) kb[x] = (int)(uintptr_t)K_lds + r32 * (DQK * 2) + ((x * 32 + hi * 16) ^ (ksw<DQK>(r32) << 4));
    bf16x8 sk[NKP], sv[NVP];
#define KT(j) ((j) < 4 ? (j) : (j) + lo)
#define SLOAD3(j) do { const int kt_ = __builtin_amdgcn_readfirstlane(KT(j)); const bf16_t* Vt_ = Vh + (long)kt_ * (KVBLK * (long)ldv); const bf16_t* Kt_ = Kh + (long)kt_ * (KVBLK * (long)ldk); \
    _Pragma("unroll") for (int q_ = 0; q_ < NVP; ++q_) sv[q_] = *reinterpret_cast<const bf16x8*>(Vt_ + voff0 + 64 * q_); \
    _Pragma("unroll") for (int q_ = 0; q_ < NKP; ++q_) sk[q_] = *reinterpret_cast<const bf16x8*>(Kt_ + koff0 + 64 * q_); } while (0)
#define SWRITE3(bi) do { \
    _Pragma("unroll") for (int q_ = 0; q_ < NVP; ++q_) *reinterpret_cast<LAS bf16x8*>((uintptr_t)(unsigned)(vst0 + (bi) * SHM_V + 1024 * q_)) = sv[q_]; \
    _Pragma("unroll") for (int q_ = 0; q_ < NKP; ++q_) *reinterpret_cast<LAS bf16x8*>((uintptr_t)(unsigned)(kst[q_] + (bi) * SHM_K)) = sk[q_]; } while (0)
#define RESC(a) do { if (__any((a) < 1.f)) { if (hi == 0) al_l[r32] = (a); asm volatile("s_waitcnt lgkmcnt(0)" ::: "memory"); \
    _Pragma("unroll") for (int d = 0; d < NDV; ++d) _Pragma("unroll") for (int r = 0; r < 16; ++r) o[d][r] *= al_l[crow(r, hi)]; } } while (0)
#define MASKT(P0, P1, j) do { if constexpr (MASK && DBG_BREAK != 4) { if ((j) >= 4) band_mask(P0, P1, (KT(j) - 4) * KVBLK - (qpos0 + wid * QBLK + r32), hi); } } while (0)
    f32x16 pA0, pA1, pB0, pB1; float mnA, mnB, alA, alB; bf16x8 pa0, pa1, pa2, pa3;
    int bp = 2, bc = 0, bn = 1;
#define ROT3() do { const int t_ = bp; bp = bc; bc = bn; bn = t_; } while (0)
#ifndef SGB
#define SGB 0
#endif
#define SGB_QK() do { if (SGB) { __builtin_amdgcn_sched_group_barrier(0x100, 2 * ND0, 0); _Pragma("unroll") for (int g_ = 0; g_ < 2 * ND0; ++g_) { __builtin_amdgcn_sched_group_barrier(0x008, 1, 0); __builtin_amdgcn_sched_group_barrier(0x002, 8, 0); } } } while (0)
#define SGB_PV() do { if (SGB) { __builtin_amdgcn_sched_group_barrier(0x100, 8, 0); \
        _Pragma("unroll") for (int g_ = 0; g_ < 4 * NDV - 4; ++g_) { __builtin_amdgcn_sched_group_barrier(0x008, 1, 0); __builtin_amdgcn_sched_group_barrier(0x100, 2, 0); __builtin_amdgcn_sched_group_barrier(0x002, 6, 0); } \
        _Pragma("unroll") for (int g_ = 0; g_ < 4; ++g_) { __builtin_amdgcn_sched_group_barrier(0x008, 1, 0); __builtin_amdgcn_sched_group_barrier(0x002, 6, 0); } } } while (0)
#define ITER(X0, X1, MNX, ALX, Y0, Y1, ALY, j) do { SBAR(); qkt_rt<DQK, QSP>(X0, X1, kb, bc * SHM_K, qr, qsp); MASKT(X0, X1, j); \
        finishSM(Y0, Y1, ALY, l_reg, pa0, pa1, pa2, pa3); SGB_QK(); SBAR(); \
        if ((j) + 1 < NT) { SWRITE3(bn); } if ((j) + 2 < NT) { SLOAD3((j) + 2); } SBAR(); \
        pv_all<DV>(o, vb0 + bp * SHM_V, pa0, pa1, pa2, pa3); partialSM(X0, X1, m_reg, MNX, ALX); SGB_PV(); SBAR(); \
        RESC(ALX); __syncthreads(); ROT3(); } while (0)
    SLOAD3(0); asm volatile("s_waitcnt vmcnt(0)" ::: "memory"); SWRITE3(0); SLOAD3(1); __syncthreads();
    qkt_rt<DQK, QSP>(pA0, pA1, kb, 0, qr, qsp); MASKT(pA0, pA1, 0); partialSM(pA0, pA1, m_reg, mnA, alA);
    SWRITE3(1); if (2 < NT) { SLOAD3(2); } __syncthreads();
    bp = 0; bc = 1; bn = 2;
    for (int j = 1; j + 1 < NT; j += 2) {
        ITER(pB0, pB1, mnB, alB, pA0, pA1, alA, j);
        ITER(pA0, pA1, mnA, alA, pB0, pB1, alB, j + 1);
    }
    ITER(pB0, pB1, mnB, alB, pA0, pA1, alA, NT - 1);
    finishSM(pB0, pB1, alB, l_reg, pa0, pa1, pa2, pa3); SBAR();
    pv_all<DV>(o, vb0 + bp * SHM_V, pa0, pa1, pa2, pa3);
    if (hi == 0) li_l[r32] = l_reg; asm volatile("s_waitcnt lgkmcnt(0)" ::: "memory");
    float rli[16];
#pragma unroll
    for (int r = 0; r < 16; ++r) rli[r] = __builtin_amdgcn_rcpf(li_l[crow(r, hi)]);
    bf16_t* Ow = Ob + (long)(wid * QBLK) * ldo;
    if constexpr (OSTAGE && DQK != 192) {
        LAS bf16_t* stg = (LAS bf16_t*)(lds + 3 * SHM_V + 3 * SHM_K + 2048) + wid * (QBLK * DV);
#pragma unroll
        for (int r = 0; r < 16; ++r) { const int orow = crow(r, hi);
#pragma unroll
            for (int d0 = 0; d0 < NDV; ++d0) stg[orow * DV + d0 * 32 + r32] = (bf16_t)(cvt_pk_bf16(o[d0][r] * rli[r], 0.f) & 0xffffu); }
        asm volatile("s_waitcnt lgkmcnt(0)" ::: "memory");
#pragma unroll
        for (int i = 0; i < QBLK * DV / 8 / 64; ++i) { const int c = i * 64 + lane, row = c / (DV / 8), ch = c % (DV / 8);
            const u32x4 v = *(const LAS u32x4*)(stg + row * DV + ch * 8); *(u32x4*)(Ow + (long)row * ldo + ch * 8) = v; }
    } else {
#pragma unroll
    for (int r = 0; r < 16; ++r) { const int orow = crow(r, hi);
#pragma unroll
        for (int d0 = 0; d0 < NDV; ++d0) Ow[(long)orow * ldo + d0 * 32 + r32] = (bf16_t)(cvt_pk_bf16(o[d0][r] * rli[r], 0.f) & 0xffffu); }
    }
    __syncthreads();
#undef KT
#undef SLOAD3
#undef SWRITE3
#undef RESC
#undef MASKT
#undef ROT3
#undef ITER
}

template <int DQK, int DV, bool MASK, int QSP, int ldq, int ldk, int ldv, int ldo>
__device__ __forceinline__ void attn_unit4(const bf16_t* __restrict__ Qb, const bf16_t* __restrict__ Kh, const bf16_t* __restrict__ Vh,
                                           bf16_t* __restrict__ Ob, int NT, int lo, float m_init, float l_init, int qpos0, LAS char* lds) {
    constexpr int SHM_K = KVBLK * DQK * 2, SHM_V = KVBLK * DV * 2, NKP = DQK / 64, NVP = DV / 64, ND0 = DQK / 16, NDV = DV / 32;
    const int tid = opaque_tid(), wid = tid >> 6, lane = tid & 63, r32 = lane & 31, hi = lane >> 5;
    LAS char* V_lds = lds; LAS char* K_lds = lds + 4 * SHM_V;
    LAS float* ws = (LAS float*)(lds + 4 * SHM_V + 4 * SHM_K) + wid * 64; LAS float* li_l = ws; LAS float* al_l = ws + 32;
    float m_reg = m_init, l_reg = l_init; f32x16 o[NDV]; bf16x8 qr[ND0 - QSP];
    LAS char* qsp = lds + 4 * SHM_V + 4 * SHM_K + 2048 + wid * (QSP * 1024) + lane * 16;
#pragma unroll
    for (int d = 0; d < NDV; ++d) o[d] = f32x16{};
    const bf16_t* Qw = Qb + (long)(wid * QBLK + r32) * ldq + hi * 8;
#pragma unroll
    for (int d0 = 0; d0 < ND0; ++d0) { const bf16x8 qv = *reinterpret_cast<const bf16x8*>(Qw + d0 * 16); if (d0 < ND0 - QSP) qr[d0 < ND0 - QSP ? d0 : 0] = qv; else *reinterpret_cast<LAS bf16x8*>(qsp + (d0 - (ND0 - QSP)) * 1024) = qv; }
    const int srow = tid >> 3, sc0 = (tid & 7) * 8;
    const int koff0 = srow * ldk + sc0, voff0 = srow * ldv + sc0, vst0 = (int)(uintptr_t)V_lds + v_st<DV>(srow, sc0);
    int kst[NKP];
#pragma unroll
    for (int q = 0; q < NKP; ++q) kst[q] = (int)(uintptr_t)K_lds + kswz<DQK>(srow, sc0 * 2 + 128 * q);
    const int vb0 = (int)(uintptr_t)V_lds + v_rd_base(lane);
    int kb[NKB<DQK>];
#pragma unroll
    for (int x = 0; x < NKB<DQK>; ++x) kb[x] = (int)(uintptr_t)K_lds + r32 * (DQK * 2) + ((x * 32 + hi * 16) ^ (ksw<DQK>(r32) << 4));
    bf16x8 sk[NKP], sv[NVP];
    bf16x8 kf[2 * ND0];
#define KT(j) ((j) < 4 ? (j) : (j) + lo)
#define SLOAD3(j) do { const int kt_ = __builtin_amdgcn_readfirstlane(KT(j)); const bf16_t* Vt_ = Vh + (long)kt_ * (KVBLK * (long)ldv); const bf16_t* Kt_ = Kh + (long)kt_ * (KVBLK * (long)ldk); \
    _Pragma("unroll") for (int q_ = 0; q_ < NVP; ++q_) sv[q_] = *reinterpret_cast<const bf16x8*>(Vt_ + voff0 + 64 * q_); \
    _Pragma("unroll") for (int q_ = 0; q_ < NKP; ++q_) sk[q_] = *reinterpret_cast<const bf16x8*>(Kt_ + koff0 + 64 * q_); } while (0)
#define SWRITE3(bi) do { \
    _Pragma("unroll") for (int q_ = 0; q_ < NVP; ++q_) *reinterpret_cast<LAS bf16x8*>((uintptr_t)(unsigned)(vst0 + (bi) * SHM_V + 1024 * q_)) = sv[q_]; \
    _Pragma("unroll") for (int q_ = 0; q_ < NKP; ++q_) *reinterpret_cast<LAS bf16x8*>((uintptr_t)(unsigned)(kst[q_] + (bi) * SHM_K)) = sk[q_]; } while (0)
#define RESC(a) do { if (__any((a) < 1.f)) { if (hi == 0) al_l[r32] = (a); asm volatile("s_waitcnt lgkmcnt(0)" ::: "memory"); \
    _Pragma("unroll") for (int d = 0; d < NDV; ++d) _Pragma("unroll") for (int r = 0; r < 16; ++r) o[d][r] *= al_l[crow(r, hi)]; } } while (0)
#define MASKT(P0, P1, j) do { if constexpr (MASK && DBG_BREAK != 4) { if ((j) >= 4) band_mask(P0, P1, (KT(j) - 4) * KVBLK - (qpos0 + wid * QBLK + r32), hi); } } while (0)
    f32x16 pA0, pA1, pB0, pB1; float mnA, mnB, alA, alB; bf16x8 pa0, pa1, pa2, pa3;
    static_assert(QSP == 0, "attn_unit4: Q fragments stay in registers");
    int bp = 0, bc = 1, bn = 2, bnn = 3;
#define ROT4() do { const int t_ = bp; bp = bc; bc = bn; bn = bnn; bnn = t_; } while (0)
#define KLOAD(bi) do { const int bo_ = (bi) * SHM_K; _Pragma("unroll") for (int d0 = 0; d0 < ND0; ++d0) { \
        kf[2 * d0] = *reinterpret_cast<const LAS bf16x8*>((uintptr_t)(unsigned)(KADDR(kb, d0) + bo_)); \
        kf[2 * d0 + 1] = *reinterpret_cast<const LAS bf16x8*>((uintptr_t)(unsigned)(KADDR(kb, d0) + bo_ + 32 * DQK * 2)); } } while (0)
#define QKREG(P0, P1) do { P0 = f32x16{}; P1 = f32x16{}; _Pragma("unroll") for (int d0 = 0; d0 < ND0; ++d0) { \
        P0 = __builtin_amdgcn_mfma_f32_32x32x16_bf16(kf[2 * d0], qr[d0], P0, 0, 0, 0); P1 = __builtin_amdgcn_mfma_f32_32x32x16_bf16(kf[2 * d0 + 1], qr[d0], P1, 0, 0, 0); } } while (0)
#define ITER(X0, X1, MNX, ALX, Y0, Y1, ALY, j) do { SBAR(); QKREG(X0, X1); MASKT(X0, X1, j); \
        finishSM(Y0, Y1, ALY, l_reg, pa0, pa1, pa2, pa3); SBAR(); \
        if ((j) + 1 < NT) { KLOAD(bn); } if ((j) + 2 < NT) { SWRITE3(bnn); } if ((j) + 3 < NT) { SLOAD3((j) + 3); } SBAR(); \
        pv_all<DV>(o, vb0 + bp * SHM_V, pa0, pa1, pa2, pa3); partialSM(X0, X1, m_reg, MNX, ALX); \
        RESC(ALX); __syncthreads(); ROT4(); } while (0)
    SLOAD3(0); asm volatile("s_waitcnt vmcnt(0)" ::: "memory"); SWRITE3(0); SLOAD3(1); asm volatile("s_waitcnt vmcnt(0)" ::: "memory"); SWRITE3(1); SLOAD3(2); __syncthreads();
    KLOAD(0); QKREG(pA0, pA1); MASKT(pA0, pA1, 0); partialSM(pA0, pA1, m_reg, mnA, alA);
    KLOAD(1); SWRITE3(2); SLOAD3(3); __syncthreads();
    for (int j = 1; j + 1 < NT; j += 2) {
        ITER(pB0, pB1, mnB, alB, pA0, pA1, alA, j);
        ITER(pA0, pA1, mnA, alA, pB0, pB1, alB, j + 1);
    }
    ITER(pB0, pB1, mnB, alB, pA0, pA1, alA, NT - 1);
    finishSM(pB0, pB1, alB, l_reg, pa0, pa1, pa2, pa3); SBAR();
    pv_all<DV>(o, vb0 + bp * SHM_V, pa0, pa1, pa2, pa3);
    if (hi == 0) li_l[r32] = l_reg; asm volatile("s_waitcnt lgkmcnt(0)" ::: "memory");
    float rli[16];
#pragma unroll
    for (int r = 0; r < 16; ++r) rli[r] = __builtin_amdgcn_rcpf(li_l[crow(r, hi)]);
    bf16_t* Ow = Ob + (long)(wid * QBLK) * ldo;
    if constexpr (OSTAGE && DQK != 192) {
        LAS bf16_t* stg = (LAS bf16_t*)(lds + 4 * SHM_V + 4 * SHM_K + 2048) + wid * (QBLK * DV);
#pragma unroll
        for (int r = 0; r < 16; ++r) { const int orow = crow(r, hi);
#pragma unroll
            for (int d0 = 0; d0 < NDV; ++d0) stg[orow * DV + d0 * 32 + r32] = (bf16_t)(cvt_pk_bf16(o[d0][r] * rli[r], 0.f) & 0xffffu); }
        asm volatile("s_waitcnt lgkmcnt(0)" ::: "memory");
#pragma unroll
        for (int i = 0; i < QBLK * DV / 8 / 64; ++i) { const int c = i * 64 + lane, row = c / (DV / 8), ch = c % (DV / 8);
            const u32x4 v = *(const LAS u32x4*)(stg + row * DV + ch * 8); *(u32x4*)(Ow + (long)row * ldo + ch * 8) = v; }
    } else {
#pragma unroll
    for (int r = 0; r < 16; ++r) { const int orow = crow(r, hi);
#pragma unroll
        for (int d0 = 0; d0 < NDV; ++d0) Ow[(long)orow * ldo + d0 * 32 + r32] = (bf16_t)(cvt_pk_bf16(o[d0][r] * rli[r], 0.f) & 0xffffu); }
    }
    __syncthreads();
#undef KT
#undef SLOAD3
#undef SWRITE3
#undef RESC
#undef MASKT
#undef ROT4
#undef KLOAD
#undef QKREG
#undef ITER
}

struct AttnP { const bf16_t* Q; const bf16_t* K; const bf16_t* V; bf16_t* O; const float* sink; };
template <int DQK, int DV, bool MASK, int SDEPTH, int QSP, int LDQ, int LDK, int LDV, int LDO, int H, int GQ, int GV, int KSTR, int VSTR, int DOCTX, bool O8 = false>
__device__ __forceinline__ void attn_phase(LAS char* lds, const AttnP& P, int G, int vcu) {
    constexpr int nheavy = 8 * H * 8, nlight = DOCTX ? 8 * H : 0;
    for (int it = vcu; it < nheavy + nlight; it += G) {
        int b, h, qb;
        if (it < nheavy) { qb = (it & 7) + 1; h = (it >> 3) % H; b = (it >> 3) / H; }
        else { const int i2 = it - nheavy; qb = 0; h = i2 % H; b = i2 / H; }
        const long r0 = (long)b * 2304;
        int NT, lo = 0;
        if (qb == 0) NT = 4;
        else if (MASK) { const int l0 = 4 * (qb - 1) - 2, h0 = 4 * (qb - 1) + 5; lo = l0 < 0 ? 0 : l0; const int hh = h0 > 31 ? 31 : h0; NT = 4 + hh - lo + 1; }
        else NT = 36;
        float m0 = -1e30f, l0f = 0.f;
        if (P.sink && DBG_BREAK != 3) { m0 = P.sink[h] * 1.4426950408889634f; l0f = 1.f; }
        if constexpr (SDEPTH == 4) attn_unit4<DQK, DV, MASK, QSP, LDQ, LDK, LDV, LDO>(P.Q + (r0 + qb * 256) * LDQ + h * DQK, P.K + r0 * LDK + (h / GQ) * KSTR, P.V + r0 * LDV + (h / GV) * VSTR,
                                 P.O + (r0 + qb * 256) * LDO + h * DV, NT, lo, m0, l0f, (qb - 1) * 256, lds);
        else if constexpr (SDEPTH == 3) attn_unit3<DQK, DV, MASK, QSP, LDQ, LDK, LDV, LDO>(P.Q + (r0 + qb * 256) * LDQ + h * DQK, P.K + r0 * LDK + (h / GQ) * KSTR, P.V + r0 * LDV + (h / GV) * VSTR,
                                 P.O + (r0 + qb * 256) * LDO + h * DV, NT, lo, m0, l0f, (qb - 1) * 256, lds);
        else attn_unit<DQK, DV, MASK, SDEPTH, QSP, LDQ, LDK, LDV, LDO, O8>(P.Q + (r0 + qb * 256) * LDQ + h * DQK, P.K + r0 * LDK + (h / GQ) * KSTR, P.V + r0 * LDV + (h / GV) * VSTR,
                                 O8 ? (bf16_t*)((unsigned char*)P.O + ((r0 + qb * 256) * LDO + h * DV)) : P.O + (r0 + qb * 256) * LDO + h * DV, NT, lo, m0, l0f, (qb - 1) * 256, lds);
    }
}
#undef SBAR
}

#ifndef DBG_BREAK
#define DBG_BREAK 0
#endif
#ifndef FUSE_QKV
#define FUSE_QKV 7
#endif
constexpr int NWAVES = 8;
constexpr int D = 1024, NB = 8, SEQ = 2048, CTXL = 256, RPB = 2304, M = NB * RPB  , MT = M / 256  , MLAT = NB * SEQ  ;
constexpr int FF = 3584, NEXP = 8, ECAP = M;
constexpr float EPS = 1e-6f, LOG2E = 1.4426950408889634f;
constexpr float SC_GQA = 0.12751743082459868f, SC_MLA = 0.10411754627697264f, SC_64 = 0.18033688011112042f;
constexpr float LAM_INIT = 0.5560582041556406f;
enum { I_X = 0, I_C, I_CTX, I_CCTX, I_ADAW, I_ADAB, I_NMIX, I_NFFN, I_GQA_WQKV, I_GQA_QG, I_GQA_KG, I_GQA_WO, I_MLA_WDOWN, I_MLA_QAG, I_MLA_KVAG, I_MLA_WUQ, I_MLA_WUKV, I_MLA_QG, I_MLA_KG, I_MLA_WO,
       I_WIN_WQKV, I_WIN_QG, I_WIN_KG, I_WIN_SINK, I_WIN_WO, I_DIFF_WQKV, I_DIFF_QG, I_DIFF_KG, I_DIFF_LAM, I_DIFF_SUBLN, I_DIFF_WO, I_FFN_W13, I_FFN_W2, I_MOE_ROUTER, I_MOE_W13, I_MOE_W2, N_IN };
constexpr size_t MiB = 1u << 20;
constexpr size_t WS_CTL = 0, CTL_ZERO_BYTES = 1 * MiB;
constexpr size_t WS_MOD = 1 * MiB;
constexpr size_t WS_R128C = 2 * MiB, WS_R128S = 2 * MiB + 512 * 1024;
constexpr size_t WS_R64C = 3 * MiB, WS_R64S = 3 * MiB + 256 * 1024;
constexpr size_t WS_TOKPOS = 4 * MiB, WS_TOKGATE = 4 * MiB + 256 * 1024;
constexpr size_t WS_WQKV0 = 8 * MiB, WS_WO0 = 11 * MiB, WS_WDOWN1 = 13 * MiB, WS_WUQ1 = 15 * MiB, WS_WUKV1 = 17 * MiB, WS_WO1 = 18 * MiB, WS_WQKV2 = 20 * MiB, WS_WO2 = 23 * MiB,
                 WS_WQKV3 = 25 * MiB, WS_WO3 = 31 * MiB, WS_WF13 = 34 * MiB, WS_WF2 = 62 * MiB, WS_WM13 = 76 * MiB, WS_WM2 = 300 * MiB;
constexpr size_t WS_XS = 412 * MiB, WS_H = 484 * MiB, WS_O2 = 520 * MiB, WS_OBUF = 556 * MiB, WS_ATT = 628 * MiB, WS_ACT = 928 * MiB, WS_Y = 1194 * MiB, WS_END = 1270 * MiB;
constexpr size_t WS_RAW = WS_ATT, WS_DN = WS_ATT, WS_CQN = WS_ATT + 32 * MiB, WS_CKVN = WS_ATT + 48 * MiB, WS_QRAW = WS_ATT + 64 * MiB, WS_KVRAW = WS_ATT + 120 * MiB, WS_KBUF = WS_ATT + 192 * MiB, WS_ASORT = WS_ATT;
constexpr int CW_BAR = 4096, CW_CNT = 8192, CW_CUR = 8448, CW_DONE = 8512;
constexpr int LDSCTL_OFF = 143360, LDS_BYTES = 147456;
constexpr int MI_BAR = 8, MI_TB = 16, MI_CNT = 32, MI_BASE = 40, MI_ENT = 64;

typedef GAS unsigned gu32;
#define RLX_AGENT __ATOMIC_RELAXED, __HIP_MEMORY_SCOPE_AGENT
#define LDS_WAIT() asm volatile("s_waitcnt lgkmcnt(0)" ::: "memory")
#define VM_WAIT() asm volatile("s_waitcnt vmcnt(0)" ::: "memory")

#define XB_TMO      128
#define XB_XCNT(j)  (256  + 64 * (j))
#define XB_XSUB(j)  (1280 + 64 * (j))
#define XB_XGEN(j)  (2304 + 64 * (j))
#define XB_TOP      3328
#define XB_TOPGEN   3392
#define XCD_BAR_WORDS 3456
#define XB_SPIN_CAP (1u << 22)
__device__ __forceinline__ unsigned xb_ld(unsigned* p)              { return __hip_atomic_load(p, __ATOMIC_RELAXED, __HIP_MEMORY_SCOPE_AGENT); }
__device__ __forceinline__ unsigned xb_add(unsigned* p, unsigned v) { return __hip_atomic_fetch_add(p, v, __ATOMIC_RELAXED, __HIP_MEMORY_SCOPE_AGENT); }
__device__ __forceinline__ unsigned xb_xcc_id() { return (unsigned)__builtin_amdgcn_s_getreg((3 << 11) | 20) & 0xFu; }
#define XB_SPIN(cond, bar) do { unsigned _sp = 0; while (cond) { __builtin_amdgcn_s_sleep(1); \
    if ((++_sp & 255u) == 0u) { if (xb_ld(&(bar)[XB_TMO])) break; if (_sp > XB_SPIN_CAP) { atomicAdd(&(bar)[XB_TMO], 1u); break; } } } } while (0)
struct XcdBarrier { unsigned* bar; unsigned x; volatile LAS unsigned* st; };
__device__ __forceinline__ XcdBarrier xcd_barrier_post(unsigned* bar, volatile LAS unsigned* st) {
    XcdBarrier b; b.bar = bar; b.x = xb_xcc_id(); b.st = st;
    if (threadIdx.x == 0) (void)xb_add(&bar[XB_XCNT(b.x)], 1u);
    return b;
}
__device__ __forceinline__ void xcd_barrier_complete(unsigned* bar, unsigned x, unsigned& nloc, unsigned& nx) {
    const unsigned G = gridDim.x * gridDim.y * gridDim.z;
    unsigned sum, cnt, mine, sp = 0u;
    for (;;) {
        sum = 0u; cnt = 0u; mine = 0u;
#pragma unroll
        for (unsigned j = 0; j < 16; ++j) { const unsigned c = xb_ld(&bar[XB_XCNT(j)]); sum += c; cnt += (c > 0u) ? 1u : 0u; mine = (j == x) ? c : mine; }
        if (sum == G) break;
        __builtin_amdgcn_s_sleep(1);
        if ((++sp & 255u) == 0u) { if (xb_ld(&bar[XB_TMO])) break; if (sp > XB_SPIN_CAP) { atomicAdd(&bar[XB_TMO], 1u); break; } }
    }
    nloc = mine > 0u ? mine : 1u; nx = cnt > 0u ? cnt : 1u;
}
__device__ __forceinline__ void xcd_barrier(const XcdBarrier& b) {
    asm volatile("s_waitcnt vmcnt(0)" ::: "memory");
    __syncthreads();
    if (threadIdx.x == 0) {
        unsigned* bar = b.bar;
        __builtin_amdgcn_s_waitcnt(0);
        unsigned nloc = b.st[0], nx = b.st[1];
        if (nloc == 0u) { xcd_barrier_complete(bar, b.x, nloc, nx); b.st[0] = nloc; b.st[1] = nx; }
        const unsigned old = xb_add(&bar[XB_XSUB(b.x)], 1u);
        const unsigned gen = old / nloc;
        if (old + 1u == (gen + 1u) * nloc) {
            __builtin_amdgcn_fence(__ATOMIC_RELEASE, "agent");
            asm volatile("s_waitcnt vmcnt(0)" ::: "memory");
            const unsigned og = xb_add(&bar[XB_TOP], 1u);
            const unsigned tg = og / nx;
            if (og + 1u == (tg + 1u) * nx) xb_add(&bar[XB_TOPGEN], 1u);
            else XB_SPIN(xb_ld(&bar[XB_TOPGEN]) == tg, bar);
            __builtin_amdgcn_fence(__ATOMIC_ACQUIRE, "agent");
            xb_add(&bar[XB_XGEN(b.x)], 1u);
            asm volatile("s_waitcnt vmcnt(0)" ::: "memory");
        } else {
            XB_SPIN(xb_ld(&bar[XB_XGEN(b.x)]) == gen, bar);
            __builtin_amdgcn_fence(__ATOMIC_ACQUIRE, "agent");
            asm volatile("s_waitcnt vmcnt(0)" ::: "memory");
        }
    }
    __syncthreads();
}

struct Params { const float* in[N_IN]; float* out; unsigned char* ws; int ph_lo, ph_hi; };
struct Frame {
    LAS unsigned char* lds; volatile LAS unsigned* MISC; gu32* ctl;
    int tid, lane, wave, vcu, G, gw, NGW;
    const float* const* in; float* out; unsigned char* ws;
};
#define WSP(T, off) ((T*)(F.ws + (off)))

__device__ __forceinline__ float wave_sum(float v) {
#pragma unroll
    for (int o = 1; o < 64; o <<= 1) v += __shfl_xor(v, o);
    return v;
}
__device__ __forceinline__ void ld8(const bf16_t* p, float (&v)[8]) { const u32x4 w = *(const u32x4*)p;
    v[0] = bf_lo(w.x); v[1] = bf_hi(w.x); v[2] = bf_lo(w.y); v[3] = bf_hi(w.y); v[4] = bf_lo(w.z); v[5] = bf_hi(w.z); v[6] = bf_lo(w.w); v[7] = bf_hi(w.w); }
__device__ __forceinline__ void st8(bf16_t* p, const float (&v)[8]) { u32x4 w; w.x = cvt_pk_bf16(v[0], v[1]); w.y = cvt_pk_bf16(v[2], v[3]); w.z = cvt_pk_bf16(v[4], v[5]); w.w = cvt_pk_bf16(v[6], v[7]); *(u32x4*)p = w; }
template <int LPG> __device__ __forceinline__ void seg_norm_rope(float (&v)[8], int lig, const float* gain, bool rope, const float* cs, const float* sn, float scale) {
    constexpr int HD = LPG * 8;
    float ss = 0.f;
#pragma unroll
    for (int i = 0; i < 8; ++i) ss += v[i] * v[i];
#pragma unroll
    for (int o = 1; o < LPG; o <<= 1) ss += __shfl_xor(ss, o);
    const float rstd = 1.0f / sqrtf(ss * (1.0f / HD) + EPS);
    const int e0 = lig * 8;
    const f32x4 g0 = *(const f32x4*)(gain + e0), g1 = *(const f32x4*)(gain + e0 + 4);
    v[0] *= rstd * g0[0]; v[1] *= rstd * g0[1]; v[2] *= rstd * g0[2]; v[3] *= rstd * g0[3]; v[4] *= rstd * g1[0]; v[5] *= rstd * g1[1]; v[6] *= rstd * g1[2]; v[7] *= rstd * g1[3];
    if (rope) {
        const bool hf = lig >= LPG / 2; const int p0 = e0 & (HD / 2 - 1);
        const f32x4 c0 = *(const f32x4*)(cs + p0), c1 = *(const f32x4*)(cs + p0 + 4), s0 = *(const f32x4*)(sn + p0), s1 = *(const f32x4*)(sn + p0 + 4);
        const float cc[8] = {c0[0], c0[1], c0[2], c0[3], c1[0], c1[1], c1[2], c1[3]}, sv[8] = {s0[0], s0[1], s0[2], s0[3], s1[0], s1[1], s1[2], s1[3]};
#pragma unroll
        for (int i = 0; i < 8; ++i) { const float py = __shfl_xor(v[i], LPG / 2); v[i] = hf ? (py * sv[i] + v[i] * cc[i]) : (v[i] * cc[i] - py * sv[i]); }
    }
#pragma unroll
    for (int i = 0; i < 8; ++i) v[i] *= scale;
}

#ifndef WO_FP8
#define WO_FP8 15
#endif
#ifndef QKV_FP8
#define QKV_FP8 15
#endif
#ifndef UPM_FP8
#define UPM_FP8 1
#endif
#ifndef CONV_KFAST
#define CONV_KFAST 1
#endif
struct TDesc { int in_idx, K, N, nmat, perm, item0; unsigned long long src_off, dst; };
#define TD_ITEMS(K, N, nmat) ((nmat) * ((K) / 64) * ((N) / 64))
constexpr int TE0 = 0, TE1 = TE0 + TD_ITEMS(1024, 1536, 1), TE2 = TE1 + TD_ITEMS(1024, 1024, 1), TE3 = TE2 + TD_ITEMS(1024, 7168, 1), TE4 = TE3 + TD_ITEMS(3584, 1024, 1),
              TE5 = TE4 + TD_ITEMS(1024, 704, 1), TE6 = TE5 + TD_ITEMS(384, 1536, 1), TE7 = TE6 + TD_ITEMS(256, 2048, 1), TE8 = TE7 + TD_ITEMS(1024, 1024, 1),
              TE9 = TE8 + TD_ITEMS(1024, 7168, 8), TE10 = TE9 + TD_ITEMS(3584, 1024, 8),
              TE11 = TE10 + TD_ITEMS(1024, 1280, 1), TE12 = TE11 + TD_ITEMS(1024, 1024, 1), TE13 = TE12 + TD_ITEMS(1024, 7168, 1), TE14 = TE13 + TD_ITEMS(3584, 1024, 1),
              TE15 = TE14 + TD_ITEMS(1024, 3072, 1), TE16 = TE15 + TD_ITEMS(1024, 1024, 1), TE17 = TE16 + TD_ITEMS(1024, 7168, 8), TI_END = TE17 + TD_ITEMS(3584, 1024, 8);
constexpr int N_TD = 18;
constexpr int TI_PRO = TE4;
constexpr int TWA = TI_PRO + 1200, TWB = TWA + 3600, TWC = TWB + 500, TWD = TWC + 12800, TWE = TWD + 600, TWF = TE10  ,
              TWG = TWF + 3000, TWH = TWG + 9000, TWI = TWH + 2400, TWJ = TWI + 3600, TWK = TWJ + 500;
static_assert(TWB > TE8 && TWE < TWF && TWG > TE12 && TWH > TE14 && TWK < TI_END, "conversion windows");
__constant__ TDesc g_td[N_TD] = {
    {I_GQA_WQKV, 1024, 1536, 1, ((FUSE_QKV & 1) ? 2 : 0) | ((QKV_FP8 & 1) ? 8 : 0), TE0, 0ull, WS_WQKV0}, {I_GQA_WO, 1024, 1024, 1, (WO_FP8 & 1) ? 8 : 0, TE1, 0ull, WS_WO0}, {I_FFN_W13, 1024, 7168, 1, 1, TE2, 0ull, WS_WF13}, {I_FFN_W2, 3584, 1024, 1, 8, TE3, 0ull, WS_WF2},
    {I_MLA_WDOWN, 1024, 704, 1, (QKV_FP8 & 2) ? 8 : 0, TE4, 0ull, WS_WDOWN1}, {I_MLA_WUQ, 384, 1536, 1, 0, TE5, 0ull, WS_WUQ1}, {I_MLA_WUKV, 256, 2048, 1, 0, TE6, 0ull, WS_WUKV1}, {I_MLA_WO, 1024, 1024, 1, (WO_FP8 & 2) ? 8 : 0, TE7, 0ull, WS_WO1},
    {I_MOE_W13, 1024, 7168, 8, UPM_FP8 ? 9 : 1, TE8, 0ull, WS_WM13}, {I_MOE_W2, 3584, 1024, 8, 8, TE9, 0ull, WS_WM2},
    {I_WIN_WQKV, 1024, 1280, 1, ((FUSE_QKV & 2) ? 3 : 0) | ((QKV_FP8 & 4) ? 8 : 0), TE10, 0ull, WS_WQKV2}, {I_WIN_WO, 1024, 1024, 1, (WO_FP8 & 4) ? 8 : 0, TE11, 0ull, WS_WO2},
    {I_FFN_W13, 1024, 7168, 1, 1, TE12, (unsigned long long)1024 * 7168, WS_WF13 + (size_t)7168 * 1024 * 2}, {I_FFN_W2, 3584, 1024, 1, 8, TE13, (unsigned long long)3584 * 1024, WS_WF2 + (size_t)1024 * 3584},
    {I_DIFF_WQKV, 1024, 3072, 1, ((FUSE_QKV & 4) ? 4 : 0) | ((QKV_FP8 & 8) ? 8 : 0), TE14, 0ull, WS_WQKV3}, {I_DIFF_WO, 1024, 1024, 1, (WO_FP8 & 8) ? 8 : 0, TE15, 0ull, WS_WO3},
    {I_MOE_W13, 1024, 7168, 8, UPM_FP8 ? 9 : 1, TE16, (unsigned long long)8 * 1024 * 7168, WS_WM13 + (size_t)8 * 7168 * 1024 * (UPM_FP8 ? 1 : 2)}, {I_MOE_W2, 3584, 1024, 8, 8, TE17, (unsigned long long)8 * 3584 * 1024, WS_WM2 + (size_t)8 * 1024 * 3584} };

__device__ __forceinline__ void p0_transpose_item(const float* W, int K, int N, int perm, bf16_t* WT, LAS float* scr, int kb, int nb, int lane) {
    const int k0 = 64 * kb, n0 = 64 * nb;
    const float* wp = W + (size_t)(k0 + (lane >> 4)) * N + n0 + (lane & 15) * 4;
    f32x4 x[16];
#pragma unroll
    for (int i = 0; i < 16; ++i) x[i] = __builtin_nontemporal_load((const f32x4*)(wp + (size_t)(4 * i) * N));
    LAS float* s0 = scr + (lane >> 4) * 65 + (lane & 15) * 4;
#pragma unroll
    for (int i = 0; i < 16; ++i) { LAS float* s = s0 + (4 * i) * 65; s[0] = x[i][0]; s[1] = x[i][1]; s[2] = x[i][2]; s[3] = x[i][3]; }
    LDS_WAIT(); asm volatile("" ::: "memory");
    const int c = lane & 7;
    const int rmap = perm & 7;
#pragma unroll 2
    for (int j = 0; j < 8; ++j) { const int n = (lane >> 3) + 8 * j; const LAS float* s = scr + (8 * c) * 65 + n;
        int nn = n0 + n;
        float ws = 1.0f;
        if (rmap == 1) { const int half = nn >= FF ? 1 : 0; nn -= half * FF; nn = (nn >> 7) * 256 + half * 128 + (nn & 127); ws = half ? pg8::SW_U : pg8::SW_G; }
        else if (rmap >= 2) { const int hd = rmap == 2 ? 128 : 64, lim = rmap == 2 ? 1280 : (rmap == 3 ? 1152 : 2048);
            if (nn < lim) { const int h = nn / hd, d = nn - h * hd; nn = h * hd + (d < hd / 2 ? 2 * d : 2 * (d - hd / 2) + 1); } }
        if (perm & 8) { float v[8];
#pragma unroll
            for (int q = 0; q < 8; ++q) v[q] = fminf(fmaxf(F8_W_MUL * ws * s[q * 65], -448.f), 448.f);
            u32x2 o; o.x = pk4_fp8(v[0], v[1], v[2], v[3]); o.y = pk4_fp8(v[4], v[5], v[6], v[7]);
            __builtin_nontemporal_store(o, (u32x2*)((unsigned char*)WT + (size_t)nn * K + k0 + 8 * c)); }
        else { u32x4 o; o.x = cvt_pk_bf16(ws * s[0 * 65], ws * s[1 * 65]); o.y = cvt_pk_bf16(ws * s[2 * 65], ws * s[3 * 65]); o.z = cvt_pk_bf16(ws * s[4 * 65], ws * s[5 * 65]); o.w = cvt_pk_bf16(ws * s[6 * 65], ws * s[7 * 65]);
            __builtin_nontemporal_store(o, (u32x4*)(WT + (size_t)nn * K + k0 + 8 * c)); } }
    LDS_WAIT(); asm volatile("" ::: "memory");
}
__device__ __forceinline__ void sincos_d(double a, double& s, double& c) {
    const double TWO_PI = 6.283185307179586476925286766559, INV_TWO_PI = 0.15915494309189533576888376337251;
    const double n = __builtin_rint(a * INV_TWO_PI); const double r = a - n * TWO_PI, r2 = r * r;
    double ts = 1.0, tc = 1.0;
#pragma unroll
    for (int k = 15; k >= 1; --k) { ts = 1.0 - ts * r2 / (double)((2 * k) * (2 * k + 1)); tc = 1.0 - tc * r2 / (double)((2 * k - 1) * (2 * k)); }
    s = r * ts; c = tc;
}
__device__ __forceinline__ void convert_one(const Frame& F, int it) {
    LAS float* scr = (LAS float*)(F.lds + F.wave * 16640);
    int d = 0;
#pragma unroll
    for (int k = 1; k < N_TD; ++k) d += (it >= g_td[k].item0) ? 1 : 0;
    const int K = g_td[d].K, N = g_td[d].N, perm = g_td[d].perm; int r = it - g_td[d].item0;
    const int nblk = N / 64, kblk = K / 64, per = kblk * nblk, mat = r / per; r -= mat * per;
#if CONV_KFAST
    const int nb = r / kblk, kb = r - nb * kblk;
#else
    const int kb = r / nblk, nb = r - kb * nblk;
#endif
    const float* W = F.in[g_td[d].in_idx] + g_td[d].src_off + (size_t)mat * K * N; bf16_t* WT = (bf16_t*)(F.ws + g_td[d].dst + (size_t)mat * K * N * ((perm & 8) ? 1 : 2));
    p0_transpose_item(W, K, N, perm, WT, scr, kb, nb, F.lane);
}
__device__ __forceinline__ void convert_items(const Frame& F, int lo, int hi, int rank, int nworkers) {
    for (int it = lo + rank * NWAVES + F.wave; it < hi; it += nworkers * NWAVES) convert_one(F, it);
}
__device__ __forceinline__ int convert_claim(const Frame& F) {
    unsigned v = 0u; if (F.lane == 0) v = __hip_atomic_fetch_add(F.ctl + CW_CUR, 2u, RLX_AGENT);
    return TI_PRO + (int)__builtin_amdgcn_readfirstlane(v);
}
__device__ __forceinline__ void tail_convert(const Frame& F, int rem, int phase) {
    if (rem == 0) return;
    gu32* done = F.ctl + CW_DONE + 64 * phase;
    if (F.vcu < rem) { if (F.tid == 0) __hip_atomic_fetch_add(done, 1u, RLX_AGENT); return; }
    for (;;) {
        const int it = convert_claim(F);
        if (it >= TI_END) break;
        const unsigned dn = __hip_atomic_load(done, RLX_AGENT);
        convert_one(F, it); if (it + 1 < TI_END) convert_one(F, it + 1);
        if ((int)__builtin_amdgcn_readfirstlane(dn) >= rem) break;
    }
}
__device__ __forceinline__ void convert_catch_up(const Frame& F, int need) {
    for (;;) {
        if ((int)__builtin_amdgcn_readfirstlane(__hip_atomic_load(F.ctl + CW_CUR, RLX_AGENT)) + TI_PRO >= need) break;
        const int it = convert_claim(F);
        if (it >= TI_END) break;
        convert_one(F, it); if (it + 1 < TI_END) convert_one(F, it + 1);
    }
}
__device__ __forceinline__ void mod_tasks(const Frame& F, int tlo, int thi, int rank, int nworkers) {
    LAS float* sl = (LAS float*)F.lds;
    LAS float* red = (LAS float*)(F.lds + 40960);
    if (tlo + rank >= thi) return;
    for (int i = F.tid; i < 9 * 1024; i += NWAVES * 64) { const float cv = (i < 8192) ? F.in[I_C][i] : F.in[I_CCTX][i - 8192]; sl[i] = cv / (1.0f + __expf(-cv)); }
    __syncthreads();
    for (int task = tlo + rank; task < thi; task += nworkers) {
        const int li = task / 96, cg = task % 96, col = cg * 64 + F.lane;
        const float* wp = F.in[I_ADAW] + ((size_t)li * 1024 + F.wave * 128) * 6144 + col;
        float acc[9];
#pragma unroll
        for (int r = 0; r < 9; ++r) acc[r] = 0.f;
        for (int k0 = 0; k0 < 128; k0 += 32) { float wv[32];
#pragma unroll
            for (int k = 0; k < 32; ++k) wv[k] = __builtin_nontemporal_load(wp + (size_t)(k0 + k) * 6144);
#pragma unroll
            for (int k = 0; k < 32; ++k)
#pragma unroll
                for (int r = 0; r < 9; ++r) acc[r] += sl[r * 1024 + F.wave * 128 + k0 + k] * wv[k]; }
#pragma unroll
        for (int r = 0; r < 9; ++r) red[(F.wave * 9 + r) * 64 + F.lane] = acc[r];
        __syncthreads();
        for (int idx = F.tid; idx < 576; idx += NWAVES * 64) { float s = 0.f;
#pragma unroll
            for (int w = 0; w < 8; ++w) s += red[w * 576 + idx];
            const int r = idx >> 6, cc = cg * 64 + (idx & 63);
            WSP(float, WS_MOD)[((size_t)li * 9 + r) * 6144 + cc] = s + F.in[I_ADAB][li * 6144 + cc]; }
        __syncthreads();
    }
}
__device__ __forceinline__ void p0_prologue(const Frame& F) {
    mod_tasks(F, 0, 384, F.vcu, F.G);
    for (int idx = blockIdx.x * (NWAVES * 64) + F.tid; idx < 2048 * 96; idx += F.G * NWAVES * 64) {
        int t, p, Q; float *co, *so;
        if (idx < 2048 * 64) { t = idx >> 6; p = idx & 63; Q = 32; co = WSP(float, WS_R128C) + idx; so = WSP(float, WS_R128S) + idx; }
        else { const int i2 = idx - 2048 * 64; t = i2 >> 5; p = i2 & 31; Q = 16; co = WSP(float, WS_R64C) + i2; so = WSP(float, WS_R64S) + i2; }
        const int pos = p < Q ? (t >> 6) : (t & 63), kf = p < Q ? p : p - Q;
        const float inv = (float)exp2(-(double)kf / (double)Q * 13.287712379549449);
        const float ang = (float)pos * inv;
        double s, c; sincos_d((double)ang, s, c); *co = (float)c; *so = (float)s;
    }
    for (int idx = blockIdx.x * (NWAVES * 64) + F.tid; idx < 64 * 1024 / 8; idx += F.G * NWAVES * 64) *(u32x4*)(WSP(bf16_t, WS_WDOWN1) + (size_t)704 * 1024 + (size_t)idx * 8) = (u32x4){0u, 0u, 0u, 0u};
    __syncthreads();
    convert_items(F, 0, TI_PRO, F.vcu, F.G);
}

struct RowCtx { int R, b, j, isctx, mr; };
__device__ __forceinline__ RowCtx row_ctx(int idx, bool latent_only) { RowCtx c; c.R = latent_only ? (idx >> 11) * RPB + CTXL + (idx & 2047) : idx; c.b = c.R / RPB; c.j = c.R - c.b * RPB; c.isctx = c.j < CTXL; c.mr = c.isctx ? 8 : c.b; return c; }
__device__ __forceinline__ void norm_row(const Frame& F, const RowCtx& rc, int layer, int which, int src_mode, f32x4 (&v)[4]) {
    const int lane = F.lane;
    f16_t* xs = WSP(f16_t, WS_XS) + (size_t)rc.R * D;
    if (src_mode == 0) { const float* src = rc.isctx ? F.in[I_CTX] + ((size_t)rc.b * CTXL + rc.j) * D : F.in[I_X] + ((size_t)rc.b * SEQ + rc.j - CTXL) * D;
#pragma unroll
        for (int jj = 0; jj < 4; ++jj) v[jj] = *((const f32x4*)src + lane + 64 * jj); }
    else {
#pragma unroll
        for (int jj = 0; jj < 4; ++jj) v[jj] = __builtin_convertvector(*((const f16x4*)xs + lane + 64 * jj), f32x4); }
    if (src_mode == 2) {
        const LAS int* tb = (const LAS int*)(F.MISC + MI_TB);
        const int p0 = WSP(int, WS_TOKPOS)[rc.R * 2], p1 = WSP(int, WS_TOKPOS)[rc.R * 2 + 1]; const float g0 = WSP(float, WS_TOKGATE)[rc.R * 2], g1 = WSP(float, WS_TOKGATE)[rc.R * 2 + 1];
        const int e0 = p0 / ECAP, e1 = p1 / ECAP; const size_t r0 = (size_t)tb[e0] * 256 + (p0 - e0 * ECAP), r1 = (size_t)tb[e1] * 256 + (p1 - e1 * ECAP);
        const bf16_t* y0 = WSP(bf16_t, WS_Y) + r0 * D; const bf16_t* y1 = WSP(bf16_t, WS_Y) + r1 * D;
        const float* gf = WSP(float, WS_MOD) + ((size_t)(layer - 1) * 9 + rc.mr) * 6144 + 5 * 1024;
#pragma unroll
        for (int jj = 0; jj < 4; ++jj) { const int col = 4 * lane + 256 * jj; const u32x2 a = *(const u32x2*)(y0 + col), bq = *(const u32x2*)(y1 + col); const f32x4 g = *(const f32x4*)(gf + col);
            v[jj][0] += g[0] * (g0 * bf_lo(a.x) + g1 * bf_lo(bq.x)); v[jj][1] += g[1] * (g0 * bf_hi(a.x) + g1 * bf_hi(bq.x));
            v[jj][2] += g[2] * (g0 * bf_lo(a.y) + g1 * bf_lo(bq.y)); v[jj][3] += g[3] * (g0 * bf_hi(a.y) + g1 * bf_hi(bq.y)); }
    }
    if (src_mode != 1) {
#pragma unroll
        for (int jj = 0; jj < 4; ++jj) *((f16x4*)xs + lane + 64 * jj) = __builtin_convertvector(v[jj], f16x4);
    }
    float ss = 0.f;
#pragma unroll
    for (int jj = 0; jj < 4; ++jj) ss += (v[jj][0] * v[jj][0] + v[jj][1] * v[jj][1]) + (v[jj][2] * v[jj][2] + v[jj][3] * v[jj][3]);
    const float rstd = 1.0f / sqrtf(wave_sum(ss) * (1.0f / D) + EPS);
    const float* gn = F.in[which ? I_NFFN : I_NMIX] + layer * D;
    const float* md = WSP(float, WS_MOD) + ((size_t)layer * 9 + rc.mr) * 6144 + (which ? 3 : 0) * 1024;
#pragma unroll
    for (int jj = 0; jj < 4; ++jj) { const int col = 4 * lane + 256 * jj; const f32x4 g = *(const f32x4*)(gn + col), sh = *(const f32x4*)(md + col), sc = *(const f32x4*)(md + 1024 + col);
        v[jj] = v[jj] * rstd * g * (sc + 1.0f) + sh; }
}
__device__ __forceinline__ void store_row_bf16(bf16_t* dst, const f32x4 (&v)[4], int lane) {
#pragma unroll
    for (int jj = 0; jj < 4; ++jj) { u32x2 w; w.x = cvt_pk_bf16(v[jj][0], v[jj][1]); w.y = cvt_pk_bf16(v[jj][2], v[jj][3]); *((u32x2*)dst + lane + 64 * jj) = w; }
}
__device__ __forceinline__ void store_row_fp8(unsigned char* dst, const f32x4 (&v)[4], int lane) {
#pragma unroll
    for (int jj = 0; jj < 4; ++jj) { float c[4];
#pragma unroll
        for (int i = 0; i < 4; ++i) c[i] = fminf(fmaxf(F8_ACT_MUL * v[jj][i], -448.f), 448.f);
        *((unsigned*)dst + lane + 64 * jj) = pk4_fp8(c[0], c[1], c[2], c[3]); }
}
__device__ __forceinline__ void moe_tile_base(const Frame& F, int j) {
    if (F.tid == 0) { int acc = 0;
        for (int e = 0; e < NEXP; ++e) { F.MISC[MI_TB + e] = (unsigned)acc; acc += (int)((__hip_atomic_load(F.ctl + CW_CNT + 64 * j + e, RLX_AGENT) + 255u) >> 8); }
        F.MISC[MI_TB + 8] = (unsigned)acc; }
    __syncthreads();
}
__device__ __forceinline__ void norm_phase_dense(const Frame& F, int layer, int which, int src_mode, bool latent_only, bool fp8out = false) {
    const int nrows = latent_only ? MLAT : M;
    for (int idx = F.gw; idx < nrows; idx += F.NGW) { const RowCtx rc = row_ctx(idx, latent_only); f32x4 v[4]; norm_row(F, rc, layer, which, src_mode, v);
        if (fp8out) store_row_fp8(WSP(unsigned char, WS_H) + (size_t)rc.R * D, v, F.lane); else store_row_bf16(WSP(bf16_t, WS_H) + (size_t)rc.R * D, v, F.lane); }
}
__device__ __forceinline__ void norm_phase_moe(const Frame& F, int layer, int j, bool latent_only) {
    LAS float* rt = (LAS float*)F.lds;
    const float* rw = F.in[I_MOE_ROUTER] + (size_t)j * D * NEXP;
    for (int i = F.tid; i < D * NEXP; i += NWAVES * 64) rt[(i & 7) * D + (i >> 3)] = rw[i];
    if (F.tid < 8) F.MISC[MI_CNT + F.tid] = 0u;
    __syncthreads();
    const int nrows = latent_only ? MLAT : M; const int lane = F.lane;
    constexpr int RC = 8;
    f32x4 vs[RC][4];
#define MOE_ROUTE(V, KK, RCX) do { float lg[NEXP]; \
        _Pragma("unroll") for (int e = 0; e < NEXP; ++e) { float s_ = 0.f; \
            _Pragma("unroll") for (int jj = 0; jj < 4; ++jj) { const f32x4 r4 = *(const LAS f32x4*)(rt + e * D + 4 * lane + 256 * jj); s_ += (V[jj][0] * r4[0] + V[jj][1] * r4[1]) + (V[jj][2] * r4[2] + V[jj][3] * r4[3]); } \
            lg[e] = wave_sum(s_); } \
        float b1 = lg[0]; int i1 = 0; \
        _Pragma("unroll") for (int e = 1; e < NEXP; ++e) if (lg[e] > b1) { b1 = lg[e]; i1 = e; } \
        float b2 = -3.0e38f; int i2 = 0; \
        _Pragma("unroll") for (int e = 0; e < NEXP; ++e) if (e != i1 && lg[e] > b2) { b2 = lg[e]; i2 = e; } \
        const float g1 = 1.0f / (1.0f + __expf(b2 - b1)), g2 = 1.0f - g1; \
        if (lane == 0) { \
            const unsigned r1 = __hip_atomic_fetch_add((LAS unsigned*)(F.MISC + MI_CNT + i1), 1u, __ATOMIC_RELAXED, __HIP_MEMORY_SCOPE_WORKGROUP); \
            const unsigned r2 = __hip_atomic_fetch_add((LAS unsigned*)(F.MISC + MI_CNT + i2), 1u, __ATOMIC_RELAXED, __HIP_MEMORY_SCOPE_WORKGROUP); \
            volatile LAS unsigned* ent = F.MISC + MI_ENT + (F.wave * 16 + (KK)) * 4; ent[0] = (unsigned)i1; ent[1] = r1; ent[2] = (unsigned)i2; ent[3] = r2; \
            WSP(float, WS_TOKGATE)[(RCX).R * 2] = g1; WSP(float, WS_TOKGATE)[(RCX).R * 2 + 1] = g2; } } while (0)
#pragma unroll
    for (int k = 0; k < RC; ++k) { const int idx = F.gw + k * F.NGW;
        if (idx < nrows) { const RowCtx rc = row_ctx(idx, latent_only); norm_row(F, rc, layer, 1, 1, vs[k]); MOE_ROUTE(vs[k], k, rc); } }
    for (int k = RC, idx = F.gw + RC * F.NGW; idx < nrows; idx += F.NGW, ++k) {
        const RowCtx rc = row_ctx(idx, latent_only); f32x4 v[4]; norm_row(F, rc, layer, 1, 1, v); MOE_ROUTE(v, k, rc); }
#undef MOE_ROUTE
    LDS_WAIT(); __syncthreads();
    if (F.tid < 8) F.MISC[MI_BASE + F.tid] = __hip_atomic_fetch_add(F.ctl + CW_CNT + 64 * j + F.tid, F.MISC[MI_CNT + F.tid], RLX_AGENT);
    __syncthreads();
#define MOE_SCATTER(V, KK, RCX) do { volatile LAS unsigned* ent = F.MISC + MI_ENT + (F.wave * 16 + (KK)) * 4; \
        const int i1 = (int)ent[0], i2 = (int)ent[2]; const int q1 = i1 * ECAP + (int)(F.MISC[MI_BASE + i1] + ent[1]), q2 = i2 * ECAP + (int)(F.MISC[MI_BASE + i2] + ent[3]); \
        if (UPM_FP8) { store_row_fp8(WSP(unsigned char, WS_ASORT) + (size_t)q1 * D, V, lane); store_row_fp8(WSP(unsigned char, WS_ASORT) + (size_t)q2 * D, V, lane); } \
        else { store_row_bf16(WSP(bf16_t, WS_ASORT) + (size_t)q1 * D, V, lane); store_row_bf16(WSP(bf16_t, WS_ASORT) + (size_t)q2 * D, V, lane); } \
        if (lane == 0) { WSP(int, WS_TOKPOS)[(RCX).R * 2] = q1; WSP(int, WS_TOKPOS)[(RCX).R * 2 + 1] = q2; } } while (0)
#pragma unroll
    for (int k = 0; k < RC; ++k) { const int idx = F.gw + k * F.NGW;
        if (idx < nrows) { const RowCtx rc = row_ctx(idx, latent_only); MOE_SCATTER(vs[k], k, rc); } }
    for (int k = RC, idx = F.gw + RC * F.NGW; idx < nrows; idx += F.NGW, ++k) {
        const RowCtx rc = row_ctx(idx, latent_only); f32x4 v[4]; norm_row(F, rc, layer, 1, 1, v); MOE_SCATTER(v, k, rc); }
#undef MOE_SCATTER
}
#ifndef OVF_SPLIT
#define OVF_SPLIT 1
#endif
__device__ __forceinline__ void final_phase(const Frame& F, int layer) {
    const LAS int* tb = (const LAS int*)(F.MISC + MI_TB); const int lane = F.lane;
    const int nt = tb[8], nun = nt * 4, lmain = (nun / F.G) * F.G, remu = nun - lmain; const bool ovon = OVF_SPLIT && remu > 0 && remu <= 128;
    const float* slab = WSP(float, WS_ASORT);
    for (int idx = F.gw; idx < MLAT; idx += F.NGW) {
        const RowCtx rc = row_ctx(idx, true);
        const f16_t* xs = WSP(f16_t, WS_XS) + (size_t)rc.R * D; float* o = F.out + (size_t)idx * D;
        const int p0 = WSP(int, WS_TOKPOS)[rc.R * 2], p1 = WSP(int, WS_TOKPOS)[rc.R * 2 + 1]; const float g0 = WSP(float, WS_TOKGATE)[rc.R * 2], g1 = WSP(float, WS_TOKGATE)[rc.R * 2 + 1];
        const int e0 = p0 / ECAP, e1 = p1 / ECAP; const int r0 = tb[e0] * 256 + (p0 - e0 * ECAP), r1 = tb[e1] * 256 + (p1 - e1 * ECAP);
        const float* gf = WSP(float, WS_MOD) + ((size_t)layer * 9 + rc.mr) * 6144 + 5 * 1024;
#pragma unroll
        for (int jj = 0; jj < 4; ++jj) { const int col = 4 * lane + 256 * jj; f32x4 x = __builtin_convertvector(*(const f16x4*)(xs + col), f32x4); const f32x4 g = *(const f32x4*)(gf + col);
            f32x4 ya, yb;
#pragma unroll
            for (int w = 0; w < 2; ++w) { const int r = w ? r1 : r0; const int t = r >> 8, gid = t >> 3, fm = gid * 8, gsz = (nt - fm) < 8 ? (nt - fm) : 8, L = gid * 32 + jj * gsz + (t - fm);
                f32x4 y;
                if (ovon && L >= lmain) { const float* sp = slab + (size_t)(L - lmain) * 65536 + (size_t)(r & 255) * 256 + 4 * lane; y = *(const f32x4*)sp;
#pragma unroll
                    for (int ks = 1; ks < 7; ++ks) y += *(const f32x4*)(sp + (size_t)ks * 128 * 65536); }
                else { const u32x2 a = *(const u32x2*)(WSP(bf16_t, WS_Y) + (size_t)r * D + col); y = (f32x4){bf_lo(a.x), bf_hi(a.x), bf_lo(a.y), bf_hi(a.y)}; }
                if (w) yb = y; else ya = y; }
            x += g * (ya * g0 + yb * g1);
            *(f32x4*)(o + col) = x; }
    }
}

template <int LPG> __device__ __forceinline__ void qk_pass(const Frame& F, bf16_t* raw, int ld, int NQ, int NK, const float* qg, const float* kg, float qscale, const float* rc_, const float* rs_) {
    constexpr int HD = LPG * 8; const int nel = (NQ + NK) * HD; const int lane = F.lane, lig = lane & (LPG - 1);
    for (int R = F.gw; R < M; R += F.NGW) {
        const int j = R % RPB; const bool rope = (j >= CTXL) && !((DBG_BREAK == 1 && LPG == 16) || (DBG_BREAK == 2 && LPG == 8)); const int pos = rope ? j - CTXL : 0;
        const float* cs = rc_ + (size_t)pos * (HD / 2); const float* sn = rs_ + (size_t)pos * (HD / 2);
        bf16_t* rowp = raw + (size_t)R * ld;
        for (int c0 = 0; c0 < nel; c0 += 512) {
            const int col = c0 + 8 * lane; const bool act = col < nel; const int seg = col / HD; const bool isq = seg < NQ;
            float v[8];
            if (act) ld8(rowp + col, v); else {
#pragma unroll
                for (int i = 0; i < 8; ++i) v[i] = 0.f; }
            seg_norm_rope<LPG>(v, lig, isq ? qg : kg, rope, cs, sn, isq ? qscale : 1.0f);
            if (act) st8(rowp + col, v);
        }
    }
}
__device__ __forceinline__ void mla_pb2(const Frame& F) {
    const int lane = F.lane;
    const bf16_t* dn = WSP(bf16_t, WS_DN); bf16_t* cqn = WSP(bf16_t, WS_CQN); bf16_t* ckvn = WSP(bf16_t, WS_CKVN); bf16_t* kbuf = WSP(bf16_t, WS_KBUF);
    for (int R = F.gw; R < M; R += F.NGW) {
        const int j = R % RPB; const bool rope = (j >= CTXL) && (DBG_BREAK != 6); const int pos = rope ? j - CTXL : 0;
        const bf16_t* rowp = dn + (size_t)R * 768; float v[8];
        {
            const bool act = lane < 48; if (act) ld8(rowp + 8 * lane, v); else {
#pragma unroll
                for (int i = 0; i < 8; ++i) v[i] = 0.f; }
            float ss = 0.f;
#pragma unroll
            for (int i = 0; i < 8; ++i) ss += v[i] * v[i];
            const float rstd = 1.0f / sqrtf(wave_sum(ss) * (1.0f / 384.0f) + EPS);
            if (act) { const float* g = F.in[I_MLA_QAG] + 8 * lane;
#pragma unroll
                for (int i = 0; i < 8; ++i) v[i] *= rstd * g[i];
                st8(cqn + (size_t)R * 384 + 8 * lane, v); }
        }
        {
            const bool act = lane < 32; if (act) ld8(rowp + 384 + 8 * lane, v); else {
#pragma unroll
                for (int i = 0; i < 8; ++i) v[i] = 0.f; }
            float ss = 0.f;
#pragma unroll
            for (int i = 0; i < 8; ++i) ss += v[i] * v[i];
            const float rstd = 1.0f / sqrtf(wave_sum(ss) * (1.0f / 256.0f) + EPS);
            if (act) { const float* g = F.in[I_MLA_KVAG] + 8 * lane;
#pragma unroll
                for (int i = 0; i < 8; ++i) v[i] *= rstd * g[i];
                st8(ckvn + (size_t)R * 256 + 8 * lane, v); }
        }
        {
            const bool act = lane < 8; if (act) ld8(rowp + 640 + 8 * lane, v); else {
#pragma unroll
                for (int i = 0; i < 8; ++i) v[i] = 0.f; }
            seg_norm_rope<8>(v, lane & 7, F.in[I_MLA_KG] + 128, rope, WSP(float, WS_R64C) + (size_t)pos * 32, WSP(float, WS_R64S) + (size_t)pos * 32, 1.0f);
            if (act) {
#pragma unroll
                for (int h = 0; h < 8; ++h) st8(kbuf + (size_t)R * 1536 + h * 192 + 128 + 8 * lane, v); }
        }
    }
}
__device__ __forceinline__ void mla_pc(const Frame& F) {
    const int lane = F.lane;
    bf16_t* qraw = WSP(bf16_t, WS_QRAW); const bf16_t* kvraw = WSP(bf16_t, WS_KVRAW); bf16_t* kbuf = WSP(bf16_t, WS_KBUF);
    for (int R = F.gw; R < M; R += F.NGW) {
        const int j = R % RPB; const bool rope = (j >= CTXL) && (DBG_BREAK != 6); const int pos = rope ? j - CTXL : 0; float v[8];
#pragma unroll
        for (int p = 0; p < 2; ++p) { const int head = 4 * p + (lane >> 4), e0 = 8 * (lane & 15);
            bf16_t* q = qraw + (size_t)R * 1536 + head * 192 + e0; ld8(q, v);
            seg_norm_rope<16>(v, lane & 15, F.in[I_MLA_QG], false, nullptr, nullptr, SC_MLA); st8(q, v);
            ld8(kvraw + (size_t)R * 2048 + head * 256 + e0, v);
            seg_norm_rope<16>(v, lane & 15, F.in[I_MLA_KG], false, nullptr, nullptr, 1.0f); st8(kbuf + (size_t)R * 1536 + head * 192 + e0, v); }
        { const int head = lane >> 3, e0 = 8 * (lane & 7);
            bf16_t* q = qraw + (size_t)R * 1536 + head * 192 + 128 + e0; ld8(q, v);
            seg_norm_rope<8>(v, lane & 7, F.in[I_MLA_QG] + 128, rope, WSP(float, WS_R64C) + (size_t)pos * 32, WSP(float, WS_R64S) + (size_t)pos * 32, SC_MLA); st8(q, v); }
    }
}
__device__ __forceinline__ void diff_combine(const Frame& F) {
    const int lane = F.lane; const float* lp = F.in[I_DIFF_LAM];
    const float lam = (DBG_BREAK == 5) ? LAM_INIT : __expf(wave_sum(lp[lane] * lp[64 + lane])) - __expf(wave_sum(lp[128 + lane] * lp[192 + lane])) + LAM_INIT;
    const bf16_t* ob = WSP(bf16_t, WS_OBUF); bf16_t* o2 = WSP(bf16_t, WS_O2);
    for (int idx = F.gw; idx < MLAT; idx += F.NGW) {
        const int R = (idx >> 11) * RPB + CTXL + (idx & 2047);
#pragma unroll
        for (int p = 0; p < 2; ++p) { const int head = 4 * p + (lane >> 4), e0 = 8 * (lane & 15); float a[8], b[8];
            ld8(ob + (size_t)R * 2048 + (2 * head) * 128 + e0, a); ld8(ob + (size_t)R * 2048 + (2 * head + 1) * 128 + e0, b);
#pragma unroll
            for (int i = 0; i < 8; ++i) a[i] -= lam * b[i];
            seg_norm_rope<16>(a, lane & 15, F.in[I_DIFF_SUBLN], false, nullptr, nullptr, 1.0f - LAM_INIT);
            if (WO_FP8 & 8) { float c[8];
#pragma unroll
                for (int i = 0; i < 8; ++i) c[i] = fminf(fmaxf(F8_W_MUL * a[i], -448.f), 448.f);
                u32x2 w; w.x = pk4_fp8(c[0], c[1], c[2], c[3]); w.y = pk4_fp8(c[4], c[5], c[6], c[7]); *(u32x2*)((unsigned char*)o2 + (size_t)R * D + head * 128 + e0) = w; }
            else st8(o2 + (size_t)R * D + head * 128 + e0, a); }
    }
}

#ifndef MK_MULTI
#define MK_MULTI 0
#endif
constexpr int NPH = 37;
#ifndef DOWN_FP8
#define DOWN_FP8 1
#endif
#ifndef OVF_SPLIT
#define OVF_SPLIT 1
#endif
#ifndef FUSE_QKV
#define FUSE_QKV 7
#endif
#ifndef ATT0_SD
#define ATT0_SD 1
#endif
#ifndef ATT0_QSP
#define ATT0_QSP 0
#endif
#ifndef ATT2_SD
#define ATT2_SD 2
#endif
#ifndef ATT3_SD
#define ATT3_SD 3
#endif
#ifndef ATT1_SD
#define ATT1_SD 1
#endif
#ifndef ATT1_QSP
#define ATT1_QSP 4
#endif
__global__ void __launch_bounds__(NWAVES * 64, 2) mega_fwd(Params P) {
    extern __shared__ __attribute__((aligned(16))) unsigned char lds_raw[];
    Frame F;
    F.lds = (LAS unsigned char*)lds_raw; F.MISC = (volatile LAS unsigned*)(F.lds + LDSCTL_OFF);
    F.tid = threadIdx.x; F.lane = F.tid & 63; F.wave = __builtin_amdgcn_readfirstlane(F.tid >> 6);
    F.G = gridDim.x; { const int bx = blockIdx.x; F.vcu = (F.G % 8 == 0) ? (bx % 8) * (F.G / 8) + bx / 8 : bx; }
    F.gw = F.vcu * NWAVES + F.wave; F.NGW = F.G * NWAVES;
    F.in = P.in; F.out = P.out; F.ws = P.ws; F.ctl = (gu32*)(P.ws + WS_CTL);
    for (int u = F.tid; u < (LDS_BYTES - LDSCTL_OFF) / 4; u += NWAVES * 64) ((LAS unsigned*)(F.lds + LDSCTL_OFF))[u] = 0u;
    __syncthreads();
    const int lo = P.ph_lo, hi = P.ph_hi;
    XcdBarrier bar = xcd_barrier_post((unsigned*)(F.ctl + CW_BAR), F.MISC + MI_BAR);
    LAS unsigned char* const lds = F.lds;
    const int gemm_sa_ = F8_SCL_A;
    const int gemm_g_ = F.G;
    const LAS int* const tbp = (const LAS int*)(F.MISC + MI_TB);
#ifndef ONLY_PH
#define ONLY_PH -1
#endif
#ifndef EMU_MASK
#define EMU_MASK 0ull
#endif
#ifndef DBL_MASK
#define DBL_MASK 0ull
#endif
#define PH(k) F.tid = opaque_tid(); F.lane = F.tid & 63; if ((ONLY_PH < 0 || ONLY_PH == (k)) && lo <= (k) && (k) < hi) for (int rep_ = 0, emu_ = (int)(((unsigned long long)(EMU_MASK) >> (k)) & 1ull); rep_ < 1 + (int)(((unsigned long long)(DBL_MASK) >> (k)) & 1ull); ++rep_)
#ifndef SEAM_REP
#define SEAM_REP 1
#endif
#define SEAM(k) do { if ((k) + 1 < hi) for (int sr_ = 0; sr_ < SEAM_REP; ++sr_) xcd_barrier(bar); } while (0)
#define GEMM_CALL_KS(EPI, EINIT, APTR, BPTR, KK, KSPLIT, NN, NTILES, MODE, AMODE, CIDX) do { const pg8::Gemm g_{(const bf16_t*)(APTR), (const bf16_t*)(BPTR), (KK), (KK) / (KSPLIT), emu_}; \
        const pg8::Sched S_{(NN), (NTILES), gemm_g_, (CIDX), (MODE), (AMODE), (KSPLIT), 2 * (KK) / (KSPLIT), tbp, 0, (NTILES) * (NN) * (KSPLIT), 0}; const pg8::EPI E_ EINIT; pg8::gemm_phase<pg8::EPI, pg8::Sched, pg8::EPI::ALIGN, true>(lds, g_, S_, E_); } while (0)
#define GEMM_CALL(EPI, EINIT, APTR, BPTR, KK, NN, NTILES, MODE, AMODE, CIDX) do { const pg8::Gemm g_{(const bf16_t*)(APTR), (const bf16_t*)(BPTR), (KK), (KK), emu_}; \
        const pg8::Sched S_{(NN), (NTILES), gemm_g_, (CIDX), (MODE), (AMODE), 1, 2 * (KK), tbp, 0, (NTILES) * (NN), 0}; const pg8::EPI E_ EINIT; pg8::gemm_phase<pg8::EPI, pg8::Sched, pg8::EPI::ALIGN, true>(lds, g_, S_, E_); } while (0)
#define GEMM_CALL_R(EPI, EINIT, APTR, BPTR, KK, KLOOP, NN, NTILES, MODE, AMODE, CIDX, LBASE, LEND, OVS) do { const pg8::Gemm g_{(const bf16_t*)(APTR), (const bf16_t*)(BPTR), (KK), (KLOOP)}; \
        const pg8::Sched S_{(NN), (NTILES), gemm_g_, (CIDX), (MODE), (AMODE), 1, 2 * (KLOOP), tbp, (LBASE), (LEND), (OVS)}; const pg8::EPI E_ EINIT; pg8::gemm_phase<pg8::EPI, pg8::Sched, pg8::EPI::ALIGN, true>(lds, g_, S_, E_); } while (0)
#define GEMM_CALL_R8(EPI, EINIT, APTR, BPTR, KK, KLOOP, NN, NTILES, MODE, AMODE, CIDX, LBASE, LEND, OVS) do { const pg8::Gemm g_{(const bf16_t*)(APTR), (const bf16_t*)(BPTR), (KK), (KLOOP), 0, gemm_sa_}; \
        const pg8::Sched S_{(NN), (NTILES), gemm_g_, (CIDX), (MODE), (AMODE), 1, (KLOOP), tbp, (LBASE), (LEND), (OVS)}; const pg8::EPI E_ EINIT; pg8::gemm_phase<pg8::EPI, pg8::Sched, pg8::EPI::ALIGN, true, true>(lds, g_, S_, E_); } while (0)
#define GEMM_CALL8(EPI, EINIT, APTR, BPTR, KK, NN, NTILES, MODE, AMODE, CIDX) do { const pg8::Gemm g_{(const bf16_t*)(APTR), (const bf16_t*)(BPTR), (KK), (KK), 0, gemm_sa_}; \
        const pg8::Sched S_{(NN), (NTILES), gemm_g_, (CIDX), (MODE), (AMODE), 1, (KK), tbp, 0, (NTILES) * (NN), 0}; const pg8::EPI E_ EINIT; pg8::gemm_phase<pg8::EPI, pg8::Sched, pg8::EPI::ALIGN, true, true>(lds, g_, S_, E_); } while (0)
#define MODP(layer, chunk) (WSP(float, WS_MOD) + (size_t)(layer) * 9 * 6144 + (chunk) * 1024)
#define BR(...) {__VA_ARGS__}
#define XCH ((LAS float*)(lds + 131072))
#ifndef CONV_REP
#define CONV_REP 1
#endif
#define TAIL_MOD(nunits, tlo, thi, ilo, ihi) do { const int rem_ = (nunits) % F.G; if (rem_ != 0 && F.vcu >= rem_) { mod_tasks(F, (tlo), (thi), F.vcu - rem_, F.G - rem_); __syncthreads(); convert_items(F, (ilo), (ihi), F.vcu - rem_, F.G - rem_); } } while (0)
#define TAIL(nunits, ilo, ihi) for (int cr_ = 0; cr_ < CONV_REP; ++cr_) do { const int rem_ = (nunits) % F.G; if (rem_ == 0) convert_items(F, (ilo), (ihi), F.vcu, F.G); else if (F.vcu >= rem_) convert_items(F, (ilo), (ihi), F.vcu - rem_, F.G - rem_); } while (0)

#define DED_SPLIT(nunits) const int r_ = ((nunits) + F.G - 1) / F.G, gc_ = r_ > 0 ? ((nunits) + r_ - 1) / r_ : F.G
#define DED_CONV(ilo, ihi) convert_items(F, (ilo), (ihi), F.vcu - gc_, F.G - gc_)
    PH(0) { p0_prologue(F); SEAM(0); }
    PH(1) { norm_phase_dense(F, 0, 0, 0, false, (QKV_FP8 & 1) != 0); SEAM(1); }
    PH(2) { if constexpr (((FUSE_QKV >> 0) & 1) && (QKV_FP8 & 1)) { GEMM_CALL8(EpiQKV<128>, BR(WSP(bf16_t, WS_RAW), 1536, F.in[I_GQA_QG], F.in[I_GQA_KG], SC_GQA, WSP(float, WS_R128C), WSP(float, WS_R128S), 1024, 1280, XCH), WSP(unsigned char, WS_H), WSP(unsigned char, WS_WQKV0), 1024, 6, MT, 0, 0, F.vcu); }
            else if constexpr ((FUSE_QKV >> 0) & 1) { GEMM_CALL(EpiQKV<128>, BR(WSP(bf16_t, WS_RAW), 1536, F.in[I_GQA_QG], F.in[I_GQA_KG], SC_GQA, WSP(float, WS_R128C), WSP(float, WS_R128S), 1024, 1280, XCH), WSP(bf16_t, WS_H), WSP(bf16_t, WS_WQKV0), 1024, 6, MT, 0, 0, F.vcu); } else { GEMM_CALL(EpiStore, BR(WSP(bf16_t, WS_RAW), 1536, 0), WSP(bf16_t, WS_H), WSP(bf16_t, WS_WQKV0), 1024, 6, MT, 0, 0, F.vcu); } TAIL(MT * 6, TI_PRO, TWA); SEAM(2); }
    PH(3) { if constexpr (!((FUSE_QKV >> 0) & 1)) { qk_pass<16>(F, WSP(bf16_t, WS_RAW), 1536, 8, 2, F.in[I_GQA_QG], F.in[I_GQA_KG], SC_GQA, WSP(float, WS_R128C), WSP(float, WS_R128S)); SEAM(3); } }
    PH(4) { const att::AttnP A{WSP(bf16_t, WS_RAW), WSP(bf16_t, WS_RAW) + 1024, WSP(bf16_t, WS_RAW) + 1280, WSP(bf16_t, WS_OBUF), nullptr};
            att::attn_phase<128, 128, false, ATT0_SD, ATT0_QSP, 1536, 1536, 1536, 1024, 8, 4, 4, 128, 128, 1, (WO_FP8 & 1) != 0>((LAS char*)lds, A, F.G, F.vcu); SEAM(4); }
    PH(5) { if constexpr ((WO_FP8 & 1) != 0) { DED_SPLIT(MT * 4); if (F.vcu < gc_) { const int gemm_g_ = gc_; const int gemm_sa_ = F8_SCL_W; GEMM_CALL8(EpiResGate, BR(WSP(f16_t, WS_XS), MODP(0, 2)), WSP(unsigned char, WS_OBUF), WSP(unsigned char, WS_WO0), 1024, 4, MT, 0, 0, F.vcu); } else DED_CONV(TWA, TWB); }
            else { GEMM_CALL(EpiResGate, BR(WSP(f16_t, WS_XS), MODP(0, 2)), WSP(bf16_t, WS_OBUF), WSP(bf16_t, WS_WO0), 1024, 4, MT, 0, 0, F.vcu); TAIL(MT * 4, TWA, TWB); } SEAM(5); }
    PH(6) { norm_phase_dense(F, 0, 1, 1, false); SEAM(6); }
    PH(7) { GEMM_CALL(EpiSwiGLU8, BR(WSP(unsigned char, WS_ACT), FF), WSP(bf16_t, WS_H), WSP(bf16_t, WS_WF13), 1024, 28, MT, 0, 0, F.vcu); TAIL(MT * 28, TWB, TWC); SEAM(7); }
    PH(8) { DED_SPLIT(MT * 4); if (F.vcu < gc_) { const int gemm_g_ = gc_; GEMM_CALL8(EpiResGate, BR(WSP(f16_t, WS_XS), MODP(0, 5)), WSP(unsigned char, WS_ACT), WSP(unsigned char, WS_WF2), FF, 4, MT, 0, 0, F.vcu); } else DED_CONV(TWC, TWD); SEAM(8); }
    PH(9) { norm_phase_dense(F, 1, 0, 1, false, (QKV_FP8 & 2) != 0); SEAM(9); }
    PH(10) { if constexpr ((QKV_FP8 & 2) != 0) { GEMM_CALL8(EpiStore, BR(WSP(bf16_t, WS_DN), 768, 0), WSP(unsigned char, WS_H), WSP(unsigned char, WS_WDOWN1), 1024, 3, MT, 0, 0, F.vcu); }
             else { GEMM_CALL(EpiStore, BR(WSP(bf16_t, WS_DN), 768, 0), WSP(bf16_t, WS_H), WSP(bf16_t, WS_WDOWN1), 1024, 3, MT, 0, 0, F.vcu); } TAIL(MT * 3, TWD, TWE); SEAM(10); }
    PH(11) { mla_pb2(F); SEAM(11); }
    PH(12) { GEMM_CALL(EpiStore, BR(WSP(bf16_t, WS_QRAW), 1536, 0), WSP(bf16_t, WS_CQN), WSP(bf16_t, WS_WUQ1), 384, 6, MT, 0, 0, F.vcu);
             GEMM_CALL(EpiStore, BR(WSP(bf16_t, WS_KVRAW), 2048, 0), WSP(bf16_t, WS_CKVN), WSP(bf16_t, WS_WUKV1), 256, 8, MT, 0, 0, F.G - 1 - F.vcu); SEAM(12); }
    PH(13) { mla_pc(F); SEAM(13); }
    PH(14) { const att::AttnP A{WSP(bf16_t, WS_QRAW), WSP(bf16_t, WS_KBUF), WSP(bf16_t, WS_KVRAW) + 128, WSP(bf16_t, WS_OBUF), nullptr};
             att::attn_phase<192, 128, false, ATT1_SD, ATT1_QSP, 1536, 1536, 2048, 1024, 8, 1, 1, 192, 256, 1, (WO_FP8 & 2) != 0>((LAS char*)lds, A, F.G, F.vcu); SEAM(14); }
    PH(15) { DED_SPLIT(MT * 4); if (F.vcu < gc_) { const int gemm_g_ = gc_; if constexpr ((WO_FP8 & 2) != 0) { const int gemm_sa_ = F8_SCL_W; GEMM_CALL8(EpiResGate, BR(WSP(f16_t, WS_XS), MODP(1, 2)), WSP(unsigned char, WS_OBUF), WSP(unsigned char, WS_WO1), 1024, 4, MT, 0, 0, F.vcu); }
             else { GEMM_CALL(EpiResGate, BR(WSP(f16_t, WS_XS), MODP(1, 2)), WSP(bf16_t, WS_OBUF), WSP(bf16_t, WS_WO1), 1024, 4, MT, 0, 0, F.vcu); } } else DED_CONV(TWE, TWF); SEAM(15); }
    PH(16) { norm_phase_moe(F, 1, 0, false); SEAM(16); }
    PH(17) { moe_tile_base(F, 0); const int nt_ = __builtin_amdgcn_readfirstlane(tbp[8]);
             if constexpr (UPM_FP8) { GEMM_CALL8(EpiSwiGLU8, BR(WSP(unsigned char, WS_ACT), FF), WSP(unsigned char, WS_ASORT), WSP(unsigned char, WS_WM13), 1024, 28, nt_, 2, 0, F.vcu); }
             else { GEMM_CALL(EpiSwiGLU8, BR(WSP(unsigned char, WS_ACT), FF), WSP(bf16_t, WS_ASORT), WSP(bf16_t, WS_WM13), 1024, 28, nt_, 2, 0, F.vcu); } TAIL(nt_ * 28, TWF, TWG); SEAM(17); }
    PH(18) { moe_tile_base(F, 0); const int nt_ = __builtin_amdgcn_readfirstlane(tbp[8]);
             DED_SPLIT(nt_ * 4); if (F.vcu < gc_) { const int gemm_g_ = gc_; GEMM_CALL8(EpiStore, BR(WSP(bf16_t, WS_Y), 1024, 0), WSP(unsigned char, WS_ACT), WSP(unsigned char, WS_WM2), FF, 4, nt_, 2, 1, F.vcu); } else DED_CONV(TWG, TWH); SEAM(18); }
    PH(19) { moe_tile_base(F, 0); norm_phase_dense(F, 2, 0, 2, false, (QKV_FP8 & 4) != 0); SEAM(19); }
    PH(20) { if constexpr (((FUSE_QKV >> 1) & 1) && (QKV_FP8 & 4)) { GEMM_CALL8(EpiQKV<64>, BR(WSP(bf16_t, WS_RAW), 1280, F.in[I_WIN_QG], F.in[I_WIN_KG], SC_64, WSP(float, WS_R64C), WSP(float, WS_R64S), 1024, 1152, XCH), WSP(unsigned char, WS_H), WSP(unsigned char, WS_WQKV2), 1024, 5, MT, 0, 0, F.vcu); }
             else if constexpr ((FUSE_QKV >> 1) & 1) { GEMM_CALL(EpiQKV<64>, BR(WSP(bf16_t, WS_RAW), 1280, F.in[I_WIN_QG], F.in[I_WIN_KG], SC_64, WSP(float, WS_R64C), WSP(float, WS_R64S), 1024, 1152, XCH), WSP(bf16_t, WS_H), WSP(bf16_t, WS_WQKV2), 1024, 5, MT, 0, 0, F.vcu); } else { GEMM_CALL(EpiStore, BR(WSP(bf16_t, WS_RAW), 1280, 0), WSP(bf16_t, WS_H), WSP(bf16_t, WS_WQKV2), 1024, 5, MT, 0, 0, F.vcu); } TAIL(MT * 5, TWH, TWI); SEAM(20); }
    PH(21) { if constexpr (!((FUSE_QKV >> 1) & 1)) { qk_pass<8>(F, WSP(bf16_t, WS_RAW), 1280, 16, 2, F.in[I_WIN_QG], F.in[I_WIN_KG], SC_64, WSP(float, WS_R64C), WSP(float, WS_R64S)); SEAM(21); } }
    PH(22) { const att::AttnP A{WSP(bf16_t, WS_RAW), WSP(bf16_t, WS_RAW) + 1024, WSP(bf16_t, WS_RAW) + 1152, WSP(bf16_t, WS_OBUF), F.in[I_WIN_SINK]};
             att::attn_phase<64, 64, true, ATT2_SD, 0, 1280, 1280, 1280, 1024, 16, 8, 8, 64, 64, 1, (WO_FP8 & 4) != 0>((LAS char*)lds, A, F.G, F.vcu); SEAM(22); }
    PH(23) { if constexpr ((WO_FP8 & 4) != 0) { DED_SPLIT(MT * 4); if (F.vcu < gc_) { const int gemm_g_ = gc_; const int gemm_sa_ = F8_SCL_W; GEMM_CALL8(EpiResGate, BR(WSP(f16_t, WS_XS), MODP(2, 2)), WSP(unsigned char, WS_OBUF), WSP(unsigned char, WS_WO2), 1024, 4, MT, 0, 0, F.vcu); } else DED_CONV(TWI, TWJ); }
             else { GEMM_CALL(EpiResGate, BR(WSP(f16_t, WS_XS), MODP(2, 2)), WSP(bf16_t, WS_OBUF), WSP(bf16_t, WS_WO2), 1024, 4, MT, 0, 0, F.vcu); TAIL(MT * 4, TWI, TWJ); } SEAM(23); }
    PH(24) { norm_phase_dense(F, 2, 1, 1, false); SEAM(24); }
    PH(25) { GEMM_CALL(EpiSwiGLU8, BR(WSP(unsigned char, WS_ACT), FF), WSP(bf16_t, WS_H), WSP(bf16_t, WS_WF13) + (size_t)7168 * 1024, 1024, 28, MT, 0, 0, F.vcu); TAIL(MT * 28, TWJ, TWK); SEAM(25); }
    PH(26) { DED_SPLIT(MT * 4); if (F.vcu < gc_) { const int gemm_g_ = gc_; GEMM_CALL8(EpiResGate, BR(WSP(f16_t, WS_XS), MODP(2, 5)), WSP(unsigned char, WS_ACT), WSP(unsigned char, WS_WF2) + (size_t)1024 * FF, FF, 4, MT, 0, 0, F.vcu); } else DED_CONV(TWK, TI_END); SEAM(26); }
    PH(27) { norm_phase_dense(F, 3, 0, 1, false, (QKV_FP8 & 8) != 0); SEAM(27); }
    PH(28) { if constexpr (((FUSE_QKV >> 2) & 1) && (QKV_FP8 & 8)) { GEMM_CALL8(EpiQKV<64>, BR(WSP(bf16_t, WS_RAW), 3072, F.in[I_DIFF_QG], F.in[I_DIFF_KG], SC_64, WSP(float, WS_R64C), WSP(float, WS_R64S), 1024, 2048, XCH), WSP(unsigned char, WS_H), WSP(unsigned char, WS_WQKV3), 1024, 12, MT, 0, 0, F.vcu); }
             else if constexpr ((FUSE_QKV >> 2) & 1) { GEMM_CALL(EpiQKV<64>, BR(WSP(bf16_t, WS_RAW), 3072, F.in[I_DIFF_QG], F.in[I_DIFF_KG], SC_64, WSP(float, WS_R64C), WSP(float, WS_R64S), 1024, 2048, XCH), WSP(bf16_t, WS_H), WSP(bf16_t, WS_WQKV3), 1024, 12, MT, 0, 0, F.vcu); } else { GEMM_CALL(EpiStore, BR(WSP(bf16_t, WS_RAW), 3072, 0), WSP(bf16_t, WS_H), WSP(bf16_t, WS_WQKV3), 1024, 12, MT, 0, 0, F.vcu); } SEAM(28); }
    PH(29) { if constexpr (!((FUSE_QKV >> 2) & 1)) { qk_pass<8>(F, WSP(bf16_t, WS_RAW), 3072, 16, 16, F.in[I_DIFF_QG], F.in[I_DIFF_KG], SC_64, WSP(float, WS_R64C), WSP(float, WS_R64S)); SEAM(29); } }
    PH(30) { const att::AttnP A{WSP(bf16_t, WS_RAW), WSP(bf16_t, WS_RAW) + 1024, WSP(bf16_t, WS_RAW) + 2048, WSP(bf16_t, WS_OBUF), nullptr};
             att::attn_phase<64, 128, false, ATT3_SD, 0, 3072, 3072, 3072, 2048, 16, 1, 2, 64, 128, 0>((LAS char*)lds, A, F.G, F.vcu); SEAM(30); }
    PH(31) { diff_combine(F); SEAM(31); }
    PH(32) { if constexpr ((WO_FP8 >> 3) & 1) { const int gemm_sa_ = F8_SCL_W; GEMM_CALL8(EpiResGate, BR(WSP(f16_t, WS_XS), MODP(3, 2)), WSP(unsigned char, WS_O2), WSP(unsigned char, WS_WO3), 1024, 4, 64, 1, 0, F.vcu); }
             else { GEMM_CALL(EpiResGate, BR(WSP(f16_t, WS_XS), MODP(3, 2)), WSP(bf16_t, WS_O2), WSP(bf16_t, WS_WO3), 1024, 4, 64, 1, 0, F.vcu); } SEAM(32); }
    PH(33) { norm_phase_moe(F, 3, 1, true); SEAM(33); }
    PH(34) { moe_tile_base(F, 1); const int nt_ = __builtin_amdgcn_readfirstlane(tbp[8]);
             if constexpr (UPM_FP8) { GEMM_CALL8(EpiSwiGLU8, BR(WSP(unsigned char, WS_ACT), FF), WSP(unsigned char, WS_ASORT), WSP(unsigned char, WS_WM13) + (size_t)NEXP * 7168 * 1024, 1024, 28, nt_, 2, 0, F.vcu); }
             else { GEMM_CALL(EpiSwiGLU8, BR(WSP(unsigned char, WS_ACT), FF), WSP(bf16_t, WS_ASORT), WSP(bf16_t, WS_WM13) + (size_t)NEXP * 7168 * 1024, 1024, 28, nt_, 2, 0, F.vcu); } SEAM(34); }
    PH(35) { moe_tile_base(F, 1); const int nt_ = __builtin_amdgcn_readfirstlane(tbp[8]);
             const int nun_ = nt_ * 4, lmain_ = (nun_ / F.G) * F.G, rem_ = nun_ - lmain_;
             if (OVF_SPLIT && rem_ > 0 && rem_ <= 128) {
                 GEMM_CALL_R8(EpiStore, BR(WSP(bf16_t, WS_Y), 1024, 0), WSP(unsigned char, WS_ACT), WSP(unsigned char, WS_WM2) + (size_t)NEXP * 1024 * FF, FF, FF, 4, nt_, 2, 1, F.vcu, 0, lmain_, 0);
                 GEMM_CALL_R8(EpiSlab, BR(WSP(float, WS_ASORT)), WSP(unsigned char, WS_ACT), WSP(unsigned char, WS_WM2) + (size_t)NEXP * 1024 * FF, FF, 512, 4, nt_, 2, 1, F.vcu, lmain_, nun_, 7);
             } else {
                 GEMM_CALL8(EpiStore, BR(WSP(bf16_t, WS_Y), 1024, 0), WSP(unsigned char, WS_ACT), WSP(unsigned char, WS_WM2) + (size_t)NEXP * 1024 * FF, FF, 4, nt_, 2, 1, F.vcu);
             }
             SEAM(35); }
    PH(36) { moe_tile_base(F, 1); final_phase(F, 3); }
#undef PH
#undef SEAM
}

extern "C" void kernel_launch(void* const* d_in, const int* in_sizes, int n_in, void* d_out, int out_size, void* d_ws, size_t ws_size, hipStream_t stream) {
    static int grid = 0;
    if (grid == 0) {
        if (n_in != N_IN || in_sizes[0] != NB * SEQ * D || out_size != NB * SEQ * D || ws_size < WS_END) {
            fprintf(stderr, "kernel_launch: shape mismatch: n_in %d in0 %d out %d ws %zu (need %zu); nothing launched\n", n_in, n_in > 0 ? in_sizes[0] : -1, out_size, ws_size, (size_t)WS_END); grid = -1; return; }
        int dev = 0, cus = 0;
        if (hipGetDevice(&dev) != hipSuccess || hipDeviceGetAttribute(&cus, hipDeviceAttributeMultiprocessorCount, dev) != hipSuccess) { fprintf(stderr, "kernel_launch: device query failed\n"); grid = -1; return; }
        if (hipFuncSetAttribute((const void*)mega_fwd, hipFuncAttributeMaxDynamicSharedMemorySize, LDS_BYTES) != hipSuccess) { fprintf(stderr, "kernel_launch: hipFuncSetAttribute failed\n"); grid = -1; return; }
        int per_cu = 0;
        if (hipOccupancyMaxActiveBlocksPerMultiprocessor(&per_cu, (const void*)mega_fwd, NWAVES * 64, LDS_BYTES) != hipSuccess || per_cu < 1) fprintf(stderr, "kernel_launch: note: occupancy query reports %d\n", per_cu);
        (void)hipGetLastError();
        grid = cus < 256 ? cus : 256;
        if (grid != 256) fprintf(stderr, "kernel_launch: warning: %d CUs; the phase programme assumes 256 workgroups\n", grid);
    }
    if (grid < 0) return;
    if (hipMemsetAsync((char*)d_ws + WS_CTL, 0, CTL_ZERO_BYTES, stream) != hipSuccess) { fprintf(stderr, "kernel_launch: memset failed\n"); return; }
    Params p{};
    for (int i = 0; i < N_IN; ++i) p.in[i] = (const float*)d_in[i];
    p.out = (float*)d_out; p.ws = (unsigned char*)d_ws;
#if MK_MULTI
    for (int ph = 0; ph < NPH; ++ph) { p.ph_lo = ph; p.ph_hi = ph + 1; hipLaunchKernelGGL(mega_fwd, dim3(grid), dim3(NWAVES * 64), LDS_BYTES, stream, p); }
#else
    p.ph_lo = 0; p.ph_hi = NPH;
    hipLaunchKernelGGL(mega_fwd, dim3(grid), dim3(NWAVES * 64), LDS_BYTES, stream, p);
#endif
    const hipError_t le = hipPeekAtLastError();
    if (le != hipSuccess) fprintf(stderr, "kernel_launch: launch failed: %s\n", hipGetErrorName(le));
}
```

```cpp
#include <hip/hip_runtime.h>
#include <cstdio>
#include <cstdint>

#define GAS __attribute__((address_space(1)))
#define LAS __attribute__((address_space(3)))
typedef unsigned short bf16_t;
typedef short bf16x8 __attribute__((ext_vector_type(8)));
typedef short s16x4 __attribute__((ext_vector_type(4)));
typedef float f32x4 __attribute__((ext_vector_type(4)));
typedef _Float16 f16_t;
typedef _Float16 f16x4 __attribute__((ext_vector_type(4)));
typedef _Float16 f16x8 __attribute__((ext_vector_type(8)));
typedef float f32x8 __attribute__((ext_vector_type(8)));
typedef float f32x2 __attribute__((ext_vector_type(2)));
typedef float f32x16 __attribute__((ext_vector_type(16)));
typedef unsigned u32x4 __attribute__((ext_vector_type(4)));
typedef unsigned u32x2 __attribute__((ext_vector_type(2)));

__device__ __forceinline__ unsigned cvt_pk_bf16(float lo, float hi) { unsigned r; asm volatile("v_cvt_pk_bf16_f32 %0, %1, %2" : "=v"(r) : "v"(lo), "v"(hi)); return r; }
__device__ __forceinline__ float bf_lo(unsigned w) { return __uint_as_float(w << 16); }
__device__ __forceinline__ float bf_hi(unsigned w) { return __uint_as_float(w & 0xffff0000u); }

typedef int v8i_t __attribute__((ext_vector_type(8)));
typedef int v4i_t __attribute__((ext_vector_type(4)));
__device__ __forceinline__ v8i_t cat8(bf16x8 lo, bf16x8 hi) { const v4i_t a = __builtin_bit_cast(v4i_t, lo), b = __builtin_bit_cast(v4i_t, hi); return __builtin_shufflevector(a, b, 0, 1, 2, 3, 4, 5, 6, 7); }
constexpr float F8_ACT_MUL = 8.0f, F8_W_MUL = 64.0f;
#ifndef FP8_SAT_MODE
#define FP8_SAT_MODE 1
#endif
#if FP8_SAT_MODE
#define F8CLAMP(x) (x)
#else
#define F8CLAMP(x) fminf(fmaxf((x), -448.f), 448.f)
#endif
#define F8_SCL_A 124
#define F8_SCL_W 121
__device__ __forceinline__ unsigned pk4_fp8(float a, float b, float c, float d) { unsigned w = 0u; w = __builtin_amdgcn_cvt_pk_fp8_f32(a, b, w, false); w = __builtin_amdgcn_cvt_pk_fp8_f32(c, d, w, true); return w; }
__device__ __forceinline__ int opaque_tid() { int t = threadIdx.x; asm volatile("" : "+v"(t)); return t; }

namespace pg8 {
#define PG8_LAS __attribute__((address_space(3)))
constexpr int BM = 256, BK = 64, HALF = 128, HTB = HALF * BK * 2  , STAGE_BYTES = 8 * HTB;

__host__ __device__ __forceinline__ int lds_byte(int r, int c) { const int st = (r >> 4) * 2 + (c >> 5), rr = r & 15, cc = c & 31, ob = rr * 64 + cc * 2; return st * 1024 + (ob ^ (((ob >> 9) & 1) << 5)); }
__host__ __device__ __forceinline__ void stage_rc(int b, int& R, int& C) { const int st = b / 1024, sb = b % 1024, swz = sb ^ (((sb >> 9) & 1) << 5); R = (st >> 1) * 16 + swz / 64; C = (st & 1) * 32 + (swz % 64) / 2; }
__host__ __device__ __forceinline__ int perm32(int rho) { const int n = rho >> 4, i = rho & 15; return 8 * (i >> 2) + 4 * n + (i & 3); }

struct Unit { int pm, pn, om, on, kb, ks, ov; };
__device__ __forceinline__ bf16x8 emu8v(bf16x8 v) { u32x4 w = __builtin_bit_cast(u32x4, v); w.x = (w.x + 0x00080008u) & 0xFFF0FFF0u; w.y = (w.y + 0x00080008u) & 0xFFF0FFF0u; w.z = (w.z + 0x00080008u) & 0xFFF0FFF0u; w.w = (w.w + 0x00080008u) & 0xFFF0FFF0u; return __builtin_bit_cast(bf16x8, w); }
struct Gemm { const bf16_t* A; const bf16_t* Bt; int K, KL; int emu = 0; int sa = F8_SCL_A; };

#ifndef GROWS
#define GROWS 8
#endif
struct Sched {
    int nN, ntiles, G, c, mode, amode, KS, KL;
    const LAS int* tb;
    int lbase, lend, ovs;
    __device__ __forceinline__ bool next(int i, Unit& u) const {
        int L, kso = 0, ov = 0;
        if (ovs) { const int Lo = i * G + c; if (Lo >= (lend - lbase) * ovs) return false; ov = Lo / ovs; kso = Lo - ov * ovs; L = lbase + ov; }
        else { L = lbase + i * G + c; if (L >= lend) return false; }
        const int ksn = ovs ? 1 : KS;
        const int nig = GROWS * nN * ksn, gid = L / nig, fm = gid * GROWS, gsz = (ntiles - fm) < GROWS ? (ntiles - fm) : GROWS, rem = L - gid * nig;
        const int t = fm + rem % gsz, q = rem / gsz, ks = q / nN, pn = q - ks * nN;
        u.ks = ovs ? kso : ks; u.kb = u.ks * KL; u.ov = ov;
        if (mode == 0) { u.pm = t; u.pn = pn; u.om = t; u.on = pn; }
        else if (mode == 1) { const int tt = t + (t >> 3) + 1; u.pm = tt; u.pn = pn; u.om = tt; u.on = pn; }
        else { int e = 0;
#pragma unroll
            for (int k = 1; k < 8; ++k) e += (t >= __builtin_amdgcn_readfirstlane(tb[k])) ? 1 : 0;
            const int rt = t - __builtin_amdgcn_readfirstlane(tb[e]); u.pm = amode ? t : e * 72 + rt; u.pn = e * nN + pn; u.om = t; u.on = pn; }
        return true;
    }
    __device__ __forceinline__ void a_ready(const Unit&) const {}
    __device__ __forceinline__ void done(const Unit&) const {}
};

struct EpiStore {
    static constexpr bool PERM = true, AFTER_DRAIN = false, ALIGN = true;
    bf16_t* O; int ldc; size_t ks_stride;
    __device__ __forceinline__ void operator()(const f32x4 (&acc)[2][2][4][2], const Unit& u, int wr, int wc, int fr, int fq) const {
        const int row0 = u.om * BM + wr * 64 + fr, col0 = u.on * BM + wc * 32 + 8 * fq;
        bf16_t* Ok = O + (size_t)u.ks * ks_stride;
#pragma unroll
        for (int ai = 0; ai < 2; ++ai)
#pragma unroll
            for (int m = 0; m < 4; ++m) { bf16_t* rowp = Ok + (size_t)(row0 + ai * HALF + m * 16) * ldc + col0;
#pragma unroll
                for (int bj = 0; bj < 2; ++bj) { const f32x4 v0 = acc[ai][bj][m][0], v1 = acc[ai][bj][m][1];
                    u32x4 w; w.x = cvt_pk_bf16(v0[0], v0[1]); w.y = cvt_pk_bf16(v0[2], v0[3]); w.z = cvt_pk_bf16(v1[0], v1[1]); w.w = cvt_pk_bf16(v1[2], v1[3]);
                    *(u32x4*)(rowp + bj * HALF) = w; } }
    }
};
template <int HD> struct EpiQKV {
    static constexpr bool PERM = true, AFTER_DRAIN = false, ALIGN = true;
    bf16_t* O; int ldc; const float* qg; const float* kg; float qscale; const float* cs; const float* sn; int nq_cols, nqk_cols; PG8_LAS float* xch;
    __device__ __forceinline__ void operator()(const f32x4 (&acc)[2][2][4][2], const Unit& u, int wr, int wc, int fr, int fq) const {
        const int colt = u.on * BM; const bool nrm0 = colt < nqk_cols, nrm1 = colt + HALF < nqk_cols;
        const int b9 = u.om / 9, t9 = u.om - b9 * 9; const bool lat = t9 != 0;
        int p0 = (HD == 128) ? (16 * wc + 4 * fq) : (16 * (wc & 1) + 4 * fq);
        asm volatile("" : "+v"(p0));
        f32x4 tc[2][4], ts[2][4];
        f32x4 G1, G2; float SC = 1.0f;
        if (nrm0) {
            { const bool isq = colt < nq_cols; const float* g = isq ? qg : kg; SC = isq ? qscale : 1.0f;
                G1 = *(const f32x4*)(g + p0); G2 = *(const f32x4*)(g + p0 + HD / 2); }
#pragma unroll
            for (int ai = 0; ai < 2; ++ai) { float s[4][2];
#pragma unroll
                for (int m = 0; m < 4; ++m)
#pragma unroll
                    for (int bj = 0; bj < 2; ++bj) { const f32x4 a = acc[ai][bj][m][0], b = acc[ai][bj][m][1];
                        s[m][bj] = (a[0] * a[0] + a[1] * a[1]) + (a[2] * a[2] + a[3] * a[3]) + (b[0] * b[0] + b[1] * b[1]) + (b[2] * b[2] + b[3] * b[3]); }
#pragma unroll
                for (int m = 0; m < 4; ++m)
#pragma unroll
                    for (int bj = 0; bj < 2; ++bj) s[m][bj] += __shfl_xor(s[m][bj], 16);
#pragma unroll
                for (int m = 0; m < 4; ++m)
#pragma unroll
                    for (int bj = 0; bj < 2; ++bj) s[m][bj] += __shfl_xor(s[m][bj], 32);
                if (fq == 0) {
#pragma unroll
                    for (int m = 0; m < 4; ++m)
#pragma unroll
                        for (int bj = 0; bj < 2; ++bj) xch[((ai * 2 + bj) * 128 + wr * 64 + m * 16 + fr) * 4 + wc] = s[m][bj];
                } }
            if (lat) {
#pragma unroll
                for (int ai = 0; ai < 2; ++ai)
#pragma unroll
                    for (int m = 0; m < 4; ++m) { const size_t to = (size_t)((t9 - 1) * 256 + ai * HALF + wr * 64 + m * 16 + fr) * (HD / 2) + p0; tc[ai][m] = *(const f32x4*)(cs + to); ts[ai][m] = *(const f32x4*)(sn + to); }
            }
            asm volatile("s_waitcnt lgkmcnt(0)" ::: "memory"); __builtin_amdgcn_s_barrier(); asm volatile("" ::: "memory");
        }
        const int row0 = u.om * BM + wr * 64 + fr, col0 = colt + wc * 32 + 8 * fq;
#pragma unroll
        for (int bj = 0; bj < 2; ++bj) {
            const bool nrm = bj == 0 ? nrm0 : nrm1;
            if (nrm) {
#pragma unroll
                for (int ai = 0; ai < 2; ++ai)
#pragma unroll
                    for (int m = 0; m < 4; ++m) { bf16_t* rowp = O + (size_t)(row0 + ai * HALF + m * 16) * ldc + col0 + bj * HALF;
                        const f32x4 v0 = acc[ai][bj][m][0], v1 = acc[ai][bj][m][1];
                        const f32x4 pp = *(const PG8_LAS f32x4*)(xch + ((ai * 2 + bj) * 128 + wr * 64 + m * 16 + fr) * 4);
                        const float ss = (HD == 128) ? ((pp[0] + pp[1]) + (pp[2] + pp[3])) : ((wc < 2) ? (pp[0] + pp[1]) : (pp[2] + pp[3]));
                        const float rs = __builtin_amdgcn_rsqf(ss * (1.0f / HD) + 1e-6f) * SC;
                        const f32x4 g1 = G1 * rs, g2 = G2 * rs;
                        float x1[4] = {v0[0] * g1[0], v0[2] * g1[1], v1[0] * g1[2], v1[2] * g1[3]};
                        float x2[4] = {v0[1] * g2[0], v0[3] * g2[1], v1[1] * g2[2], v1[3] * g2[3]};
                        if (lat) { const f32x4 c = tc[ai][m], sv = ts[ai][m];
#pragma unroll
                            for (int i = 0; i < 4; ++i) { const float a = x1[i], b = x2[i]; x1[i] = a * c[i] - b * sv[i]; x2[i] = a * sv[i] + b * c[i]; } }
                        u32x4 w; w.x = cvt_pk_bf16(x1[0], x2[0]); w.y = cvt_pk_bf16(x1[1], x2[1]); w.z = cvt_pk_bf16(x1[2], x2[2]); w.w = cvt_pk_bf16(x1[3], x2[3]);
                        *(u32x4*)rowp = w; }
            } else {
#pragma unroll
                for (int ai = 0; ai < 2; ++ai)
#pragma unroll
                    for (int m = 0; m < 4; ++m) { bf16_t* rowp = O + (size_t)(row0 + ai * HALF + m * 16) * ldc + col0 + bj * HALF;
                        const f32x4 v0 = acc[ai][bj][m][0], v1 = acc[ai][bj][m][1];
                        u32x4 w; w.x = cvt_pk_bf16(v0[0], v0[1]); w.y = cvt_pk_bf16(v0[2], v0[3]); w.z = cvt_pk_bf16(v1[0], v1[1]); w.w = cvt_pk_bf16(v1[2], v1[3]);
                        *(u32x4*)rowp = w; }
            }
        }
    }
};
constexpr float SW_G = 1.4426950408889634f, SW_U = 8.0f / 1.4426950408889634f;
__device__ __forceinline__ float swiglu8(float gp, float up) { return F8CLAMP(gp * up * __builtin_amdgcn_rcpf(1.0f + __builtin_amdgcn_exp2f(-gp))); }
__device__ __forceinline__ float silu_mul(float g, float u) { return g * u * __builtin_amdgcn_rcpf(1.0f + __builtin_amdgcn_exp2f(-1.4426950408889634f * g)); }
struct EpiSlab {
    static constexpr bool PERM = false, AFTER_DRAIN = false, ALIGN = true;
    float* slab;
    __device__ __forceinline__ void operator()(const f32x4 (&acc)[2][2][4][2], const Unit& u, int wr, int wc, int fr, int fq) const {
        float* base = slab + (size_t)(u.ks * 128 + u.ov) * 65536 + (size_t)(wr * 64 + fr) * 256 + wc * 32 + 4 * fq;
#pragma unroll
        for (int ai = 0; ai < 2; ++ai)
#pragma unroll
            for (int m = 0; m < 4; ++m)
#pragma unroll
                for (int bj = 0; bj < 2; ++bj)
#pragma unroll
                    for (int n = 0; n < 2; ++n) *(f32x4*)(base + (size_t)(ai * HALF + m * 16) * 256 + bj * HALF + n * 16) = acc[ai][bj][m][n];
    }
};
#ifndef SWIGLU_ALIGN
#define SWIGLU_ALIGN true
#endif
struct EpiSwiGLU8 {
    static constexpr bool PERM = true, AFTER_DRAIN = false, ALIGN = true;
    unsigned char* O; int ldc;
    __device__ __forceinline__ void operator()(const f32x4 (&acc)[2][2][4][2], const Unit& u, int wr, int wc, int fr, int fq) const {
        const int row0 = u.om * BM + wr * 64 + fr, col0 = u.on * HALF + wc * 32 + 8 * fq;
#pragma unroll
        for (int ai = 0; ai < 2; ++ai)
#pragma unroll
            for (int m = 0; m < 4; ++m) { unsigned char* rowp = O + (size_t)(row0 + ai * HALF + m * 16) * ldc + col0;
                const f32x4 g0 = acc[ai][0][m][0], g1 = acc[ai][0][m][1], u0 = acc[ai][1][m][0], u1 = acc[ai][1][m][1];
                float v[8];
#pragma unroll
                for (int i = 0; i < 4; ++i) { v[i] = swiglu8(g0[i], u0[i]); v[4 + i] = swiglu8(g1[i], u1[i]); }
                u32x2 w; w.x = pk4_fp8(v[0], v[1], v[2], v[3]); w.y = pk4_fp8(v[4], v[5], v[6], v[7]);
                *(u32x2*)rowp = w; }
    }
};
#ifndef RESGATE_ALIGN
#define RESGATE_ALIGN false
#endif
struct EpiResGate {
    static constexpr bool PERM = true, AFTER_DRAIN = false, ALIGN = RESGATE_ALIGN;
    f16_t* X; const float* mod;
    __device__ __forceinline__ void operator()(const f32x4 (&acc)[2][2][4][2], const Unit& u, int wr, int wc, int fr, int fq) const {
        const int b = u.om / 9, mr = (u.om - b * 9 == 0) ? 8 : b;
        const float* gp = mod + (size_t)mr * 6144;
        const int row0 = u.om * BM + wr * 64 + fr, col0 = u.on * BM + wc * 32 + 8 * fq;
        f32x4 gv[2][2];
#pragma unroll
        for (int bj = 0; bj < 2; ++bj)
#pragma unroll
            for (int n = 0; n < 2; ++n) gv[bj][n] = *(const f32x4*)(gp + col0 + bj * HALF + n * 4);
#pragma unroll
        for (int ai = 0; ai < 2; ++ai)
#pragma unroll
            for (int m = 0; m < 4; ++m) { f16_t* rowp = X + (size_t)(row0 + ai * HALF + m * 16) * 1024 + col0;
#pragma unroll
                for (int bj = 0; bj < 2; ++bj) { f16x8* p = (f16x8*)(rowp + bj * HALF); const f32x8 x = __builtin_convertvector(*p, f32x8);
                    const f32x4 lo = (f32x4){x[0], x[1], x[2], x[3]} + gv[bj][0] * acc[ai][bj][m][0], hi = (f32x4){x[4], x[5], x[6], x[7]} + gv[bj][1] * acc[ai][bj][m][1];
                    *p = __builtin_convertvector((f32x8){lo[0], lo[1], lo[2], lo[3], hi[0], hi[1], hi[2], hi[3]}, f16x8); }
                if (m & 1) asm volatile("" ::: "memory"); }
    }
};

template <class Epi, class Sched, bool ALIGN_EPI = false, bool SP2 = false, bool F8 = false>
__device__ __forceinline__ void gemm_phase(PG8_LAS unsigned char* lds, const Gemm g, const Sched& S, const Epi& E) {
    const int tid = opaque_tid(), wid = __builtin_amdgcn_readfirstlane(tid >> 6), lane = tid & 63, wr = wid >> 2, wc = wid & 3, fr = lane & 15, fq = lane >> 4;
    const int RS = F8 ? g.K : 2 * g.K, nt = F8 ? g.KL / 128 : g.KL / BK;
    unsigned voffA[2], voffB[2];
#pragma unroll
    for (int i = 0; i < 2; ++i) { int R, C; stage_rc(tid * 16 + i * 8192, R, C); const int Rb = Epi::PERM ? ((R & ~31) + perm32(R & 31)) : R;
        voffA[i] = (unsigned)(R * RS + C * 2); voffB[i] = (unsigned)(Rb * RS + C * 2); }
    const size_t kstep = (size_t)(BK * 2);
    const size_t hstep = (size_t)HALF * RS;
    const size_t tstep = 2 * hstep;
    const unsigned ldsw = (unsigned)wid * 1024u;
    const int aoff = lds_byte(wr * 64 + fr, fq * 8), boff = lds_byte(wc * 32 + fr, fq * 8);
#define PG8_SA(b, h) (((b) * 2 + (h)) * HTB)
#define PG8_SB(b, h) ((4 + (b) * 2 + (h)) * HTB)
#define PG8_STAGE(bufoff, gbase, voff) do { _Pragma("unroll") for (int _i = 0; _i < 2; ++_i) \
        __builtin_amdgcn_global_load_lds((const unsigned*)((const char*)(gbase) + (voff)[_i]), (PG8_LAS unsigned*)(lds + (bufoff) + ldsw + _i * 8192), 16, 0, 0); } while (0)
#define PG8_LDA(dst, b, h) do { if constexpr (F8) { _Pragma("unroll") for (int m = 0; m < 4; ++m) dst##8[m] = cat8(*(const PG8_LAS bf16x8*)(lds + PG8_SA(b, h) + aoff + m * 2048), *(const PG8_LAS bf16x8*)(lds + PG8_SA(b, h) + aoff + m * 2048 + 1024)); } \
    else { _Pragma("unroll") for (int m = 0; m < 4; ++m) _Pragma("unroll") for (int k = 0; k < 2; ++k) dst[m][k] = *(const PG8_LAS bf16x8*)(lds + PG8_SA(b, h) + aoff + m * 2048 + k * 1024); } } while (0)
#define PG8_LDB(dst, b, h) do { if constexpr (F8) { _Pragma("unroll") for (int n = 0; n < 2; ++n) dst##8[n] = cat8(*(const PG8_LAS bf16x8*)(lds + PG8_SB(b, h) + boff + n * 2048), *(const PG8_LAS bf16x8*)(lds + PG8_SB(b, h) + boff + n * 2048 + 1024)); } \
    else { _Pragma("unroll") for (int n = 0; n < 2; ++n) _Pragma("unroll") for (int k = 0; k < 2; ++k) dst[n][k] = *(const PG8_LAS bf16x8*)(lds + PG8_SB(b, h) + boff + n * 2048 + k * 1024); } } while (0)
#define PG8_MMA(ai, bj, At, Bt, FST) do { __builtin_amdgcn_s_setprio(1); if constexpr (F8) { if (FST) { _Pragma("unroll") for (int m = 0; m < 4; ++m) _Pragma("unroll") for (int n = 0; n < 2; ++n) \
        asm volatile("v_mfma_scale_f32_16x16x128_f8f6f4 %0, %1, %2, 0, %3, %4 op_sel_hi:[0,0,0]" : "=&v"(acc[ai][bj][m][n]) : "v"(Bt##8[n]), "v"(At##8[m]), "v"(f8sw), "v"(f8sa)); } else { \
        _Pragma("unroll") for (int m = 0; m < 4; ++m) _Pragma("unroll") for (int n = 0; n < 2; ++n) \
        asm volatile("v_mfma_scale_f32_16x16x128_f8f6f4 %0, %1, %2, %0, %3, %4 op_sel_hi:[0,0,0]" : "+v"(acc[ai][bj][m][n]) : "v"(Bt##8[n]), "v"(At##8[m]), "v"(f8sw), "v"(f8sa)); } } else { \
        if (FST) { _Pragma("unroll") for (int m = 0; m < 4; ++m) _Pragma("unroll") for (int n = 0; n < 2; ++n) { \
            acc[ai][bj][m][n] = g.emu ? __builtin_amdgcn_mfma_f32_16x16x32_bf16(emu8v(Bt[n][0]), emu8v(At[m][0]), (f32x4){0.f, 0.f, 0.f, 0.f}, 0, 0, 0) : __builtin_amdgcn_mfma_f32_16x16x32_bf16(Bt[n][0], At[m][0], (f32x4){0.f, 0.f, 0.f, 0.f}, 0, 0, 0); \
            acc[ai][bj][m][n] = g.emu ? __builtin_amdgcn_mfma_f32_16x16x32_bf16(emu8v(Bt[n][1]), emu8v(At[m][1]), acc[ai][bj][m][n], 0, 0, 0) : __builtin_amdgcn_mfma_f32_16x16x32_bf16(Bt[n][1], At[m][1], acc[ai][bj][m][n], 0, 0, 0); } } else \
        _Pragma("unroll") for (int m = 0; m < 4; ++m) _Pragma("unroll") for (int n = 0; n < 2; ++n) _Pragma("unroll") for (int k = 0; k < 2; ++k) \
        acc[ai][bj][m][n] = g.emu ? __builtin_amdgcn_mfma_f32_16x16x32_bf16(emu8v(Bt[n][k]), emu8v(At[m][k]), acc[ai][bj][m][n], 0, 0, 0) : __builtin_amdgcn_mfma_f32_16x16x32_bf16(Bt[n][k], At[m][k], acc[ai][bj][m][n], 0, 0, 0); } __builtin_amdgcn_s_setprio(0); } while (0)
#define PG8_WAIT_V(n) asm volatile("s_waitcnt vmcnt(" #n ")" ::: "memory")
#define PG8_WAIT_L(n) asm volatile("s_waitcnt lgkmcnt(" #n ")" ::: "memory")
#define PG8_BAR __builtin_amdgcn_s_barrier()
#define PG8_SCHED __builtin_amdgcn_sched_barrier(0)
    Unit cur, nxt; int ui = 0;
    if (!S.next(0, cur)) return;
    f32x4 acc[2][2][4][2];
#pragma unroll
    for (int a = 0; a < 2; ++a)
#pragma unroll
        for (int b = 0; b < 2; ++b)
#pragma unroll
            for (int m = 0; m < 4; ++m)
#pragma unroll
                for (int n = 0; n < 2; ++n) acc[a][b][m][n] = (f32x4){0.f, 0.f, 0.f, 0.f};
    const int f8sw = F8_SCL_W, f8sa = g.sa;
    bf16x8 At[4][2], B0[2][2], B1[2][2]; v8i_t At8[4], B08[2], B18[2];
    const char* cA = (const char*)g.A + (size_t)cur.pm * tstep + cur.kb; const char* cB = (const char*)g.Bt + (size_t)cur.pn * tstep + cur.kb;
    S.a_ready(cur);
    if constexpr (SP2) {
        PG8_STAGE(PG8_SB(0, 0), cB, voffB); PG8_STAGE(PG8_SB(0, 1), cB + hstep, voffB); PG8_STAGE(PG8_SA(0, 0), cA, voffA); PG8_STAGE(PG8_SA(0, 1), cA + hstep, voffA);
        if (wr == 1) PG8_BAR;
        PG8_WAIT_V(2); PG8_BAR;
        PG8_STAGE(PG8_SB(1, 0), cB + kstep, voffB); PG8_STAGE(PG8_SA(1, 0), cA + kstep, voffA); PG8_STAGE(PG8_SB(1, 1), cB + hstep + kstep, voffB);
        PG8_WAIT_V(6); PG8_BAR;
    } else {
        PG8_STAGE(PG8_SB(0, 0), cB, voffB); PG8_STAGE(PG8_SA(0, 0), cA, voffA); PG8_STAGE(PG8_SB(0, 1), cB + hstep, voffB); PG8_STAGE(PG8_SA(0, 1), cA + hstep, voffA);
        if (wr == 1) PG8_BAR;
        PG8_WAIT_V(4); PG8_BAR;
        PG8_STAGE(PG8_SB(1, 0), cB + kstep, voffB); PG8_STAGE(PG8_SA(1, 0), cA + kstep, voffA); PG8_STAGE(PG8_SB(1, 1), cB + hstep + kstep, voffB);
        PG8_WAIT_V(6); PG8_BAR;
    }
    for (;;) {
        const bool has_next = S.next(ui + 1, nxt);
        const char* nA = has_next ? (const char*)g.A + (size_t)nxt.pm * tstep + nxt.kb : cA; const char* nB = has_next ? (const char*)g.Bt + (size_t)nxt.pn * tstep + nxt.kb : cB;
        for (int t = 0; t < nt; t += 2) {
            const bool last = (t == nt - 2); const bool first_ = (t == 0);
            const char* a1 = cA + (size_t)(t + 1) * kstep;
            const char* a2 = last ? nA : cA + (size_t)(t + 2) * kstep; const char* b2 = last ? nB : cB + (size_t)(t + 2) * kstep;
            const char* a3 = a2 + kstep; const char* b3 = b2 + kstep;
            if (last && has_next) S.a_ready(nxt);
            if constexpr (SP2) {
            PG8_LDB(B0, 0, 0); PG8_LDB(B1, 0, 1); PG8_SCHED; PG8_LDA(At, 0, 0); PG8_STAGE(PG8_SA(1, 1), a1 + hstep, voffA);
            PG8_WAIT_V(8); PG8_WAIT_L(0); PG8_BAR; PG8_MMA(0, 0, At, B0, first_); PG8_MMA(0, 1, At, B1, first_); PG8_BAR; PG8_SCHED;
            PG8_LDA(At, 0, 1); PG8_STAGE(PG8_SB(0, 0), b2, voffB); PG8_STAGE(PG8_SB(0, 1), b2 + hstep, voffB); PG8_STAGE(PG8_SA(0, 0), a2, voffA);
            PG8_WAIT_V(8); PG8_WAIT_L(0); PG8_BAR; PG8_MMA(1, 0, At, B0, first_); PG8_MMA(1, 1, At, B1, first_); PG8_BAR; PG8_SCHED;
            PG8_LDB(B0, 1, 0); PG8_LDB(B1, 1, 1); PG8_SCHED; PG8_LDA(At, 1, 0); PG8_STAGE(PG8_SA(0, 1), a2 + hstep, voffA);
            PG8_WAIT_V(8); PG8_WAIT_L(0); PG8_BAR; PG8_MMA(0, 0, At, B0, false); PG8_MMA(0, 1, At, B1, false); PG8_BAR; PG8_SCHED;
            PG8_LDA(At, 1, 1); PG8_STAGE(PG8_SB(1, 0), b3, voffB); PG8_STAGE(PG8_SB(1, 1), b3 + hstep, voffB); PG8_STAGE(PG8_SA(1, 0), a3, voffA);
            PG8_WAIT_V(8); PG8_WAIT_L(0); PG8_BAR; PG8_MMA(1, 0, At, B0, false); PG8_MMA(1, 1, At, B1, false); PG8_BAR; PG8_SCHED;
            } else {
            PG8_LDB(B0, 0, 0); PG8_SCHED; PG8_LDA(At, 0, 0); PG8_STAGE(PG8_SA(1, 1), a1 + hstep, voffA);
            PG8_WAIT_L(8); PG8_BAR; PG8_WAIT_L(0); PG8_MMA(0, 0, At, B0, first_); PG8_BAR; PG8_SCHED;
            PG8_LDB(B1, 0, 1); PG8_STAGE(PG8_SB(0, 0), b2, voffB);
            PG8_BAR; PG8_WAIT_L(0); PG8_MMA(0, 1, At, B1, first_); PG8_BAR;
            PG8_LDA(At, 0, 1); PG8_STAGE(PG8_SA(0, 0), a2, voffA);
            PG8_BAR; PG8_WAIT_L(0); PG8_MMA(1, 0, At, B0, first_); PG8_BAR; PG8_SCHED;
            PG8_STAGE(PG8_SB(0, 1), b2 + hstep, voffB);
            PG8_WAIT_V(6); PG8_BAR; PG8_MMA(1, 1, At, B1, first_); PG8_BAR;
            PG8_LDB(B0, 1, 0); PG8_SCHED; PG8_LDA(At, 1, 0); PG8_STAGE(PG8_SA(0, 1), a2 + hstep, voffA);
            PG8_WAIT_L(8); PG8_BAR; PG8_WAIT_L(0); PG8_MMA(0, 0, At, B0, false); PG8_BAR; PG8_SCHED;
            PG8_LDB(B1, 1, 1); PG8_STAGE(PG8_SB(1, 0), b3, voffB);
            PG8_BAR; PG8_WAIT_L(0); PG8_MMA(0, 1, At, B1, false); PG8_BAR;
            PG8_LDA(At, 1, 1); PG8_STAGE(PG8_SA(1, 0), a3, voffA);
            PG8_BAR; PG8_WAIT_L(0); PG8_MMA(1, 0, At, B0, false); PG8_BAR; PG8_SCHED;
            PG8_STAGE(PG8_SB(1, 1), b3 + hstep, voffB);
            PG8_WAIT_V(6); PG8_BAR; PG8_MMA(1, 1, At, B1, false); PG8_BAR;
            }
        }
        if constexpr (F8) asm volatile("s_nop 15\n\ts_nop 15" ::: "memory");
        if constexpr (ALIGN_EPI) { if (wr == 0) PG8_BAR; }
#ifdef EPI_DBL
        if constexpr (F8 && ALIGN_EPI) { E(acc, cur, wr, wc, fr, fq); asm volatile("" ::: "memory");
            _Pragma("unroll") for (int a = 0; a < 2; ++a) _Pragma("unroll") for (int b = 0; b < 2; ++b) _Pragma("unroll") for (int m = 0; m < 4; ++m) _Pragma("unroll") for (int n = 0; n < 2; ++n) asm volatile("" : "+v"(acc[a][b][m][n])); }
#endif
        if constexpr (!Epi::AFTER_DRAIN) { E(acc, cur, wr, wc, fr, fq); S.done(cur); }
        if (!has_next) break;
        if constexpr (false)
#pragma unroll
        for (int a = 0; a < 2; ++a)
#pragma unroll
            for (int b = 0; b < 2; ++b)
#pragma unroll
                for (int m = 0; m < 4; ++m)
#pragma unroll
                    for (int n = 0; n < 2; ++n) acc[a][b][m][n] = (f32x4){0.f, 0.f, 0.f, 0.f};
        cur = nxt; cA = nA; cB = nB; ++ui;
        if constexpr (ALIGN_EPI) { if (wr == 1) PG8_BAR; }
    }
    PG8_WAIT_V(0);
    if constexpr (!ALIGN_EPI) { if (wr == 0) PG8_BAR; }
    PG8_BAR;
    if constexpr (Epi::AFTER_DRAIN) { E.fused(acc, cur, wr, wc, fr, fq, lds, wid, lane); S.done(cur); }
#undef PG8_SA
#undef PG8_SB
#undef PG8_STAGE
#undef PG8_LDA
#undef PG8_LDB
#undef PG8_MMA
#undef PG8_WAIT_V
#undef PG8_WAIT_L
#undef PG8_BAR
#undef PG8_SCHED
}
}

#ifndef DBG_BREAK
#define DBG_BREAK 0
#endif
namespace att {
#ifndef OSTAGE
#define OSTAGE 1
#endif
constexpr int NW = 8, QBLK = 32, KVBLK = 64;
constexpr float THR_L2 = 11.5f;
#define SBAR() __builtin_amdgcn_sched_barrier(0)
__device__ __forceinline__ int crow(int r, int hi) { return (r & 3) + 8 * (r >> 2) + 4 * hi; }
template <int DQK> __device__ __forceinline__ int ksw(int row) { return (DQK == 128) ? (row & 15) : ((row >> 1) & 7); }
template <int DQK> __device__ __forceinline__ int kswz(int row, int colB) { return row * (DQK * 2) + (colB ^ (ksw<DQK>(row) << 4)); }
template <int DQK> constexpr int NKB = (DQK == 128) ? 8 : 4;
#define KADDR(kbarr, d0) ((DQK == 128) ? (kbarr)[(d0) & (NKB<DQK> - 1)] : (kbarr)[(d0) & 3] + ((d0) >> 2) * 128)
template <int DV> __device__ __forceinline__ int v_st(int k, int c) { const int kk = (k & ~0xC) | ((k & 4) << 1) | ((k & 8) >> 1); return ((kk >> 3) * (DV / 32) + (c >> 5)) * 512 + ((kk & 7) * 32 + (c & 31)) * 2; }
__device__ __forceinline__ int v_rd_base(int lane) { return ((lane & 3) << 3) | (((lane >> 2) & 3) << 6) | (((lane >> 4) & 1) << 5) | (((lane >> 5) & 1) << 8); }
template <int DV> constexpr int v_rd_off(int d0, int ks, int half) { return d0 * 512 + ks * (2 * (DV / 32) * 512) + half * ((DV / 32) * 512); }
template <int OFF> __device__ __forceinline__ s16x4 tr_read(int vb) {
    s16x4 r; asm volatile("ds_read_b64_tr_b16 %0, %1 offset:%2" : "=&v"(r) : "v"(vb), "i"(OFF) : "memory"); return r;
}
__device__ __forceinline__ void band_mask(f32x16& p0, f32x16& p1, int d  , int hi) {
#pragma unroll
    for (int r = 0; r < 16; ++r) { const int d0 = d + crow(r, hi), d1 = d0 + 32;
        if (d0 < -128 || d0 > 128) p0[r] = -1e30f; if (d1 < -128 || d1 > 128) p1[r] = -1e30f; }
}
__device__ __forceinline__ void partialSM(f32x16& p0, f32x16& p1, float& m_reg, float& mn, float& alpha) {
    float ma = fmaxf(p0[0], p0[1]), mb = fmaxf(p0[2], p0[3]), mc = fmaxf(p1[0], p1[1]), md = fmaxf(p1[2], p1[3]);
#pragma unroll
    for (int r = 4; r < 16; r += 4) { ma = fmaxf(fmaxf(ma, p0[r]), p0[r + 1]); mb = fmaxf(fmaxf(mb, p0[r + 2]), p0[r + 3]); mc = fmaxf(fmaxf(mc, p1[r]), p1[r + 1]); md = fmaxf(fmaxf(md, p1[r + 2]), p1[r + 3]); }
    float pmax = fmaxf(fmaxf(ma, mb), fmaxf(mc, md));
    { auto rr = __builtin_amdgcn_permlane32_swap(__float_as_uint(pmax), __float_as_uint(pmax), false, false);
      pmax = fmaxf(__uint_as_float(rr[0]), __uint_as_float(rr[1])); }
    if (__builtin_expect(__all(pmax - m_reg <= THR_L2), 1)) { mn = m_reg; alpha = 1.f; }
    else { mn = fmaxf(m_reg, pmax); alpha = __builtin_amdgcn_exp2f(m_reg - mn); m_reg = mn; }
#pragma unroll
    for (int r = 0; r < 16; ++r) p0[r] = p0[r] - mn;
#pragma unroll
    for (int r = 0; r < 16; ++r) p1[r] = p1[r] - mn;
#pragma unroll
    for (int r = 0; r < 16; ++r) p0[r] = __builtin_amdgcn_exp2f(p0[r]);
}
__device__ __forceinline__ void finishSM(f32x16& p0, f32x16& p1, float alpha, float& l_reg, bf16x8& pa0, bf16x8& pa1, bf16x8& pa2, bf16x8& pa3) {
#pragma unroll
    for (int r = 0; r < 16; ++r) p1[r] = __builtin_amdgcn_exp2f(p1[r]);
    float sa = p0[0] + p0[1], sb = p0[2] + p0[3], sc = p1[0] + p1[1], sd = p1[2] + p1[3];
#pragma unroll
    for (int r = 4; r < 16; r += 4) { sa += p0[r] + p0[r + 1]; sb += p0[r + 2] + p0[r + 3]; sc += p1[r] + p1[r + 1]; sd += p1[r + 2] + p1[r + 3]; }
    float ps = (sa + sb) + (sc + sd);
    { auto rr = __builtin_amdgcn_permlane32_swap(__float_as_uint(ps), __float_as_uint(ps), false, false);
      ps = __uint_as_float(rr[0]) + __uint_as_float(rr[1]); }
    l_reg = l_reg * alpha + ps;
#define PK4(P, BASE, OUT) do { unsigned a0 = cvt_pk_bf16(P[BASE + 0], P[BASE + 1]), a1 = cvt_pk_bf16(P[BASE + 2], P[BASE + 3]);   \
    unsigned b0 = cvt_pk_bf16(P[BASE + 4], P[BASE + 5]), b1 = cvt_pk_bf16(P[BASE + 6], P[BASE + 7]);                              \
    auto r0 = __builtin_amdgcn_permlane32_swap(a0, b0, false, false); auto r1 = __builtin_amdgcn_permlane32_swap(a1, b1, false, false); \
    u32x4 w = {r0[0], r1[0], r0[1], r1[1]}; OUT = *reinterpret_cast<bf16x8*>(&w); } while (0)
    PK4(p0, 0, pa0); PK4(p0, 8, pa1); PK4(p1, 0, pa2); PK4(p1, 8, pa3);
#undef PK4
}
template <int DQK, int QSP, int BOFF> __device__ __forceinline__ void qkt(f32x16& p0, f32x16& p1, const int (&kb)[NKB<DQK>], const bf16x8 (&qr)[DQK / 16 - QSP], const LAS char* qsp) {
    p0 = f32x16{}; p1 = f32x16{};
#pragma unroll
    for (int d0 = 0; d0 < DQK / 16; ++d0) {
        const bf16x8 b0 = *reinterpret_cast<const LAS bf16x8*>((uintptr_t)(unsigned)(KADDR(kb, d0) + BOFF));
        const bf16x8 b1 = *reinterpret_cast<const LAS bf16x8*>((uintptr_t)(unsigned)(KADDR(kb, d0) + BOFF + 32 * DQK * 2));
        bf16x8 qf;
        if constexpr (QSP > 0) { if (d0 >= DQK / 16 - QSP) qf = *reinterpret_cast<const volatile LAS bf16x8*>(qsp + (d0 - (DQK / 16 - QSP)) * 1024); else qf = qr[d0 < DQK / 16 - QSP ? d0 : 0]; }
        else qf = qr[d0];
        p0 = __builtin_amdgcn_mfma_f32_32x32x16_bf16(b0, qf, p0, 0, 0, 0);
        p1 = __builtin_amdgcn_mfma_f32_32x32x16_bf16(b1, qf, p1, 0, 0, 0); }
}
#ifndef PV_BUILTIN
#define PV_BUILTIN 1
#endif
typedef short v4i16_t __attribute__((ext_vector_type(4)));
template <int OFF> __device__ __forceinline__ s16x4 tr_read_b(int vb) {
    return __builtin_bit_cast(s16x4, __builtin_amdgcn_ds_read_tr16_b64_v4i16((LAS v4i16_t*)(uintptr_t)(unsigned)(vb + OFF)));
}
template <int DV, int D0, bool BI> __device__ __forceinline__ void pv_one(f32x16& od, int vb, bf16x8 pa0, bf16x8 pa1, bf16x8 pa2, bf16x8 pa3) {
  s16x4 l0, h0, l1, h1, l2, h2, l3, h3;
  if constexpr (BI && PV_BUILTIN) {
    l0 = tr_read_b<v_rd_off<DV>(D0, 0, 0)>(vb); h0 = tr_read_b<v_rd_off<DV>(D0, 0, 1)>(vb); l1 = tr_read_b<v_rd_off<DV>(D0, 1, 0)>(vb); h1 = tr_read_b<v_rd_off<DV>(D0, 1, 1)>(vb);
    l2 = tr_read_b<v_rd_off<DV>(D0, 2, 0)>(vb); h2 = tr_read_b<v_rd_off<DV>(D0, 2, 1)>(vb); l3 = tr_read_b<v_rd_off<DV>(D0, 3, 0)>(vb); h3 = tr_read_b<v_rd_off<DV>(D0, 3, 1)>(vb);
  } else {
    l0 = tr_read<v_rd_off<DV>(D0, 0, 0)>(vb); h0 = tr_read<v_rd_off<DV>(D0, 0, 1)>(vb); l1 = tr_read<v_rd_off<DV>(D0, 1, 0)>(vb); h1 = tr_read<v_rd_off<DV>(D0, 1, 1)>(vb);
    l2 = tr_read<v_rd_off<DV>(D0, 2, 0)>(vb); h2 = tr_read<v_rd_off<DV>(D0, 2, 1)>(vb); l3 = tr_read<v_rd_off<DV>(D0, 3, 0)>(vb); h3 = tr_read<v_rd_off<DV>(D0, 3, 1)>(vb);
    asm volatile("s_waitcnt lgkmcnt(0)" ::: "memory"); SBAR();
  }
#define PKV(L, H) (bf16x8){L[0], L[1], L[2], L[3], H[0], H[1], H[2], H[3]}
    od = __builtin_amdgcn_mfma_f32_32x32x16_bf16(pa0, PKV(l0, h0), od, 0, 0, 0);
    od = __builtin_amdgcn_mfma_f32_32x32x16_bf16(pa1, PKV(l1, h1), od, 0, 0, 0);
    od = __builtin_amdgcn_mfma_f32_32x32x16_bf16(pa2, PKV(l2, h2), od, 0, 0, 0);
    od = __builtin_amdgcn_mfma_f32_32x32x16_bf16(pa3, PKV(l3, h3), od, 0, 0, 0);
#undef PKV
}
template <int DV, bool BI = true> __device__ __forceinline__ void pv_all(f32x16 (&o)[DV / 32], int vb, bf16x8 pa0, bf16x8 pa1, bf16x8 pa2, bf16x8 pa3) {
    pv_one<DV, 0, BI>(o[0], vb, pa0, pa1, pa2, pa3); pv_one<DV, 1, BI>(o[1], vb, pa0, pa1, pa2, pa3);
    if constexpr (DV == 128) { pv_one<DV, 2, BI>(o[2], vb, pa0, pa1, pa2, pa3); pv_one<DV, 3, BI>(o[3], vb, pa0, pa1, pa2, pa3); }
}

template <int DQK, int DV, bool MASK, int SDEPTH, int QSP, int ldq, int ldk, int ldv, int ldo, bool O8 = false>
__device__ __forceinline__ void attn_unit(const bf16_t* __restrict__ Qb, const bf16_t* __restrict__ Kh, const bf16_t* __restrict__ Vh,
                                          bf16_t* __restrict__ Ob, int NT, int lo, float m_init, float l_init, int qpos0, LAS char* lds) {
    constexpr int SHM_K = KVBLK * DQK * 2, SHM_V = KVBLK * DV * 2, NKP = DQK / 64, NVP = DV / 64, LPT = NKP + NVP, ND0 = DQK / 16, NDV = DV / 32;
    const int tid = opaque_tid(), wid = tid >> 6, lane = tid & 63, r32 = lane & 31, hi = lane >> 5;
    LAS char* V_lds = lds; LAS char* K_lds = lds + 2 * SHM_V;
    LAS float* ws = (LAS float*)(lds + 2 * SHM_V + 2 * SHM_K) + wid * 64; LAS float* li_l = ws; LAS float* al_l = ws + 32;
    float m_reg = m_init, l_reg = l_init; f32x16 o[NDV]; bf16x8 qr[ND0 - QSP];
    LAS char* qsp = lds + 2 * SHM_V + 2 * SHM_K + 2048 + wid * (QSP * 1024) + lane * 16;
#pragma unroll
    for (int d = 0; d < NDV; ++d) o[d] = f32x16{};
    const bf16_t* Qw = Qb + (long)(wid * QBLK + r32) * ldq + hi * 8;
#pragma unroll
    for (int d0 = 0; d0 < ND0; ++d0) { const bf16x8 qv = *reinterpret_cast<const bf16x8*>(Qw + d0 * 16); if (d0 < ND0 - QSP) qr[d0 < ND0 - QSP ? d0 : 0] = qv; else *reinterpret_cast<LAS bf16x8*>(qsp + (d0 - (ND0 - QSP)) * 1024) = qv; }
    const int srow = tid >> 3, sc0 = (tid & 7) * 8;
    const int koff0 = srow * ldk + sc0, voff0 = srow * ldv + sc0, vst0 = v_st<DV>(srow, sc0);
    int kst[NKP];
#pragma unroll
    for (int q = 0; q < NKP; ++q) kst[q] = kswz<DQK>(srow, sc0 * 2 + 128 * q);
    const int vb0 = (int)(uintptr_t)V_lds + v_rd_base(lane);
    int kb[NKB<DQK>];
#pragma unroll
    for (int x = 0; x < NKB<DQK>; ++x) kb[x] = (int)(uintptr_t)K_lds + r32 * (DQK * 2) + ((x * 32 + hi * 16) ^ (ksw<DQK>(r32) << 4));
    struct { bf16x8 k[NKP], v[NVP]; } sr_[SDEPTH];
#define KT(j) ((j) < 4 ? (j) : (j) + lo)
#define SLOAD(i, j) do { const int kt_ = __builtin_amdgcn_readfirstlane(KT(j)); const bf16_t* Vt_ = Vh + (long)kt_ * (KVBLK * (long)ldv); const bf16_t* Kt_ = Kh + (long)kt_ * (KVBLK * (long)ldk); \
    _Pragma("unroll") for (int q_ = 0; q_ < NVP; ++q_) sr_[i].v[q_] = *reinterpret_cast<const bf16x8*>(Vt_ + voff0 + 64 * q_); \
    _Pragma("unroll") for (int q_ = 0; q_ < NKP; ++q_) sr_[i].k[q_] = *reinterpret_cast<const bf16x8*>(Kt_ + koff0 + 64 * q_); } while (0)
#define SWRITE(b, i) do { \
    _Pragma("unroll") for (int q_ = 0; q_ < NVP; ++q_) *(LAS bf16x8*)(V_lds + (b) * SHM_V + vst0 + 1024 * q_) = sr_[i].v[q_]; \
    _Pragma("unroll") for (int q_ = 0; q_ < NKP; ++q_) *(LAS bf16x8*)(K_lds + (b) * SHM_K + kst[q_]) = sr_[i].k[q_]; } while (0)
#define SWAIT() asm volatile("s_waitcnt vmcnt(%0)" :: "n"(SDEPTH == 2 ? LPT : 0) : "memory")
#define RESC(a) do { if (__any((a) < 1.f)) { if (hi == 0) al_l[r32] = (a); asm volatile("s_waitcnt lgkmcnt(0)" ::: "memory"); \
    _Pragma("unroll") for (int d = 0; d < NDV; ++d) _Pragma("unroll") for (int r = 0; r < 16; ++r) o[d][r] *= al_l[crow(r, hi)]; } } while (0)
#define MASKT(P0, P1, j) do { if constexpr (MASK && DBG_BREAK != 4) { if ((j) >= 4) band_mask(P0, P1, (KT(j) - 4) * KVBLK - (qpos0 + wid * QBLK + r32), hi); } } while (0)
    f32x16 pA0, pA1, pB0, pB1; float mnA, mnB, alA, alB; bf16x8 pa0, pa1, pa2, pa3;
    constexpr int SE = 0, SO = SDEPTH - 1;
    SLOAD(SE, 0); asm volatile("s_waitcnt vmcnt(0)" ::: "memory"); SWRITE(0, SE); __syncthreads();
    qkt<DQK, QSP, 0>(pA0, pA1, kb, qr, qsp); MASKT(pA0, pA1, 0); partialSM(pA0, pA1, m_reg, mnA, alA);
    SLOAD(SO, 1); if (SDEPTH == 2 && 2 < NT) SLOAD(SE, 2);
    SWAIT(); SWRITE(1, SO); __syncthreads();
    for (int j = 1; j + 1 < NT; j += 2) {
        SBAR(); qkt<DQK, QSP, SHM_K>(pB0, pB1, kb, qr, qsp); MASKT(pB0, pB1, j);
        finishSM(pA0, pA1, alA, l_reg, pa0, pa1, pa2, pa3); SBAR();
        SLOAD(SO, j + SDEPTH); SBAR();
        pv_all<DV, (DQK != 192)>(o, vb0, pa0, pa1, pa2, pa3); partialSM(pB0, pB1, m_reg, mnB, alB);
        __syncthreads(); SWAIT(); SWRITE(0, SE);
        RESC(alB); __syncthreads();
        SBAR(); qkt<DQK, QSP, 0>(pA0, pA1, kb, qr, qsp); MASKT(pA0, pA1, j + 1);
        finishSM(pB0, pB1, alB, l_reg, pa0, pa1, pa2, pa3); SBAR();
        if (SDEPTH == 1 || j + 3 < NT) SLOAD(SE, j + 1 + SDEPTH); SBAR();
        pv_all<DV, (DQK != 192)>(o, vb0 + SHM_V, pa0, pa1, pa2, pa3); partialSM(pA0, pA1, m_reg, mnA, alA);
        __syncthreads(); SWAIT(); SWRITE(1, SO);
        RESC(alA); __syncthreads();
    }
    SBAR(); qkt<DQK, QSP, SHM_K>(pB0, pB1, kb, qr, qsp); MASKT(pB0, pB1, NT - 1);
    finishSM(pA0, pA1, alA, l_reg, pa0, pa1, pa2, pa3); SBAR();
    pv_all<DV, (DQK != 192)>(o, vb0, pa0, pa1, pa2, pa3); partialSM(pB0, pB1, m_reg, mnB, alB);
    __syncthreads(); RESC(alB);
    finishSM(pB0, pB1, alB, l_reg, pa0, pa1, pa2, pa3); SBAR();
    pv_all<DV, (DQK != 192)>(o, vb0 + SHM_V, pa0, pa1, pa2, pa3);
    if (hi == 0) li_l[r32] = l_reg; asm volatile("s_waitcnt lgkmcnt(0)" ::: "memory");
    float rli[16];
#pragma unroll
    for (int r = 0; r < 16; ++r) rli[r] = __builtin_amdgcn_rcpf(li_l[crow(r, hi)]);
    if constexpr (O8) {
        unsigned char* Ow8 = (unsigned char*)Ob + (long)(wid * QBLK) * ldo;
        if constexpr (OSTAGE && DQK != 192) {
            LAS unsigned char* stg8 = (LAS unsigned char*)(lds + 2 * SHM_V + 2 * SHM_K + 2048) + wid * (QBLK * DV);
#pragma unroll
            for (int r = 0; r < 16; ++r) { const int orow = crow(r, hi);
#pragma unroll
                for (int d0 = 0; d0 < NDV; ++d0) { const float x = F8CLAMP(o[d0][r] * rli[r] * 64.0f); stg8[orow * DV + d0 * 32 + r32] = (unsigned char)(__builtin_amdgcn_cvt_pk_fp8_f32(x, x, 0, false) & 0xffu); } }
            asm volatile("s_waitcnt lgkmcnt(0)" ::: "memory");
#pragma unroll
            for (int i = 0; i < QBLK * DV / 16 / 64; ++i) { const int c = i * 64 + lane, row = c / (DV / 16), ch = c % (DV / 16);
                const u32x4 v = *(const LAS u32x4*)(stg8 + row * DV + ch * 16); *(u32x4*)(Ow8 + (long)row * ldo + ch * 16) = v; }
        } else {
#pragma unroll
            for (int r = 0; r < 16; ++r) { const int orow = crow(r, hi);
#pragma unroll
                for (int d0 = 0; d0 < NDV; ++d0) { const float x = F8CLAMP(o[d0][r] * rli[r] * 64.0f); Ow8[(long)orow * ldo + d0 * 32 + r32] = (unsigned char)(__builtin_amdgcn_cvt_pk_fp8_f32(x, x, 0, false) & 0xffu); } }
        }
    } else {
    bf16_t* Ow = Ob + (long)(wid * QBLK) * ldo;
    if constexpr (OSTAGE && DQK != 192) {
        LAS bf16_t* stg = (LAS bf16_t*)(lds + 2 * SHM_V + 2 * SHM_K + 2048) + wid * (QBLK * DV);
#pragma unroll
        for (int r = 0; r < 16; ++r) { const int orow = crow(r, hi);
#pragma unroll
            for (int d0 = 0; d0 < NDV; ++d0) stg[orow * DV + d0 * 32 + r32] = (bf16_t)(cvt_pk_bf16(o[d0][r] * rli[r], 0.f) & 0xffffu); }
        asm volatile("s_waitcnt lgkmcnt(0)" ::: "memory");
#pragma unroll
        for (int i = 0; i < QBLK * DV / 8 / 64; ++i) { const int c = i * 64 + lane, row = c / (DV / 8), ch = c % (DV / 8);
            const u32x4 v = *(const LAS u32x4*)(stg + row * DV + ch * 8); *(u32x4*)(Ow + (long)row * ldo + ch * 8) = v; }
    } else {
#pragma unroll
    for (int r = 0; r < 16; ++r) { const int orow = crow(r, hi);
#pragma unroll
        for (int d0 = 0; d0 < NDV; ++d0) Ow[(long)orow * ldo + d0 * 32 + r32] = (bf16_t)(cvt_pk_bf16(o[d0][r] * rli[r], 0.f) & 0xffffu); }
    }
    }
    __syncthreads();
#undef KT
#undef SLOAD
#undef SWRITE
#undef SWAIT
#undef RESC
#undef MASKT
}

template <int DQK, int QSP> __device__ __forceinline__ void qkt_rt(f32x16& p0, f32x16& p1, const int (&kb)[NKB<DQK>], int boff, const bf16x8 (&qr)[DQK / 16 - QSP], const LAS char* qsp) {
    p0 = f32x16{}; p1 = f32x16{};
    int kbb[NKB<DQK>];
#pragma unroll
    for (int x = 0; x < NKB<DQK>; ++x) kbb[x] = kb[x] + boff;
#pragma unroll
    for (int d0 = 0; d0 < DQK / 16; ++d0) {
        const bf16x8 b0 = *reinterpret_cast<const LAS bf16x8*>((uintptr_t)(unsigned)(KADDR(kbb, d0)));
        const bf16x8 b1 = *reinterpret_cast<const LAS bf16x8*>((uintptr_t)(unsigned)(KADDR(kbb, d0) + 32 * DQK * 2));
        bf16x8 qf;
        if constexpr (QSP > 0) { if (d0 >= DQK / 16 - QSP) qf = *reinterpret_cast<const volatile LAS bf16x8*>(qsp + (d0 - (DQK / 16 - QSP)) * 1024); else qf = qr[d0 < DQK / 16 - QSP ? d0 : 0]; }
        else qf = qr[d0];
        p0 = __builtin_amdgcn_mfma_f32_32x32x16_bf16(b0, qf, p0, 0, 0, 0);
        p1 = __builtin_amdgcn_mfma_f32_32x32x16_bf16(b1, qf, p1, 0, 0, 0); }
}
template <int DQK, int DV, bool MASK, int QSP, int ldq, int ldk, int ldv, int ldo>
__device__ __forceinline__ void attn_unit3(const bf16_t* __restrict__ Qb, const bf16_t* __restrict__ Kh, const bf16_t* __restrict__ Vh,
                                           bf16_t* __restrict__ Ob, int NT, int lo, float m_init, float l_init, int qpos0, LAS char* lds) {
    constexpr int SHM_K = KVBLK * DQK * 2, SHM_V = KVBLK * DV * 2, NKP = DQK / 64, NVP = DV / 64, ND0 = DQK / 16, NDV = DV / 32;
    const int tid = opaque_tid(), wid = tid >> 6, lane = tid & 63, r32 = lane & 31, hi = lane >> 5;
    LAS char* V_lds = lds; LAS char* K_lds = lds + 3 * SHM_V;
    LAS float* ws = (LAS float*)(lds + 3 * SHM_V + 3 * SHM_K) + wid * 64; LAS float* li_l = ws; LAS float* al_l = ws + 32;
    float m_reg = m_init, l_reg = l_init; f32x16 o[NDV]; bf16x8 qr[ND0 - QSP];
    LAS char* qsp = lds + 3 * SHM_V + 3 * SHM_K + 2048 + wid * (QSP * 1024) + lane * 16;
#pragma unroll
    for (int d = 0; d < NDV; ++d) o[d] = f32x16{};
    const bf16_t* Qw = Qb + (long)(wid * QBLK + r32) * ldq + hi * 8;
#pragma unroll
    for (int d0 = 0; d0 < ND0; ++d0) { const bf16x8 qv = *reinterpret_cast<const bf16x8*>(Qw + d0 * 16); if (d0 < ND0 - QSP) qr[d0 < ND0 - QSP ? d0 : 0] = qv; else *reinterpret_cast<LAS bf16x8*>(qsp + (d0 - (ND0 - QSP)) * 1024) = qv; }
    const int srow = tid >> 3, sc0 = (tid & 7) * 8;
    const int koff0 = srow * ldk + sc0, voff0 = srow * ldv + sc0, vst0 = (int)(uintptr_t)V_lds + v_st<DV>(srow, sc0);
    int kst[NKP];
#pragma unroll
    for (int q = 0; q < NKP; ++q) kst[q] = (int)(uintptr_t)K_lds + kswz<DQK>(srow, sc0 * 2 + 128 * q);
    const int vb0 = (int)(uintptr_t)V_lds + v_rd_base(lane);
    int kb[NKB<DQK>];
#pragma unroll
    for (int x = 0; x < NKB<DQK>; ++x) kb[x] = (int)(uintptr_t)K_lds + r32 * (DQK * 2) + ((x * 32 + hi * 16) ^ (ksw<DQK>(r32) << 4));
    bf16x8 sk[NKP], sv[NVP];
#define KT(j) ((j) < 4 ? (j) : (j) + lo)
#define SLOAD3(j) do { const int kt_ = __builtin_amdgcn_readfirstlane(KT(j)); const bf16_t* Vt_ = Vh + (long)kt_ * (KVBLK * (long)ldv); const bf16_t* Kt_ = Kh + (long)kt_ * (KVBLK * (long)ldk); \
    _Pragma("unroll") for (int q_ = 0; q_ < NVP; ++q_) sv[q_] = *reinterpret_cast<const bf16x8*>(Vt_ + voff0 + 64 * q_); \
    _Pragma("unroll") for (int q_ = 0; q_ < NKP; ++q_) sk[q_] = *reinterpret_cast<const bf16x8*>(Kt_ + koff0 + 64 * q_); } while (0)
#define SWRITE3(bi) do { \
    _Pragma("unroll") for (int q_ = 0; q_ < NVP; ++q_) *reinterpret_cast<LAS bf16x8*>((uintptr_t)(unsigned)(vst0 + (bi) * SHM_V + 1024 * q_)) = sv[q_]; \
    _Pragma("unroll") for (int q_ = 0; q_ < NKP; ++q_) *reinterpret_cast<LAS bf16x8*>((uintptr_t)(unsigned)(kst[q_] + (bi) * SHM_K)) = sk[q_]; } while (0)
#define RESC(a) do { if (__any((a) < 1.f)) { if (hi == 0) al_l[r32] = (a); asm volatile("s_waitcnt lgkmcnt(0)" ::: "memory"); \
    _Pragma("unroll") for (int d = 0; d < NDV; ++d) _Pragma("unroll") for (int r = 0; r < 16; ++r) o[d][r] *= al_l[crow(r, hi)]; } } while (0)
#define MASKT(P0, P1, j) do { if constexpr (MASK && DBG_BREAK != 4) { if ((j) >= 4) band_mask(P0, P1, (KT(j) - 4) * KVBLK - (qpos0 + wid * QBLK + r32), hi); } } while (0)
    f32x16 pA0, pA1, pB0, pB1; float mnA, mnB, alA, alB; bf16x8 pa0, pa1, pa2, pa3;
    int bp = 2, bc = 0, bn = 1;
#define ROT3() do { const int t_ = bp; bp = bc; bc = bn; bn = t_; } while (0)
#ifndef SGB
#define SGB 0
#endif
#define SGB_QK() do { if (SGB) { __builtin_amdgcn_sched_group_barrier(0x100, 2 * ND0, 0); _Pragma("unroll") for (int g_ = 0; g_ < 2 * ND0; ++g_) { __builtin_amdgcn_sched_group_barrier(0x008, 1, 0); __builtin_amdgcn_sched_group_barrier(0x002, 8, 0); } } } while (0)
#define SGB_PV() do { if (SGB) { __builtin_amdgcn_sched_group_barrier(0x100, 8, 0); \
        _Pragma("unroll") for (int g_ = 0; g_ < 4 * NDV - 4; ++g_) { __builtin_amdgcn_sched_group_barrier(0x008, 1, 0); __builtin_amdgcn_sched_group_barrier(0x100, 2, 0); __builtin_amdgcn_sched_group_barrier(0x002, 6, 0); } \
        _Pragma("unroll") for (int g_ = 0; g_ < 4; ++g_) { __builtin_amdgcn_sched_group_barrier(0x008, 1, 0); __builtin_amdgcn_sched_group_barrier(0x002, 6, 0); } } } while (0)
#define ITER(X0, X1, MNX, ALX, Y0, Y1, ALY, j) do { SBAR(); qkt_rt<DQK, QSP>(X0, X1, kb, bc * SHM_K, qr, qsp); MASKT(X0, X1, j); \
        finishSM(Y0, Y1, ALY, l_reg, pa0, pa1, pa2, pa3); SGB_QK(); SBAR(); \
        if ((j) + 1 < NT) { SWRITE3(bn); } if ((j) + 2 < NT) { SLOAD3((j) + 2); } SBAR(); \
        pv_all<DV>(o, vb0 + bp * SHM_V, pa0, pa1, pa2, pa3); partialSM(X0, X1, m_reg, MNX, ALX); SGB_PV(); SBAR(); \
        RESC(ALX); __syncthreads(); ROT3(); } while (0)
    SLOAD3(0); asm volatile("s_waitcnt vmcnt(0)" ::: "memory"); SWRITE3(0); SLOAD3(1); __syncthreads();
    qkt_rt<DQK, QSP>(pA0, pA1, kb, 0, qr, qsp); MASKT(pA0, pA1, 0); partialSM(pA0, pA1, m_reg, mnA, alA);
    SWRITE3(1); if (2 < NT) { SLOAD3(2); } __syncthreads();
    bp = 0; bc = 1; bn = 2;
    for (int j = 1; j + 1 < NT; j += 2) {
        ITER(pB0, pB1, mnB, alB, pA0, pA1, alA, j);
        ITER(pA0, pA1, mnA, alA, pB0, pB1, alB, j + 1);
    }
    ITER(pB0, pB1, mnB, alB, pA0, pA1, alA, NT - 1);
    finishSM(pB0, pB1, alB, l_reg, pa0, pa1, pa2, pa3); SBAR();
    pv_all<DV>(o, vb0 + bp * SHM_V, pa0, pa1, pa2, pa3);
    if (hi == 0) li_l[r32] = l_reg; asm volatile("s_waitcnt lgkmcnt(0)" ::: "memory");
    float rli[16];
#pragma unroll
    for (int r = 0; r < 16; ++r) rli[r] = __builtin_amdgcn_rcpf(li_l[crow(r, hi)]);
    bf16_t* Ow = Ob + (long)(wid * QBLK) * ldo;
    if constexpr (OSTAGE && DQK != 192) {
        LAS bf16_t* stg = (LAS bf16_t*)(lds + 3 * SHM_V + 3 * SHM_K + 2048) + wid * (QBLK * DV);
#pragma unroll
        for (int r = 0; r < 16; ++r) { const int orow = crow(r, hi);
#pragma unroll
            for (int d0 = 0; d0 < NDV; ++d0) stg[orow * DV + d0 * 32 + r32] = (bf16_t)(cvt_pk_bf16(o[d0][r] * rli[r], 0.f) & 0xffffu); }
        asm volatile("s_waitcnt lgkmcnt(0)" ::: "memory");
#pragma unroll
        for (int i = 0; i < QBLK * DV / 8 / 64; ++i) { const int c = i * 64 + lane, row = c / (DV / 8), ch = c % (DV / 8);
            const u32x4 v = *(const LAS u32x4*)(stg + row * DV + ch * 8); *(u32x4*)(Ow + (long)row * ldo + ch * 8) = v; }
    } else {
#pragma unroll
    for (int r = 0; r < 16; ++r) { const int orow = crow(r, hi);
#pragma unroll
        for (int d0 = 0; d0 < NDV; ++d0) Ow[(long)orow * ldo + d0 * 32 + r32] = (bf16_t)(cvt_pk_bf16(o[d0][r] * rli[r], 0.f) & 0xffffu); }
    }
    __syncthreads();
#undef KT
#undef SLOAD3
#undef SWRITE3
#undef RESC
#undef MASKT
#undef ROT3
#undef ITER
}

template <int DQK, int DV, bool MASK, int QSP, int ldq, int ldk, int ldv, int ldo>
__device__ __forceinline__ void attn_unit4(const bf16_t* __restrict__ Qb, const bf16_t* __restrict__ Kh, const bf16_t* __restrict__ Vh,
                                           bf16_t* __restrict__ Ob, int NT, int lo, float m_init, float l_init, int qpos0, LAS char* lds) {
    constexpr int SHM_K = KVBLK * DQK * 2, SHM_V = KVBLK * DV * 2, NKP = DQK / 64, NVP = DV / 64, ND0 = DQK / 16, NDV = DV / 32;
    const int tid = opaque_tid(), wid = tid >> 6, lane = tid & 63, r32 = lane & 31, hi = lane >> 5;
    LAS char* V_lds = lds; LAS char* K_lds = lds + 4 * SHM_V;
    LAS float* ws = (LAS float*)(lds + 4 * SHM_V + 4 * SHM_K) + wid * 64; LAS float* li_l = ws; LAS float* al_l = ws + 32;
    float m_reg = m_init, l_reg = l_init; f32x16 o[NDV]; bf16x8 qr[ND0 - QSP];
    LAS char* qsp = lds + 4 * SHM_V + 4 * SHM_K + 2048 + wid * (QSP * 1024) + lane * 16;
#pragma unroll
    for (int d = 0; d < NDV; ++d) o[d] = f32x16{};
    const bf16_t* Qw = Qb + (long)(wid * QBLK + r32) * ldq + hi * 8;
#pragma unroll
    for (int d0 = 0; d0 < ND0; ++d0) { const bf16x8 qv = *reinterpret_cast<const bf16x8*>(Qw + d0 * 16); if (d0 < ND0 - QSP) qr[d0 < ND0 - QSP ? d0 : 0] = qv; else *reinterpret_cast<LAS bf16x8*>(qsp + (d0 - (ND0 - QSP)) * 1024) = qv; }
    const int srow = tid >> 3, sc0 = (tid & 7) * 8;
    const int koff0 = srow * ldk + sc0, voff0 = srow * ldv + sc0, vst0 = (int)(uintptr_t)V_lds + v_st<DV>(srow, sc0);
    int kst[NKP];
#pragma unroll
    for (int q = 0; q < NKP; ++q) kst[q] = (int)(uintptr_t)K_lds + kswz<DQK>(srow, sc0 * 2 + 128 * q);
    const int vb0 = (int)(uintptr_t)V_lds + v_rd_base(lane);
    int kb[NKB<DQK>];
#pragma unroll
    for (int x = 0; x < NKB<DQK>; ++x) kb[x] = (int)(uintptr_t)K_lds + r32 * (DQK * 2) + ((x * 32 + hi * 16) ^ (ksw<DQK>(r32) << 4));
    bf16x8 sk[NKP], sv[NVP];
    bf16x8 kf[2 * ND0];
#define KT(j) ((j) < 4 ? (j) : (j) + lo)
#define SLOAD3(j) do { const int kt_ = __builtin_amdgcn_readfirstlane(KT(j)); const bf16_t* Vt_ = Vh + (long)kt_ * (KVBLK * (long)ldv); const bf16_t* Kt_ = Kh + (long)kt_ * (KVBLK * (long)ldk); \
    _Pragma("unroll") for (int q_ = 0; q_ < NVP; ++q_) sv[q_] = *reinterpret_cast<const bf16x8*>(Vt_ + voff0 + 64 * q_); \
    _Pragma("unroll") for (int q_ = 0; q_ < NKP; ++q_) sk[q_] = *reinterpret_cast<const bf16x8*>(Kt_ + koff0 + 64 * q_); } while (0)
#define SWRITE3(bi) do { \
    _Pragma("unroll") for (int q_ = 0; q_ < NVP; ++q_) *reinterpret_cast<LAS bf16x8*>((uintptr_t)(unsigned)(vst0 + (bi) * SHM_V + 1024 * q_)) = sv[q_]; \
    _Pragma("unroll") for (int q_ = 0; q_ < NKP; ++q_) *reinterpret_cast<LAS bf16x8*>((uintptr_t)(unsigned)(kst[q_] + (bi) * SHM_K)) = sk[q_]; } while (0)
#define RESC(a) do { if (__any((a) < 1.f)) { if (hi == 0) al_l[r32] = (a); asm volatile("s_waitcnt lgkmcnt(0)" ::: "memory"); \
    _Pragma("unroll") for (int d = 0; d < NDV; ++d) _Pragma("unroll") for (int r = 0; r < 16; ++r) o[d][r] *= al_l[crow(r, hi)]; } } while (0)
#define MASKT(P0, P1, j) do { if constexpr (MASK && DBG_BREAK != 4) { if ((j) >= 4) band_mask(P0, P1, (KT(j) - 4) * KVBLK - (qpos0 + wid * QBLK + r32), hi); } } while (0)
    f32x16 pA0, pA1, pB0, pB1; float mnA, mnB, alA, alB; bf16x8 pa0, pa1, pa2, pa3;
    static_assert(QSP == 0, "attn_unit4: Q fragments stay in registers");
    int bp = 0, bc = 1, bn = 2, bnn = 3;
#define ROT4() do { const int t_ = bp; bp = bc; bc = bn; bn = bnn; bnn = t_; } while (0)
#define KLOAD(bi) do { const int bo_ = (bi) * SHM_K; _Pragma("unroll") for (int d0 = 0; d0 < ND0; ++d0) { \
        kf[2 * d0] = *reinterpret_cast<const LAS bf16x8*>((uintptr_t)(unsigned)(KADDR(kb, d0) + bo_)); \
        kf[2 * d0 + 1] = *reinterpret_cast<const LAS bf16x8*>((uintptr_t)(unsigned)(KADDR(kb, d0) + bo_ + 32 * DQK * 2)); } } while (0)
#define QKREG(P0, P1) do { P0 = f32x16{}; P1 = f32x16{}; _Pragma("unroll") for (int d0 = 0; d0 < ND0; ++d0) { \
        P0 = __builtin_amdgcn_mfma_f32_32x32x16_bf16(kf[2 * d0], qr[d0], P0, 0, 0, 0); P1 = __builtin_amdgcn_mfma_f32_32x32x16_bf16(kf[2 * d0 + 1], qr[d0], P1, 0, 0, 0); } } while (0)
#define ITER(X0, X1, MNX, ALX, Y0, Y1, ALY, j) do { SBAR(); QKREG(X0, X1); MASKT(X0, X1, j); \
        finishSM(Y0, Y1, ALY, l_reg, pa0, pa1, pa2, pa3); SBAR(); \
        if ((j) + 1 < NT) { KLOAD(bn); } if ((j) + 2 < NT) { SWRITE3(bnn); } if ((j) + 3 < NT) { SLOAD3((j) + 3); } SBAR(); \
        pv_all<DV>(o, vb0 + bp * SHM_V, pa0, pa1, pa2, pa3); partialSM(X0, X1, m_reg, MNX, ALX); \
        RESC(ALX); __syncthreads(); ROT4(); } while (0)
    SLOAD3(0); asm volatile("s_waitcnt vmcnt(0)" ::: "memory"); SWRITE3(0); SLOAD3(1); asm volatile("s_waitcnt vmcnt(0)" ::: "memory"); SWRITE3(1); SLOAD3(2); __syncthreads();
    KLOAD(0); QKREG(pA0, pA1); MASKT(pA0, pA1, 0); partialSM(pA0, pA1, m_reg, mnA, alA);
    KLOAD(1); SWRITE3(2); SLOAD3(3); __syncthreads();
    for (int j = 1; j + 1 < NT; j += 2) {
        ITER(pB0, pB1, mnB, alB, pA0, pA1, alA, j);
        ITER(pA0, pA1, mnA, alA, pB0, pB1, alB, j + 1);
    }
    ITER(pB0, pB1, mnB, alB, pA0, pA1, alA, NT - 1);
    finishSM(pB0, pB1, alB, l_reg, pa0, pa1, pa2, pa3); SBAR();
    pv_all<DV>(o, vb0 + bp * SHM_V, pa0, pa1, pa2, pa3);
    if (hi == 0) li_l[r32] = l_reg; asm volatile("s_waitcnt lgkmcnt(0)" ::: "memory");
    float rli[16];
#pragma unroll
    for (int r = 0; r < 16; ++r) rli[r] = __builtin_amdgcn_rcpf(li_l[crow(r, hi)]);
    bf16_t* Ow = Ob + (long)(wid * QBLK) * ldo;
    if constexpr (OSTAGE && DQK != 192) {
        LAS bf16_t* stg = (LAS bf16_t*)(lds + 4 * SHM_V + 4 * SHM_K + 2048) + wid * (QBLK * DV);
#pragma unroll
        for (int r = 0; r < 16; ++r) { const int orow = crow(r, hi);
#pragma unroll
            for (int d0 = 0; d0 < NDV; ++d0) stg[orow * DV + d0 * 32 + r32] = (bf16_t)(cvt_pk_bf16(o[d0][r] * rli[r], 0.f) & 0xffffu); }
        asm volatile("s_waitcnt lgkmcnt(0)" ::: "memory");
#pragma unroll
        for (int i = 0; i < QBLK * DV / 8 / 64; ++i) { const int c = i * 64 + lane, row = c / (DV / 8), ch = c % (DV / 8);
            const u32x4 v = *(const LAS u32x4*)(stg + row * DV + ch * 8); *(u32x4*)(Ow + (long)row * ldo + ch * 8) = v; }
    } else {
#pragma unroll
    for (int r = 0; r < 16; ++r) { const int orow = crow(r, hi);
#pragma unroll
        for (int d0 = 0; d0 < NDV; ++d0) Ow[(long)orow * ldo + d0 * 32 + r32] = (bf16_t)(cvt_pk_bf16(o[d0][r] * rli[r], 0.f) & 0xffffu); }
    }
    __syncthreads();
#undef KT
#undef SLOAD3
#undef SWRITE3
#undef RESC
#undef MASKT
#undef ROT4
#undef KLOAD
#undef QKREG
#undef ITER
}

struct AttnP { const bf16_t* Q; const bf16_t* K; const bf16_t* V; bf16_t* O; const float* sink; };
template <int DQK, int DV, bool MASK, int SDEPTH, int QSP, int LDQ, int LDK, int LDV, int LDO, int H, int GQ, int GV, int KSTR, int VSTR, int DOCTX, bool O8 = false>
__device__ __forceinline__ void attn_phase(LAS char* lds, const AttnP& P, int G, int vcu) {
    constexpr int nheavy = 8 * H * 8, nlight = DOCTX ? 8 * H : 0;
    for (int it = vcu; it < nheavy + nlight; it += G) {
        int b, h, qb;
        if (it < nheavy) { qb = (it & 7) + 1; h = (it >> 3) % H; b = (it >> 3) / H; }
        else { const int i2 = it - nheavy; qb = 0; h = i2 % H; b = i2 / H; }
        const long r0 = (long)b * 2304;
        int NT, lo = 0;
        if (qb == 0) NT = 4;
        else if (MASK) { const int l0 = 4 * (qb - 1) - 2, h0 = 4 * (qb - 1) + 5; lo = l0 < 0 ? 0 : l0; const int hh = h0 > 31 ? 31 : h0; NT = 4 + hh - lo + 1; }
        else NT = 36;
        float m0 = -1e30f, l0f = 0.f;
        if (P.sink && DBG_BREAK != 3) { m0 = P.sink[h] * 1.4426950408889634f; l0f = 1.f; }
        if constexpr (SDEPTH == 4) attn_unit4<DQK, DV, MASK, QSP, LDQ, LDK, LDV, LDO>(P.Q + (r0 + qb * 256) * LDQ + h * DQK, P.K + r0 * LDK + (h / GQ) * KSTR, P.V + r0 * LDV + (h / GV) * VSTR,
                                 P.O + (r0 + qb * 256) * LDO + h * DV, NT, lo, m0, l0f, (qb - 1) * 256, lds);
        else if constexpr (SDEPTH == 3) attn_unit3<DQK, DV, MASK, QSP, LDQ, LDK, LDV, LDO>(P.Q + (r0 + qb * 256) * LDQ + h * DQK, P.K + r0 * LDK + (h / GQ) * KSTR, P.V + r0 * LDV + (h / GV) * VSTR,
                                 P.O + (r0 + qb * 256) * LDO + h * DV, NT, lo, m0, l0f, (qb - 1) * 256, lds);
        else attn_unit<DQK, DV, MASK, SDEPTH, QSP, LDQ, LDK, LDV, LDO, O8>(P.Q + (r0 + qb * 256) * LDQ + h * DQK, P.K + r0 * LDK + (h / GQ) * KSTR, P.V + r0 * LDV + (h / GV) * VSTR,
                                 O8 ? (bf16_t*)((unsigned char*)P.O + ((r0 + qb * 256) * LDO + h * DV)) : P.O + (r0 + qb * 256) * LDO + h * DV, NT, lo, m0, l0f, (qb - 1) * 256, lds);
    }
}
#undef SBAR
}

#ifndef DBG_BREAK
#define DBG_BREAK 0
#endif
#ifndef FUSE_QKV
#define FUSE_QKV 7
#endif
constexpr int NWAVES = 8;
constexpr int D = 1024, NB = 8, SEQ = 2048, CTXL = 256, RPB = 2304, M = NB * RPB  , MT = M / 256  , MLAT = NB * SEQ  ;
constexpr int FF = 3584, NEXP = 8, ECAP = M;
constexpr float EPS = 1e-6f, LOG2E = 1.4426950408889634f;
constexpr float SC_GQA = 0.12751743082459868f, SC_MLA = 0.10411754627697264f, SC_64 = 0.18033688011112042f;
constexpr float LAM_INIT = 0.5560582041556406f;
enum { I_X = 0, I_C, I_CTX, I_CCTX, I_ADAW, I_ADAB, I_NMIX, I_NFFN, I_GQA_WQKV, I_GQA_QG, I_GQA_KG, I_GQA_WO, I_MLA_WDOWN, I_MLA_QAG, I_MLA_KVAG, I_MLA_WUQ, I_MLA_WUKV, I_MLA_QG, I_MLA_KG, I_MLA_WO,
       I_WIN_WQKV, I_WIN_QG, I_WIN_KG, I_WIN_SINK, I_WIN_WO, I_DIFF_WQKV, I_DIFF_QG, I_DIFF_KG, I_DIFF_LAM, I_DIFF_SUBLN, I_DIFF_WO, I_FFN_W13, I_FFN_W2, I_MOE_ROUTER, I_MOE_W13, I_MOE_W2, N_IN };
constexpr size_t MiB = 1u << 20;
constexpr size_t WS_CTL = 0, CTL_ZERO_BYTES = 1 * MiB;
constexpr size_t WS_MOD = 1 * MiB;
constexpr size_t WS_R128C = 2 * MiB, WS_R128S = 2 * MiB + 512 * 1024;
constexpr size_t WS_R64C = 3 * MiB, WS_R64S = 3 * MiB + 256 * 1024;
constexpr size_t WS_TOKPOS = 4 * MiB, WS_TOKGATE = 4 * MiB + 256 * 1024;
constexpr size_t WS_WQKV0 = 8 * MiB, WS_WO0 = 11 * MiB, WS_WDOWN1 = 13 * MiB, WS_WUQ1 = 15 * MiB, WS_WUKV1 = 17 * MiB, WS_WO1 = 18 * MiB, WS_WQKV2 = 20 * MiB, WS_WO2 = 23 * MiB,
                 WS_WQKV3 = 25 * MiB, WS_WO3 = 31 * MiB, WS_WF13 = 34 * MiB, WS_WF2 = 62 * MiB, WS_WM13 = 76 * MiB, WS_WM2 = 300 * MiB;
constexpr size_t WS_XS = 412 * MiB, WS_H = 484 * MiB, WS_O2 = 520 * MiB, WS_OBUF = 556 * MiB, WS_ATT = 628 * MiB, WS_ACT = 928 * MiB, WS_Y = 1194 * MiB, WS_END = 1270 * MiB;
constexpr size_t WS_RAW = WS_ATT, WS_DN = WS_ATT, WS_CQN = WS_ATT + 32 * MiB, WS_CKVN = WS_ATT + 48 * MiB, WS_QRAW = WS_ATT + 64 * MiB, WS_KVRAW = WS_ATT + 120 * MiB, WS_KBUF = WS_ATT + 192 * MiB, WS_ASORT = WS_ATT;
constexpr int CW_BAR = 4096, CW_CNT = 8192, CW_CUR = 8448, CW_DONE = 8512;
constexpr int LDSCTL_OFF = 143360, LDS_BYTES = 147456;
constexpr int MI_BAR = 8, MI_TB = 16, MI_CNT = 32, MI_BASE = 40, MI_ENT = 64;

typedef GAS unsigned gu32;
#define RLX_AGENT __ATOMIC_RELAXED, __HIP_MEMORY_SCOPE_AGENT
#define LDS_WAIT() asm volatile("s_waitcnt lgkmcnt(0)" ::: "memory")
#define VM_WAIT() asm volatile("s_waitcnt vmcnt(0)" ::: "memory")

#define XB_TMO      128
#define XB_XCNT(j)  (256  + 64 * (j))
#define XB_XSUB(j)  (1280 + 64 * (j))
#define XB_XGEN(j)  (2304 + 64 * (j))
#define XB_TOP      3328
#define XB_TOPGEN   3392
#define XCD_BAR_WORDS 3456
#define XB_SPIN_CAP (1u << 22)
__device__ __forceinline__ unsigned xb_ld(unsigned* p)              { return __hip_atomic_load(p, __ATOMIC_RELAXED, __HIP_MEMORY_SCOPE_AGENT); }
__device__ __forceinline__ unsigned xb_add(unsigned* p, unsigned v) { return __hip_atomic_fetch_add(p, v, __ATOMIC_RELAXED, __HIP_MEMORY_SCOPE_AGENT); }
__device__ __forceinline__ unsigned xb_xcc_id() { return (unsigned)__builtin_amdgcn_s_getreg((3 << 11) | 20) & 0xFu; }
#define XB_SPIN(cond, bar) do { unsigned _sp = 0; while (cond) { __builtin_amdgcn_s_sleep(1); \
    if ((++_sp & 255u) == 0u) { if (xb_ld(&(bar)[XB_TMO])) break; if (_sp > XB_SPIN_CAP) { atomicAdd(&(bar)[XB_TMO], 1u); break; } } } } while (0)
struct XcdBarrier { unsigned* bar; unsigned x; volatile LAS unsigned* st; };
__device__ __forceinline__ XcdBarrier xcd_barrier_post(unsigned* bar, volatile LAS unsigned* st) {
    XcdBarrier b; b.bar = bar; b.x = xb_xcc_id(); b.st = st;
    if (threadIdx.x == 0) (void)xb_add(&bar[XB_XCNT(b.x)], 1u);
    return b;
}
__device__ __forceinline__ void xcd_barrier_complete(unsigned* bar, unsigned x, unsigned& nloc, unsigned& nx) {
    const unsigned G = gridDim.x * gridDim.y * gridDim.z;
    unsigned sum, cnt, mine, sp = 0u;
    for (;;) {
        sum = 0u; cnt = 0u; mine = 0u;
#pragma unroll
        for (unsigned j = 0; j < 16; ++j) { const unsigned c = xb_ld(&bar[XB_XCNT(j)]); sum += c; cnt += (c > 0u) ? 1u : 0u; mine = (j == x) ? c : mine; }
        if (sum == G) break;
        __builtin_amdgcn_s_sleep(1);
        if ((++sp & 255u) == 0u) { if (xb_ld(&bar[XB_TMO])) break; if (sp > XB_SPIN_CAP) { atomicAdd(&bar[XB_TMO], 1u); break; } }
    }
    nloc = mine > 0u ? mine : 1u; nx = cnt > 0u ? cnt : 1u;
}
__device__ __forceinline__ void xcd_barrier(const XcdBarrier& b) {
    asm volatile("s_waitcnt vmcnt(0)" ::: "memory");
    __syncthreads();
    if (threadIdx.x == 0) {
        unsigned* bar = b.bar;
        __builtin_amdgcn_s_waitcnt(0);
        unsigned nloc = b.st[0], nx = b.st[1];
        if (nloc == 0u) { xcd_barrier_complete(bar, b.x, nloc, nx); b.st[0] = nloc; b.st[1] = nx; }
        const unsigned old = xb_add(&bar[XB_XSUB(b.x)], 1u);
        const unsigned gen = old / nloc;
        if (old + 1u == (gen + 1u) * nloc) {
            __builtin_amdgcn_fence(__ATOMIC_RELEASE, "agent");
            asm volatile("s_waitcnt vmcnt(0)" ::: "memory");
            const unsigned og = xb_add(&bar[XB_TOP], 1u);
            const unsigned tg = og / nx;
            if (og + 1u == (tg + 1u) * nx) xb_add(&bar[XB_TOPGEN], 1u);
            else XB_SPIN(xb_ld(&bar[XB_TOPGEN]) == tg, bar);
            __builtin_amdgcn_fence(__ATOMIC_ACQUIRE, "agent");
            xb_add(&bar[XB_XGEN(b.x)], 1u);
            asm volatile("s_waitcnt vmcnt(0)" ::: "memory");
        } else {
            XB_SPIN(xb_ld(&bar[XB_XGEN(b.x)]) == gen, bar);
            __builtin_amdgcn_fence(__ATOMIC_ACQUIRE, "agent");
            asm volatile("s_waitcnt vmcnt(0)" ::: "memory");
        }
    }
    __syncthreads();
}

struct Params { const float* in[N_IN]; float* out; unsigned char* ws; int ph_lo, ph_hi; };
struct Frame {
    LAS unsigned char* lds; volatile LAS unsigned* MISC; gu32* ctl;
    int tid, lane, wave, vcu, G, gw, NGW;
    const float* const* in; float* out; unsigned char* ws;
};
#define WSP(T, off) ((T*)(F.ws + (off)))

__device__ __forceinline__ float wave_sum(float v) {
#pragma unroll
    for (int o = 1; o < 64; o <<= 1) v += __shfl_xor(v, o);
    return v;
}
__device__ __forceinline__ void ld8(const bf16_t* p, float (&v)[8]) { const u32x4 w = *(const u32x4*)p;
    v[0] = bf_lo(w.x); v[1] = bf_hi(w.x); v[2] = bf_lo(w.y); v[3] = bf_hi(w.y); v[4] = bf_lo(w.z); v[5] = bf_hi(w.z); v[6] = bf_lo(w.w); v[7] = bf_hi(w.w); }
__device__ __forceinline__ void st8(bf16_t* p, const float (&v)[8]) { u32x4 w; w.x = cvt_pk_bf16(v[0], v[1]); w.y = cvt_pk_bf16(v[2], v[3]); w.z = cvt_pk_bf16(v[4], v[5]); w.w = cvt_pk_bf16(v[6], v[7]); *(u32x4*)p = w; }
template <int LPG> __device__ __forceinline__ void seg_norm_rope(float (&v)[8], int lig, const float* gain, bool rope, const float* cs, const float* sn, float scale) {
    constexpr int HD = LPG * 8;
    float ss = 0.f;
#pragma unroll
    for (int i = 0; i < 8; ++i) ss += v[i] * v[i];
#pragma unroll
    for (int o = 1; o < LPG; o <<= 1) ss += __shfl_xor(ss, o);
    const float rstd = 1.0f / sqrtf(ss * (1.0f / HD) + EPS);
    const int e0 = lig * 8;
    const f32x4 g0 = *(const f32x4*)(gain + e0), g1 = *(const f32x4*)(gain + e0 + 4);
    v[0] *= rstd * g0[0]; v[1] *= rstd * g0[1]; v[2] *= rstd * g0[2]; v[3] *= rstd * g0[3]; v[4] *= rstd * g1[0]; v[5] *= rstd * g1[1]; v[6] *= rstd * g1[2]; v[7] *= rstd * g1[3];
    if (rope) {
        const bool hf = lig >= LPG / 2; const int p0 = e0 & (HD / 2 - 1);
        const f32x4 c0 = *(const f32x4*)(cs + p0), c1 = *(const f32x4*)(cs + p0 + 4), s0 = *(const f32x4*)(sn + p0), s1 = *(const f32x4*)(sn + p0 + 4);
        const float cc[8] = {c0[0], c0[1], c0[2], c0[3], c1[0], c1[1], c1[2], c1[3]}, sv[8] = {s0[0], s0[1], s0[2], s0[3], s1[0], s1[1], s1[2], s1[3]};
#pragma unroll
        for (int i = 0; i < 8; ++i) { const float py = __shfl_xor(v[i], LPG / 2); v[i] = hf ? (py * sv[i] + v[i] * cc[i]) : (v[i] * cc[i] - py * sv[i]); }
    }
#pragma unroll
    for (int i = 0; i < 8; ++i) v[i] *= scale;
}

#ifndef WO_FP8
#define WO_FP8 15
#endif
#ifndef QKV_FP8
#define QKV_FP8 15
#endif
#ifndef UPM_FP8
#define UPM_FP8 1
#endif
#ifndef CONV_KFAST
#define CONV_KFAST 1
#endif
struct TDesc { int in_idx, K, N, nmat, perm, item0; unsigned long long src_off, dst; };
#define TD_ITEMS(K, N, nmat) ((nmat) * ((K) / 64) * ((N) / 64))
constexpr int TE0 = 0, TE1 = TE0 + TD_ITEMS(1024, 1536, 1), TE2 = TE1 + TD_ITEMS(1024, 1024, 1), TE3 = TE2 + TD_ITEMS(1024, 7168, 1), TE4 = TE3 + TD_ITEMS(3584, 1024, 1),
              TE5 = TE4 + TD_ITEMS(1024, 704, 1), TE6 = TE5 + TD_ITEMS(384, 1536, 1), TE7 = TE6 + TD_ITEMS(256, 2048, 1), TE8 = TE7 + TD_ITEMS(1024, 1024, 1),
              TE9 = TE8 + TD_ITEMS(1024, 7168, 8), TE10 = TE9 + TD_ITEMS(3584, 1024, 8),
              TE11 = TE10 + TD_ITEMS(1024, 1280, 1), TE12 = TE11 + TD_ITEMS(1024, 1024, 1), TE13 = TE12 + TD_ITEMS(1024, 7168, 1), TE14 = TE13 + TD_ITEMS(3584, 1024, 1),
              TE15 = TE14 + TD_ITEMS(1024, 3072, 1), TE16 = TE15 + TD_ITEMS(1024, 1024, 1), TE17 = TE16 + TD_ITEMS(1024, 7168, 8), TI_END = TE17 + TD_ITEMS(3584, 1024, 8);
constexpr int N_TD = 18;
constexpr int TI_PRO = TE4;
constexpr int TWA = TI_PRO + 1200, TWB = TWA + 3600, TWC = TWB + 500, TWD = TWC + 12800, TWE = TWD + 600, TWF = TE10  ,
              TWG = TWF + 3000, TWH = TWG + 9000, TWI = TWH + 2400, TWJ = TWI + 3600, TWK = TWJ + 500;
static_assert(TWB > TE8 && TWE < TWF && TWG > TE12 && TWH > TE14 && TWK < TI_END, "conversion windows");
__constant__ TDesc g_td[N_TD] = {
    {I_GQA_WQKV, 1024, 1536, 1, ((FUSE_QKV & 1) ? 2 : 0) | ((QKV_FP8 & 1) ? 8 : 0), TE0, 0ull, WS_WQKV0}, {I_GQA_WO, 1024, 1024, 1, (WO_FP8 & 1) ? 8 : 0, TE1, 0ull, WS_WO0}, {I_FFN_W13, 1024, 7168, 1, 1, TE2, 0ull, WS_WF13}, {I_FFN_W2, 3584, 1024, 1, 8, TE3, 0ull, WS_WF2},
    {I_MLA_WDOWN, 1024, 704, 1, (QKV_FP8 & 2) ? 8 : 0, TE4, 0ull, WS_WDOWN1}, {I_MLA_WUQ, 384, 1536, 1, 0, TE5, 0ull, WS_WUQ1}, {I_MLA_WUKV, 256, 2048, 1, 0, TE6, 0ull, WS_WUKV1}, {I_MLA_WO, 1024, 1024, 1, (WO_FP8 & 2) ? 8 : 0, TE7, 0ull, WS_WO1},
    {I_MOE_W13, 1024, 7168, 8, UPM_FP8 ? 9 : 1, TE8, 0ull, WS_WM13}, {I_MOE_W2, 3584, 1024, 8, 8, TE9, 0ull, WS_WM2},
    {I_WIN_WQKV, 1024, 1280, 1, ((FUSE_QKV & 2) ? 3 : 0) | ((QKV_FP8 & 4) ? 8 : 0), TE10, 0ull, WS_WQKV2}, {I_WIN_WO, 1024, 1024, 1, (WO_FP8 & 4) ? 8 : 0, TE11, 0ull, WS_WO2},
    {I_FFN_W13, 1024, 7168, 1, 1, TE12, (unsigned long long)1024 * 7168, WS_WF13 + (size_t)7168 * 1024 * 2}, {I_FFN_W2, 3584, 1024, 1, 8, TE13, (unsigned long long)3584 * 1024, WS_WF2 + (size_t)1024 * 3584},
    {I_DIFF_WQKV, 1024, 3072, 1, ((FUSE_QKV & 4) ? 4 : 0) | ((QKV_FP8 & 8) ? 8 : 0), TE14, 0ull, WS_WQKV3}, {I_DIFF_WO, 1024, 1024, 1, (WO_FP8 & 8) ? 8 : 0, TE15, 0ull, WS_WO3},
    {I_MOE_W13, 1024, 7168, 8, UPM_FP8 ? 9 : 1, TE16, (unsigned long long)8 * 1024 * 7168, WS_WM13 + (size_t)8 * 7168 * 1024 * (UPM_FP8 ? 1 : 2)}, {I_MOE_W2, 3584, 1024, 8, 8, TE17, (unsigned long long)8 * 3584 * 1024, WS_WM2 + (size_t)8 * 1024 * 3584} };

__device__ __forceinline__ void p0_transpose_item(const float* W, int K, int N, int perm, bf16_t* WT, LAS float* scr, int kb, int nb, int lane) {
    const int k0 = 64 * kb, n0 = 64 * nb;
    const float* wp = W + (size_t)(k0 + (lane >> 4)) * N + n0 + (lane & 15) * 4;
    f32x4 x[16];
#pragma unroll
    for (int i = 0; i < 16; ++i) x[i] = __builtin_nontemporal_load((const f32x4*)(wp + (size_t)(4 * i) * N));
    LAS float* s0 = scr + (lane >> 4) * 65 + (lane & 15) * 4;
#pragma unroll
    for (int i = 0; i < 16; ++i) { LAS float* s = s0 + (4 * i) * 65; s[0] = x[i][0]; s[1] = x[i][1]; s[2] = x[i][2]; s[3] = x[i][3]; }
    LDS_WAIT(); asm volatile("" ::: "memory");
    const int c = lane & 7;
    const int rmap = perm & 7;
#pragma unroll 2
    for (int j = 0; j < 8; ++j) { const int n = (lane >> 3) + 8 * j; const LAS float* s = scr + (8 * c) * 65 + n;
        int nn = n0 + n;
        float ws = 1.0f;
        if (rmap == 1) { const int half = nn >= FF ? 1 : 0; nn -= half * FF; nn = (nn >> 7) * 256 + half * 128 + (nn & 127); ws = half ? pg8::SW_U : pg8::SW_G; }
        else if (rmap >= 2) { const int hd = rmap == 2 ? 128 : 64, lim = rmap == 2 ? 1280 : (rmap == 3 ? 1152 : 2048);
            if (nn < lim) { const int h = nn / hd, d = nn - h * hd; nn = h * hd + (d < hd / 2 ? 2 * d : 2 * (d - hd / 2) + 1); } }
        if (perm & 8) { float v[8];
#pragma unroll
            for (int q = 0; q < 8; ++q) v[q] = F8CLAMP(F8_W_MUL * ws * s[q * 65]);
            u32x2 o; o.x = pk4_fp8(v[0], v[1], v[2], v[3]); o.y = pk4_fp8(v[4], v[5], v[6], v[7]);
            __builtin_nontemporal_store(o, (u32x2*)((unsigned char*)WT + (size_t)nn * K + k0 + 8 * c)); }
        else { u32x4 o; o.x = cvt_pk_bf16(ws * s[0 * 65], ws * s[1 * 65]); o.y = cvt_pk_bf16(ws * s[2 * 65], ws * s[3 * 65]); o.z = cvt_pk_bf16(ws * s[4 * 65], ws * s[5 * 65]); o.w = cvt_pk_bf16(ws * s[6 * 65], ws * s[7 * 65]);
            __builtin_nontemporal_store(o, (u32x4*)(WT + (size_t)nn * K + k0 + 8 * c)); } }
    LDS_WAIT(); asm volatile("" ::: "memory");
}
__device__ __forceinline__ void sincos_d(double a, double& s, double& c) {
    const double TWO_PI = 6.283185307179586476925286766559, INV_TWO_PI = 0.15915494309189533576888376337251;
    const double n = __builtin_rint(a * INV_TWO_PI); const double r = a - n * TWO_PI, r2 = r * r;
    double ts = 1.0, tc = 1.0;
#pragma unroll
    for (int k = 15; k >= 1; --k) { ts = 1.0 - ts * r2 / (double)((2 * k) * (2 * k + 1)); tc = 1.0 - tc * r2 / (double)((2 * k - 1) * (2 * k)); }
    s = r * ts; c = tc;
}
__device__ __forceinline__ void convert_one(const Frame& F, int it) {
    LAS float* scr = (LAS float*)(F.lds + F.wave * 16640);
    int d = 0;
#pragma unroll
    for (int k = 1; k < N_TD; ++k) d += (it >= g_td[k].item0) ? 1 : 0;
    const int K = g_td[d].K, N = g_td[d].N, perm = g_td[d].perm; int r = it - g_td[d].item0;
    const int nblk = N / 64, kblk = K / 64, per = kblk * nblk, mat = r / per; r -= mat * per;
#if CONV_KFAST
    const int nb = r / kblk, kb = r - nb * kblk;
#else
    const int kb = r / nblk, nb = r - kb * nblk;
#endif
    const float* W = F.in[g_td[d].in_idx] + g_td[d].src_off + (size_t)mat * K * N; bf16_t* WT = (bf16_t*)(F.ws + g_td[d].dst + (size_t)mat * K * N * ((perm & 8) ? 1 : 2));
    p0_transpose_item(W, K, N, perm, WT, scr, kb, nb, F.lane);
}
__device__ __forceinline__ void convert_items(const Frame& F, int lo, int hi, int rank, int nworkers) {
    for (int it = lo + rank * NWAVES + F.wave; it < hi; it += nworkers * NWAVES) convert_one(F, it);
}
__device__ __forceinline__ int convert_claim(const Frame& F) {
    unsigned v = 0u; if (F.lane == 0) v = __hip_atomic_fetch_add(F.ctl + CW_CUR, 2u, RLX_AGENT);
    return TI_PRO + (int)__builtin_amdgcn_readfirstlane(v);
}
__device__ __forceinline__ void tail_convert(const Frame& F, int rem, int phase) {
    if (rem == 0) return;
    gu32* done = F.ctl + CW_DONE + 64 * phase;
    if (F.vcu < rem) { if (F.tid == 0) __hip_atomic_fetch_add(done, 1u, RLX_AGENT); return; }
    for (;;) {
        const int it = convert_claim(F);
        if (it >= TI_END) break;
        const unsigned dn = __hip_atomic_load(done, RLX_AGENT);
        convert_one(F, it); if (it + 1 < TI_END) convert_one(F, it + 1);
        if ((int)__builtin_amdgcn_readfirstlane(dn) >= rem) break;
    }
}
__device__ __forceinline__ void convert_catch_up(const Frame& F, int need) {
    for (;;) {
        if ((int)__builtin_amdgcn_readfirstlane(__hip_atomic_load(F.ctl + CW_CUR, RLX_AGENT)) + TI_PRO >= need) break;
        const int it = convert_claim(F);
        if (it >= TI_END) break;
        convert_one(F, it); if (it + 1 < TI_END) convert_one(F, it + 1);
    }
}
__device__ __forceinline__ void mod_tasks(const Frame& F, int tlo, int thi, int rank, int nworkers) {
    LAS float* sl = (LAS float*)F.lds;
    LAS float* red = (LAS float*)(F.lds + 40960);
    if (tlo + rank >= thi) return;
    for (int i = F.tid; i < 9 * 1024; i += NWAVES * 64) { const float cv = (i < 8192) ? F.in[I_C][i] : F.in[I_CCTX][i - 8192]; sl[i] = cv / (1.0f + __expf(-cv)); }
    __syncthreads();
    for (int task = tlo + rank; task < thi; task += nworkers) {
        const int li = task / 96, cg = task % 96, col = cg * 64 + F.lane;
        const float* wp = F.in[I_ADAW] + ((size_t)li * 1024 + F.wave * 128) * 6144 + col;
        float acc[9];
#pragma unroll
        for (int r = 0; r < 9; ++r) acc[r] = 0.f;
        for (int k0 = 0; k0 < 128; k0 += 32) { float wv[32];
#pragma unroll
            for (int k = 0; k < 32; ++k) wv[k] = __builtin_nontemporal_load(wp + (size_t)(k0 + k) * 6144);
#pragma unroll
            for (int k = 0; k < 32; ++k)
#pragma unroll
                for (int r = 0; r < 9; ++r) acc[r] += sl[r * 1024 + F.wave * 128 + k0 + k] * wv[k]; }
#pragma unroll
        for (int r = 0; r < 9; ++r) red[(F.wave * 9 + r) * 64 + F.lane] = acc[r];
        __syncthreads();
        for (int idx = F.tid; idx < 576; idx += NWAVES * 64) { float s = 0.f;
#pragma unroll
            for (int w = 0; w < 8; ++w) s += red[w * 576 + idx];
            const int r = idx >> 6, cc = cg * 64 + (idx & 63);
            WSP(float, WS_MOD)[((size_t)li * 9 + r) * 6144 + cc] = s + F.in[I_ADAB][li * 6144 + cc]; }
        __syncthreads();
    }
}
__device__ __forceinline__ void p0_prologue(const Frame& F) {
    mod_tasks(F, 0, 384, F.vcu, F.G);
    for (int idx = blockIdx.x * (NWAVES * 64) + F.tid; idx < 2048 * 96; idx += F.G * NWAVES * 64) {
        int t, p, Q; float *co, *so;
        if (idx < 2048 * 64) { t = idx >> 6; p = idx & 63; Q = 32; co = WSP(float, WS_R128C) + idx; so = WSP(float, WS_R128S) + idx; }
        else { const int i2 = idx - 2048 * 64; t = i2 >> 5; p = i2 & 31; Q = 16; co = WSP(float, WS_R64C) + i2; so = WSP(float, WS_R64S) + i2; }
        const int pos = p < Q ? (t >> 6) : (t & 63), kf = p < Q ? p : p - Q;
        const float inv = (float)exp2(-(double)kf / (double)Q * 13.287712379549449);
        const float ang = (float)pos * inv;
        double s, c; sincos_d((double)ang, s, c); *co = (float)c; *so = (float)s;
    }
    for (int idx = blockIdx.x * (NWAVES * 64) + F.tid; idx < 64 * 1024 / 8; idx += F.G * NWAVES * 64) *(u32x4*)(WSP(bf16_t, WS_WDOWN1) + (size_t)704 * 1024 + (size_t)idx * 8) = (u32x4){0u, 0u, 0u, 0u};
    __syncthreads();
    convert_items(F, 0, TI_PRO, F.vcu, F.G);
}

struct RowCtx { int R, b, j, isctx, mr; };
__device__ __forceinline__ RowCtx row_ctx(int idx, bool latent_only) { RowCtx c; c.R = latent_only ? (idx >> 11) * RPB + CTXL + (idx & 2047) : idx; c.b = c.R / RPB; c.j = c.R - c.b * RPB; c.isctx = c.j < CTXL; c.mr = c.isctx ? 8 : c.b; return c; }
__device__ __forceinline__ void norm_row(const Frame& F, const RowCtx& rc, int layer, int which, int src_mode, f32x4 (&v)[4]) {
    const int lane = F.lane;
    f16_t* xs = WSP(f16_t, WS_XS) + (size_t)rc.R * D;
    if (src_mode == 0) { const float* src = rc.isctx ? F.in[I_CTX] + ((size_t)rc.b * CTXL + rc.j) * D : F.in[I_X] + ((size_t)rc.b * SEQ + rc.j - CTXL) * D;
#pragma unroll
        for (int jj = 0; jj < 4; ++jj) v[jj] = *((const f32x4*)src + lane + 64 * jj); }
    else {
#pragma unroll
        for (int jj = 0; jj < 4; ++jj) v[jj] = __builtin_convertvector(*((const f16x4*)xs + lane + 64 * jj), f32x4); }
    if (src_mode == 2) {
        const LAS int* tb = (const LAS int*)(F.MISC + MI_TB);
        const int p0 = WSP(int, WS_TOKPOS)[rc.R * 2], p1 = WSP(int, WS_TOKPOS)[rc.R * 2 + 1]; const float g0 = WSP(float, WS_TOKGATE)[rc.R * 2], g1 = WSP(float, WS_TOKGATE)[rc.R * 2 + 1];
        const int e0 = p0 / ECAP, e1 = p1 / ECAP; const size_t r0 = (size_t)tb[e0] * 256 + (p0 - e0 * ECAP), r1 = (size_t)tb[e1] * 256 + (p1 - e1 * ECAP);
        const bf16_t* y0 = WSP(bf16_t, WS_Y) + r0 * D; const bf16_t* y1 = WSP(bf16_t, WS_Y) + r1 * D;
        const float* gf = WSP(float, WS_MOD) + ((size_t)(layer - 1) * 9 + rc.mr) * 6144 + 5 * 1024;
#pragma unroll
        for (int jj = 0; jj < 4; ++jj) { const int col = 4 * lane + 256 * jj; const u32x2 a = *(const u32x2*)(y0 + col), bq = *(const u32x2*)(y1 + col); const f32x4 g = *(const f32x4*)(gf + col);
            v[jj][0] += g[0] * (g0 * bf_lo(a.x) + g1 * bf_lo(bq.x)); v[jj][1] += g[1] * (g0 * bf_hi(a.x) + g1 * bf_hi(bq.x));
            v[jj][2] += g[2] * (g0 * bf_lo(a.y) + g1 * bf_lo(bq.y)); v[jj][3] += g[3] * (g0 * bf_hi(a.y) + g1 * bf_hi(bq.y)); }
    }
    if (src_mode != 1) {
#pragma unroll
        for (int jj = 0; jj < 4; ++jj) *((f16x4*)xs + lane + 64 * jj) = __builtin_convertvector(v[jj], f16x4);
    }
    float ss = 0.f;
#pragma unroll
    for (int jj = 0; jj < 4; ++jj) ss += (v[jj][0] * v[jj][0] + v[jj][1] * v[jj][1]) + (v[jj][2] * v[jj][2] + v[jj][3] * v[jj][3]);
    const float rstd = 1.0f / sqrtf(wave_sum(ss) * (1.0f / D) + EPS);
    const float* gn = F.in[which ? I_NFFN : I_NMIX] + layer * D;
    const float* md = WSP(float, WS_MOD) + ((size_t)layer * 9 + rc.mr) * 6144 + (which ? 3 : 0) * 1024;
#pragma unroll
    for (int jj = 0; jj < 4; ++jj) { const int col = 4 * lane + 256 * jj; const f32x4 g = *(const f32x4*)(gn + col), sh = *(const f32x4*)(md + col), sc = *(const f32x4*)(md + 1024 + col);
        v[jj] = v[jj] * rstd * g * (sc + 1.0f) + sh; }
}
__device__ __forceinline__ void store_row_bf16(bf16_t* dst, const f32x4 (&v)[4], int lane) {
#pragma unroll
    for (int jj = 0; jj < 4; ++jj) { u32x2 w; w.x = cvt_pk_bf16(v[jj][0], v[jj][1]); w.y = cvt_pk_bf16(v[jj][2], v[jj][3]); *((u32x2*)dst + lane + 64 * jj) = w; }
}
__device__ __forceinline__ void store_row_fp8(unsigned char* dst, const f32x4 (&v)[4], int lane) {
#pragma unroll
    for (int jj = 0; jj < 4; ++jj) { float c[4];
#pragma unroll
        for (int i = 0; i < 4; ++i) c[i] = F8CLAMP(F8_ACT_MUL * v[jj][i]);
        *((unsigned*)dst + lane + 64 * jj) = pk4_fp8(c[0], c[1], c[2], c[3]); }
}
__device__ __forceinline__ void moe_tile_base(const Frame& F, int j) {
    if (F.tid == 0) { int acc = 0;
        for (int e = 0; e < NEXP; ++e) { F.MISC[MI_TB + e] = (unsigned)acc; acc += (int)((__hip_atomic_load(F.ctl + CW_CNT + 64 * j + e, RLX_AGENT) + 255u) >> 8); }
        F.MISC[MI_TB + 8] = (unsigned)acc; }
    __syncthreads();
}
__device__ __forceinline__ void norm_phase_dense(const Frame& F, int layer, int which, int src_mode, bool latent_only, bool fp8out = false) {
    const int nrows = latent_only ? MLAT : M;
    for (int idx = F.gw; idx < nrows; idx += F.NGW) { const RowCtx rc = row_ctx(idx, latent_only); f32x4 v[4]; norm_row(F, rc, layer, which, src_mode, v);
        if (fp8out) store_row_fp8(WSP(unsigned char, WS_H) + (size_t)rc.R * D, v, F.lane); else store_row_bf16(WSP(bf16_t, WS_H) + (size_t)rc.R * D, v, F.lane); }
}
__device__ __forceinline__ void norm_phase_moe(const Frame& F, int layer, int j, bool latent_only) {
    LAS float* rt = (LAS float*)F.lds;
    const float* rw = F.in[I_MOE_ROUTER] + (size_t)j * D * NEXP;
    for (int i = F.tid; i < D * NEXP; i += NWAVES * 64) rt[(i & 7) * D + (i >> 3)] = rw[i];
    if (F.tid < 8) F.MISC[MI_CNT + F.tid] = 0u;
    __syncthreads();
    const int nrows = latent_only ? MLAT : M; const int lane = F.lane;
    constexpr int RC = 8;
    f32x4 vs[RC][4];
#define MOE_ROUTE(V, KK, RCX) do { float lg[NEXP]; \
        _Pragma("unroll") for (int e = 0; e < NEXP; ++e) { float s_ = 0.f; \
            _Pragma("unroll") for (int jj = 0; jj < 4; ++jj) { const f32x4 r4 = *(const LAS f32x4*)(rt + e * D + 4 * lane + 256 * jj); s_ += (V[jj][0] * r4[0] + V[jj][1] * r4[1]) + (V[jj][2] * r4[2] + V[jj][3] * r4[3]); } \
            lg[e] = wave_sum(s_); } \
        float b1 = lg[0]; int i1 = 0; \
        _Pragma("unroll") for (int e = 1; e < NEXP; ++e) if (lg[e] > b1) { b1 = lg[e]; i1 = e; } \
        float b2 = -3.0e38f; int i2 = 0; \
        _Pragma("unroll") for (int e = 0; e < NEXP; ++e) if (e != i1 && lg[e] > b2) { b2 = lg[e]; i2 = e; } \
        const float g1 = 1.0f / (1.0f + __expf(b2 - b1)), g2 = 1.0f - g1; \
        if (lane == 0) { \
            const unsigned r1 = __hip_atomic_fetch_add((LAS unsigned*)(F.MISC + MI_CNT + i1), 1u, __ATOMIC_RELAXED, __HIP_MEMORY_SCOPE_WORKGROUP); \
            const unsigned r2 = __hip_atomic_fetch_add((LAS unsigned*)(F.MISC + MI_CNT + i2), 1u, __ATOMIC_RELAXED, __HIP_MEMORY_SCOPE_WORKGROUP); \
            volatile LAS unsigned* ent = F.MISC + MI_ENT + (F.wave * 16 + (KK)) * 4; ent[0] = (unsigned)i1; ent[1] = r1; ent[2] = (unsigned)i2; ent[3] = r2; \
            WSP(float, WS_TOKGATE)[(RCX).R * 2] = g1; WSP(float, WS_TOKGATE)[(RCX).R * 2 + 1] = g2; } } while (0)
#pragma unroll
    for (int k = 0; k < RC; ++k) { const int idx = F.gw + k * F.NGW;
        if (idx < nrows) { const RowCtx rc = row_ctx(idx, latent_only); norm_row(F, rc, layer, 1, 1, vs[k]); MOE_ROUTE(vs[k], k, rc); } }
    for (int k = RC, idx = F.gw + RC * F.NGW; idx < nrows; idx += F.NGW, ++k) {
        const RowCtx rc = row_ctx(idx, latent_only); f32x4 v[4]; norm_row(F, rc, layer, 1, 1, v); MOE_ROUTE(v, k, rc); }
#undef MOE_ROUTE
    LDS_WAIT(); __syncthreads();
    if (F.tid < 8) F.MISC[MI_BASE + F.tid] = __hip_atomic_fetch_add(F.ctl + CW_CNT + 64 * j + F.tid, F.MISC[MI_CNT + F.tid], RLX_AGENT);
    __syncthreads();
#define MOE_SCATTER(V, KK, RCX) do { volatile LAS unsigned* ent = F.MISC + MI_ENT + (F.wave * 16 + (KK)) * 4; \
        const int i1 = (int)ent[0], i2 = (int)ent[2]; const int q1 = i1 * ECAP + (int)(F.MISC[MI_BASE + i1] + ent[1]), q2 = i2 * ECAP + (int)(F.MISC[MI_BASE + i2] + ent[3]); \
        if (UPM_FP8) { store_row_fp8(WSP(unsigned char, WS_ASORT) + (size_t)q1 * D, V, lane); store_row_fp8(WSP(unsigned char, WS_ASORT) + (size_t)q2 * D, V, lane); } \
        else { store_row_bf16(WSP(bf16_t, WS_ASORT) + (size_t)q1 * D, V, lane); store_row_bf16(WSP(bf16_t, WS_ASORT) + (size_t)q2 * D, V, lane); } \
        if (lane == 0) { WSP(int, WS_TOKPOS)[(RCX).R * 2] = q1; WSP(int, WS_TOKPOS)[(RCX).R * 2 + 1] = q2; } } while (0)
#pragma unroll
    for (int k = 0; k < RC; ++k) { const int idx = F.gw + k * F.NGW;
        if (idx < nrows) { const RowCtx rc = row_ctx(idx, latent_only); MOE_SCATTER(vs[k], k, rc); } }
    for (int k = RC, idx = F.gw + RC * F.NGW; idx < nrows; idx += F.NGW, ++k) {
        const RowCtx rc = row_ctx(idx, latent_only); f32x4 v[4]; norm_row(F, rc, layer, 1, 1, v); MOE_SCATTER(v, k, rc); }
#undef MOE_SCATTER
}
#ifndef OVF_SPLIT
#define OVF_SPLIT 1
#endif
__device__ __forceinline__ void final_phase(const Frame& F, int layer) {
    const LAS int* tb = (const LAS int*)(F.MISC + MI_TB); const int lane = F.lane;
    const int nt = tb[8], nun = nt * 4, lmain = (nun / F.G) * F.G, remu = nun - lmain; const bool ovon = OVF_SPLIT && remu > 0 && remu <= 128;
    const float* slab = WSP(float, WS_ASORT);
    for (int idx = F.gw; idx < MLAT; idx += F.NGW) {
        const RowCtx rc = row_ctx(idx, true);
        const f16_t* xs = WSP(f16_t, WS_XS) + (size_t)rc.R * D; float* o = F.out + (size_t)idx * D;
        const int p0 = WSP(int, WS_TOKPOS)[rc.R * 2], p1 = WSP(int, WS_TOKPOS)[rc.R * 2 + 1]; const float g0 = WSP(float, WS_TOKGATE)[rc.R * 2], g1 = WSP(float, WS_TOKGATE)[rc.R * 2 + 1];
        const int e0 = p0 / ECAP, e1 = p1 / ECAP; const int r0 = tb[e0] * 256 + (p0 - e0 * ECAP), r1 = tb[e1] * 256 + (p1 - e1 * ECAP);
        const float* gf = WSP(float, WS_MOD) + ((size_t)layer * 9 + rc.mr) * 6144 + 5 * 1024;
#pragma unroll
        for (int jj = 0; jj < 4; ++jj) { const int col = 4 * lane + 256 * jj; f32x4 x = __builtin_convertvector(*(const f16x4*)(xs + col), f32x4); const f32x4 g = *(const f32x4*)(gf + col);
            f32x4 ya, yb;
#pragma unroll
            for (int w = 0; w < 2; ++w) { const int r = w ? r1 : r0; const int t = r >> 8, gid = t >> 3, fm = gid * 8, gsz = (nt - fm) < 8 ? (nt - fm) : 8, L = gid * 32 + jj * gsz + (t - fm);
                f32x4 y;
                if (ovon && L >= lmain) { const float* sp = slab + (size_t)(L - lmain) * 65536 + (size_t)(r & 255) * 256 + 4 * lane; y = *(const f32x4*)sp;
#pragma unroll
                    for (int ks = 1; ks < 7; ++ks) y += *(const f32x4*)(sp + (size_t)ks * 128 * 65536); }
                else { const u32x2 a = *(const u32x2*)(WSP(bf16_t, WS_Y) + (size_t)r * D + col); y = (f32x4){bf_lo(a.x), bf_hi(a.x), bf_lo(a.y), bf_hi(a.y)}; }
                if (w) yb = y; else ya = y; }
            x += g * (ya * g0 + yb * g1);
#ifdef SAT_TEST
            { const float big = F.in[I_X][0] * 0.0f + 1000.0f; const unsigned tw = __builtin_amdgcn_cvt_pk_fp8_f32(big, -big, 0, false) & 0xffffu;
              if (tw != 0xFE7Eu && idx == 0 && jj == 0 && lane == 0) x[0] = __builtin_nanf(""); }
#endif
            *(f32x4*)(o + col) = x; }
    }
}

template <int LPG> __device__ __forceinline__ void qk_pass(const Frame& F, bf16_t* raw, int ld, int NQ, int NK, const float* qg, const float* kg, float qscale, const float* rc_, const float* rs_) {
    constexpr int HD = LPG * 8; const int nel = (NQ + NK) * HD; const int lane = F.lane, lig = lane & (LPG - 1);
    for (int R = F.gw; R < M; R += F.NGW) {
        const int j = R % RPB; const bool rope = (j >= CTXL) && !((DBG_BREAK == 1 && LPG == 16) || (DBG_BREAK == 2 && LPG == 8)); const int pos = rope ? j - CTXL : 0;
        const float* cs = rc_ + (size_t)pos * (HD / 2); const float* sn = rs_ + (size_t)pos * (HD / 2);
        bf16_t* rowp = raw + (size_t)R * ld;
        for (int c0 = 0; c0 < nel; c0 += 512) {
            const int col = c0 + 8 * lane; const bool act = col < nel; const int seg = col / HD; const bool isq = seg < NQ;
            float v[8];
            if (act) ld8(rowp + col, v); else {
#pragma unroll
                for (int i = 0; i < 8; ++i) v[i] = 0.f; }
            seg_norm_rope<LPG>(v, lig, isq ? qg : kg, rope, cs, sn, isq ? qscale : 1.0f);
            if (act) st8(rowp + col, v);
        }
    }
}
__device__ __forceinline__ void mla_pb2(const Frame& F) {
    const int lane = F.lane;
    const bf16_t* dn = WSP(bf16_t, WS_DN); bf16_t* cqn = WSP(bf16_t, WS_CQN); bf16_t* ckvn = WSP(bf16_t, WS_CKVN); bf16_t* kbuf = WSP(bf16_t, WS_KBUF);
    for (int R = F.gw; R < M; R += F.NGW) {
        const int j = R % RPB; const bool rope = (j >= CTXL) && (DBG_BREAK != 6); const int pos = rope ? j - CTXL : 0;
        const bf16_t* rowp = dn + (size_t)R * 768; float v[8];
        {
            const bool act = lane < 48; if (act) ld8(rowp + 8 * lane, v); else {
#pragma unroll
                for (int i = 0; i < 8; ++i) v[i] = 0.f; }
            float ss = 0.f;
#pragma unroll
            for (int i = 0; i < 8; ++i) ss += v[i] * v[i];
            const float rstd = 1.0f / sqrtf(wave_sum(ss) * (1.0f / 384.0f) + EPS);
            if (act) { const float* g = F.in[I_MLA_QAG] + 8 * lane;
#pragma unroll
                for (int i = 0; i < 8; ++i) v[i] *= rstd * g[i];
                st8(cqn + (size_t)R * 384 + 8 * lane, v); }
        }
        {
            const bool act = lane < 32; if (act) ld8(rowp + 384 + 8 * lane, v); else {
#pragma unroll
                for (int i = 0; i < 8; ++i) v[i] = 0.f; }
            float ss = 0.f;
#pragma unroll
            for (int i = 0; i < 8; ++i) ss += v[i] * v[i];
            const float rstd = 1.0f / sqrtf(wave_sum(ss) * (1.0f / 256.0f) + EPS);
            if (act) { const float* g = F.in[I_MLA_KVAG] + 8 * lane;
#pragma unroll
                for (int i = 0; i < 8; ++i) v[i] *= rstd * g[i];
                st8(ckvn + (size_t)R * 256 + 8 * lane, v); }
        }
        {
            const bool act = lane < 8; if (act) ld8(rowp + 640 + 8 * lane, v); else {
#pragma unroll
                for (int i = 0; i < 8; ++i) v[i] = 0.f; }
            seg_norm_rope<8>(v, lane & 7, F.in[I_MLA_KG] + 128, rope, WSP(float, WS_R64C) + (size_t)pos * 32, WSP(float, WS_R64S) + (size_t)pos * 32, 1.0f);
            if (act) {
#pragma unroll
                for (int h = 0; h < 8; ++h) st8(kbuf + (size_t)R * 1536 + h * 192 + 128 + 8 * lane, v); }
        }
    }
}
__device__ __forceinline__ void mla_pc(const Frame& F) {
    const int lane = F.lane;
    bf16_t* qraw = WSP(bf16_t, WS_QRAW); const bf16_t* kvraw = WSP(bf16_t, WS_KVRAW); bf16_t* kbuf = WSP(bf16_t, WS_KBUF);
    for (int R = F.gw; R < M; R += F.NGW) {
        const int j = R % RPB; const bool rope = (j >= CTXL) && (DBG_BREAK != 6); const int pos = rope ? j - CTXL : 0; float v[8];
#pragma unroll
        for (int p = 0; p < 2; ++p) { const int head = 4 * p + (lane >> 4), e0 = 8 * (lane & 15);
            bf16_t* q = qraw + (size_t)R * 1536 + head * 192 + e0; ld8(q, v);
            seg_norm_rope<16>(v, lane & 15, F.in[I_MLA_QG], false, nullptr, nullptr, SC_MLA); st8(q, v);
            ld8(kvraw + (size_t)R * 2048 + head * 256 + e0, v);
            seg_norm_rope<16>(v, lane & 15, F.in[I_MLA_KG], false, nullptr, nullptr, 1.0f); st8(kbuf + (size_t)R * 1536 + head * 192 + e0, v); }
        { const int head = lane >> 3, e0 = 8 * (lane & 7);
            bf16_t* q = qraw + (size_t)R * 1536 + head * 192 + 128 + e0; ld8(q, v);
            seg_norm_rope<8>(v, lane & 7, F.in[I_MLA_QG] + 128, rope, WSP(float, WS_R64C) + (size_t)pos * 32, WSP(float, WS_R64S) + (size_t)pos * 32, SC_MLA); st8(q, v); }
    }
}
__device__ __forceinline__ void diff_combine(const Frame& F) {
    const int lane = F.lane; const float* lp = F.in[I_DIFF_LAM];
    const float lam = (DBG_BREAK == 5) ? LAM_INIT : __expf(wave_sum(lp[lane] * lp[64 + lane])) - __expf(wave_sum(lp[128 + lane] * lp[192 + lane])) + LAM_INIT;
    const bf16_t* ob = WSP(bf16_t, WS_OBUF); bf16_t* o2 = WSP(bf16_t, WS_O2);
    for (int idx = F.gw; idx < MLAT; idx += F.NGW) {
        const int R = (idx >> 11) * RPB + CTXL + (idx & 2047);
#pragma unroll
        for (int p = 0; p < 2; ++p) { const int head = 4 * p + (lane >> 4), e0 = 8 * (lane & 15); float a[8], b[8];
            ld8(ob + (size_t)R * 2048 + (2 * head) * 128 + e0, a); ld8(ob + (size_t)R * 2048 + (2 * head + 1) * 128 + e0, b);
#pragma unroll
            for (int i = 0; i < 8; ++i) a[i] -= lam * b[i];
            seg_norm_rope<16>(a, lane & 15, F.in[I_DIFF_SUBLN], false, nullptr, nullptr, 1.0f - LAM_INIT);
            if (WO_FP8 & 8) { float c[8];
#pragma unroll
                for (int i = 0; i < 8; ++i) c[i] = F8CLAMP(F8_W_MUL * a[i]);
                u32x2 w; w.x = pk4_fp8(c[0], c[1], c[2], c[3]); w.y = pk4_fp8(c[4], c[5], c[6], c[7]); *(u32x2*)((unsigned char*)o2 + (size_t)R * D + head * 128 + e0) = w; }
            else st8(o2 + (size_t)R * D + head * 128 + e0, a); }
    }
}

#ifndef MK_MULTI
#define MK_MULTI 0
#endif
constexpr int NPH = 37;
#ifndef DOWN_FP8
#define DOWN_FP8 1
#endif
#ifndef OVF_SPLIT
#define OVF_SPLIT 1
#endif
#ifndef FUSE_QKV
#define FUSE_QKV 7
#endif
#ifndef ATT0_SD
#define ATT0_SD 1
#endif
#ifndef ATT0_QSP
#define ATT0_QSP 0
#endif
#ifndef ATT2_SD
#define ATT2_SD 2
#endif
#ifndef ATT3_SD
#define ATT3_SD 3
#endif
#ifndef ATT1_SD
#define ATT1_SD 1
#endif
#ifndef ATT1_QSP
#define ATT1_QSP 4
#endif
__global__ void __launch_bounds__(NWAVES * 64, 2) mega_fwd(Params P) {
    extern __shared__ __attribute__((aligned(16))) unsigned char lds_raw[];
#if FP8_SAT_MODE
    asm volatile("s_setreg_imm32_b32 hwreg(HW_REG_MODE, 23, 1), 1");
#endif
    Frame F;
    F.lds = (LAS unsigned char*)lds_raw; F.MISC = (volatile LAS unsigned*)(F.lds + LDSCTL_OFF);
    F.tid = threadIdx.x; F.lane = F.tid & 63; F.wave = __builtin_amdgcn_readfirstlane(F.tid >> 6);
    F.G = gridDim.x; { const int bx = blockIdx.x; F.vcu = (F.G % 8 == 0) ? (bx % 8) * (F.G / 8) + bx / 8 : bx; }
    F.gw = F.vcu * NWAVES + F.wave; F.NGW = F.G * NWAVES;
    F.in = P.in; F.out = P.out; F.ws = P.ws; F.ctl = (gu32*)(P.ws + WS_CTL);
    for (int u = F.tid; u < (LDS_BYTES - LDSCTL_OFF) / 4; u += NWAVES * 64) ((LAS unsigned*)(F.lds + LDSCTL_OFF))[u] = 0u;
    __syncthreads();
    const int lo = P.ph_lo, hi = P.ph_hi;
    XcdBarrier bar = xcd_barrier_post((unsigned*)(F.ctl + CW_BAR), F.MISC + MI_BAR);
    LAS unsigned char* const lds = F.lds;
    const int gemm_sa_ = F8_SCL_A;
    const int gemm_g_ = F.G;
    const LAS int* const tbp = (const LAS int*)(F.MISC + MI_TB);
#ifndef ONLY_PH
#define ONLY_PH -1
#endif
#ifndef EMU_MASK
#define EMU_MASK 0ull
#endif
#ifndef DBL_MASK
#define DBL_MASK 0ull
#endif
#define PH(k) F.tid = opaque_tid(); F.lane = F.tid & 63; if ((ONLY_PH < 0 || ONLY_PH == (k)) && lo <= (k) && (k) < hi) for (int rep_ = 0, emu_ = (int)(((unsigned long long)(EMU_MASK) >> (k)) & 1ull); rep_ < 1 + (int)(((unsigned long long)(DBL_MASK) >> (k)) & 1ull); ++rep_)
#ifndef SEAM_REP
#define SEAM_REP 1
#endif
#define SEAM(k) do { if ((k) + 1 < hi) for (int sr_ = 0; sr_ < SEAM_REP; ++sr_) xcd_barrier(bar); } while (0)
#define GEMM_CALL_KS(EPI, EINIT, APTR, BPTR, KK, KSPLIT, NN, NTILES, MODE, AMODE, CIDX) do { const pg8::Gemm g_{(const bf16_t*)(APTR), (const bf16_t*)(BPTR), (KK), (KK) / (KSPLIT), emu_}; \
        const pg8::Sched S_{(NN), (NTILES), gemm_g_, (CIDX), (MODE), (AMODE), (KSPLIT), 2 * (KK) / (KSPLIT), tbp, 0, (NTILES) * (NN) * (KSPLIT), 0}; const pg8::EPI E_ EINIT; pg8::gemm_phase<pg8::EPI, pg8::Sched, pg8::EPI::ALIGN, true>(lds, g_, S_, E_); } while (0)
#define GEMM_CALL(EPI, EINIT, APTR, BPTR, KK, NN, NTILES, MODE, AMODE, CIDX) do { const pg8::Gemm g_{(const bf16_t*)(APTR), (const bf16_t*)(BPTR), (KK), (KK), emu_}; \
        const pg8::Sched S_{(NN), (NTILES), gemm_g_, (CIDX), (MODE), (AMODE), 1, 2 * (KK), tbp, 0, (NTILES) * (NN), 0}; const pg8::EPI E_ EINIT; pg8::gemm_phase<pg8::EPI, pg8::Sched, pg8::EPI::ALIGN, true>(lds, g_, S_, E_); } while (0)
#define GEMM_CALL_R(EPI, EINIT, APTR, BPTR, KK, KLOOP, NN, NTILES, MODE, AMODE, CIDX, LBASE, LEND, OVS) do { const pg8::Gemm g_{(const bf16_t*)(APTR), (const bf16_t*)(BPTR), (KK), (KLOOP)}; \
        const pg8::Sched S_{(NN), (NTILES), gemm_g_, (CIDX), (MODE), (AMODE), 1, 2 * (KLOOP), tbp, (LBASE), (LEND), (OVS)}; const pg8::EPI E_ EINIT; pg8::gemm_phase<pg8::EPI, pg8::Sched, pg8::EPI::ALIGN, true>(lds, g_, S_, E_); } while (0)
#define GEMM_CALL_R8(EPI, EINIT, APTR, BPTR, KK, KLOOP, NN, NTILES, MODE, AMODE, CIDX, LBASE, LEND, OVS) do { const pg8::Gemm g_{(const bf16_t*)(APTR), (const bf16_t*)(BPTR), (KK), (KLOOP), 0, gemm_sa_}; \
        const pg8::Sched S_{(NN), (NTILES), gemm_g_, (CIDX), (MODE), (AMODE), 1, (KLOOP), tbp, (LBASE), (LEND), (OVS)}; const pg8::EPI E_ EINIT; pg8::gemm_phase<pg8::EPI, pg8::Sched, pg8::EPI::ALIGN, true, true>(lds, g_, S_, E_); } while (0)
#define GEMM_CALL8(EPI, EINIT, APTR, BPTR, KK, NN, NTILES, MODE, AMODE, CIDX) do { const pg8::Gemm g_{(const bf16_t*)(APTR), (const bf16_t*)(BPTR), (KK), (KK), 0, gemm_sa_}; \
        const pg8::Sched S_{(NN), (NTILES), gemm_g_, (CIDX), (MODE), (AMODE), 1, (KK), tbp, 0, (NTILES) * (NN), 0}; const pg8::EPI E_ EINIT; pg8::gemm_phase<pg8::EPI, pg8::Sched, pg8::EPI::ALIGN, true, true>(lds, g_, S_, E_); } while (0)
#define MODP(layer, chunk) (WSP(float, WS_MOD) + (size_t)(layer) * 9 * 6144 + (chunk) * 1024)
#define BR(...) {__VA_ARGS__}
#define XCH ((LAS float*)(lds + 131072))
#ifndef CONV_REP
#define CONV_REP 1
#endif
#define TAIL_MOD(nunits, tlo, thi, ilo, ihi) do { const int rem_ = (nunits) % F.G; if (rem_ != 0 && F.vcu >= rem_) { mod_tasks(F, (tlo), (thi), F.vcu - rem_, F.G - rem_); __syncthreads(); convert_items(F, (ilo), (ihi), F.vcu - rem_, F.G - rem_); } } while (0)
#define TAIL(nunits, ilo, ihi) for (int cr_ = 0; cr_ < CONV_REP; ++cr_) do { const int rem_ = (nunits) % F.G; if (rem_ == 0) convert_items(F, (ilo), (ihi), F.vcu, F.G); else if (F.vcu >= rem_) convert_items(F, (ilo), (ihi), F.vcu - rem_, F.G - rem_); } while (0)

#define DED_SPLIT(nunits) const int r_ = ((nunits) + F.G - 1) / F.G, gc_ = r_ > 0 ? ((nunits) + r_ - 1) / r_ : F.G
#define DED_CONV(ilo, ihi) convert_items(F, (ilo), (ihi), F.vcu - gc_, F.G - gc_)
    PH(0) { p0_prologue(F); SEAM(0); }
    PH(1) { norm_phase_dense(F, 0, 0, 0, false, (QKV_FP8 & 1) != 0); SEAM(1); }
    PH(2) { if constexpr (((FUSE_QKV >> 0) & 1) && (QKV_FP8 & 1)) { GEMM_CALL8(EpiQKV<128>, BR(WSP(bf16_t, WS_RAW), 1536, F.in[I_GQA_QG], F.in[I_GQA_KG], SC_GQA, WSP(float, WS_R128C), WSP(float, WS_R128S), 1024, 1280, XCH), WSP(unsigned char, WS_H), WSP(unsigned char, WS_WQKV0), 1024, 6, MT, 0, 0, F.vcu); }
            else if constexpr ((FUSE_QKV >> 0) & 1) { GEMM_CALL(EpiQKV<128>, BR(WSP(bf16_t, WS_RAW), 1536, F.in[I_GQA_QG], F.in[I_GQA_KG], SC_GQA, WSP(float, WS_R128C), WSP(float, WS_R128S), 1024, 1280, XCH), WSP(bf16_t, WS_H), WSP(bf16_t, WS_WQKV0), 1024, 6, MT, 0, 0, F.vcu); } else { GEMM_CALL(EpiStore, BR(WSP(bf16_t, WS_RAW), 1536, 0), WSP(bf16_t, WS_H), WSP(bf16_t, WS_WQKV0), 1024, 6, MT, 0, 0, F.vcu); } TAIL(MT * 6, TI_PRO, TWA); SEAM(2); }
    PH(3) { if constexpr (!((FUSE_QKV >> 0) & 1)) { qk_pass<16>(F, WSP(bf16_t, WS_RAW), 1536, 8, 2, F.in[I_GQA_QG], F.in[I_GQA_KG], SC_GQA, WSP(float, WS_R128C), WSP(float, WS_R128S)); SEAM(3); } }
    PH(4) { const att::AttnP A{WSP(bf16_t, WS_RAW), WSP(bf16_t, WS_RAW) + 1024, WSP(bf16_t, WS_RAW) + 1280, WSP(bf16_t, WS_OBUF), nullptr};
            att::attn_phase<128, 128, false, ATT0_SD, ATT0_QSP, 1536, 1536, 1536, 1024, 8, 4, 4, 128, 128, 1, (WO_FP8 & 1) != 0>((LAS char*)lds, A, F.G, F.vcu); SEAM(4); }
    PH(5) { if constexpr ((WO_FP8 & 1) != 0) { DED_SPLIT(MT * 4); if (F.vcu < gc_) { const int gemm_g_ = gc_; const int gemm_sa_ = F8_SCL_W; GEMM_CALL8(EpiResGate, BR(WSP(f16_t, WS_XS), MODP(0, 2)), WSP(unsigned char, WS_OBUF), WSP(unsigned char, WS_WO0), 1024, 4, MT, 0, 0, F.vcu); } else DED_CONV(TWA, TWB); }
            else { GEMM_CALL(EpiResGate, BR(WSP(f16_t, WS_XS), MODP(0, 2)), WSP(bf16_t, WS_OBUF), WSP(bf16_t, WS_WO0), 1024, 4, MT, 0, 0, F.vcu); TAIL(MT * 4, TWA, TWB); } SEAM(5); }
    PH(6) { norm_phase_dense(F, 0, 1, 1, false); SEAM(6); }
    PH(7) { GEMM_CALL(EpiSwiGLU8, BR(WSP(unsigned char, WS_ACT), FF), WSP(bf16_t, WS_H), WSP(bf16_t, WS_WF13), 1024, 28, MT, 0, 0, F.vcu); TAIL(MT * 28, TWB, TWC); SEAM(7); }
    PH(8) { DED_SPLIT(MT * 4); if (F.vcu < gc_) { const int gemm_g_ = gc_; GEMM_CALL8(EpiResGate, BR(WSP(f16_t, WS_XS), MODP(0, 5)), WSP(unsigned char, WS_ACT), WSP(unsigned char, WS_WF2), FF, 4, MT, 0, 0, F.vcu); } else DED_CONV(TWC, TWD); SEAM(8); }
    PH(9) { norm_phase_dense(F, 1, 0, 1, false, (QKV_FP8 & 2) != 0); SEAM(9); }
    PH(10) { if constexpr ((QKV_FP8 & 2) != 0) { GEMM_CALL8(EpiStore, BR(WSP(bf16_t, WS_DN), 768, 0), WSP(unsigned char, WS_H), WSP(unsigned char, WS_WDOWN1), 1024, 3, MT, 0, 0, F.vcu); }
             else { GEMM_CALL(EpiStore, BR(WSP(bf16_t, WS_DN), 768, 0), WSP(bf16_t, WS_H), WSP(bf16_t, WS_WDOWN1), 1024, 3, MT, 0, 0, F.vcu); } TAIL(MT * 3, TWD, TWE); SEAM(10); }
    PH(11) { mla_pb2(F); SEAM(11); }
    PH(12) { GEMM_CALL(EpiStore, BR(WSP(bf16_t, WS_QRAW), 1536, 0), WSP(bf16_t, WS_CQN), WSP(bf16_t, WS_WUQ1), 384, 6, MT, 0, 0, F.vcu);
             GEMM_CALL(EpiStore, BR(WSP(bf16_t, WS_KVRAW), 2048, 0), WSP(bf16_t, WS_CKVN), WSP(bf16_t, WS_WUKV1), 256, 8, MT, 0, 0, F.G - 1 - F.vcu); SEAM(12); }
    PH(13) { mla_pc(F); SEAM(13); }
    PH(14) { const att::AttnP A{WSP(bf16_t, WS_QRAW), WSP(bf16_t, WS_KBUF), WSP(bf16_t, WS_KVRAW) + 128, WSP(bf16_t, WS_OBUF), nullptr};
             att::attn_phase<192, 128, false, ATT1_SD, ATT1_QSP, 1536, 1536, 2048, 1024, 8, 1, 1, 192, 256, 1, (WO_FP8 & 2) != 0>((LAS char*)lds, A, F.G, F.vcu); SEAM(14); }
    PH(15) { DED_SPLIT(MT * 4); if (F.vcu < gc_) { const int gemm_g_ = gc_; if constexpr ((WO_FP8 & 2) != 0) { const int gemm_sa_ = F8_SCL_W; GEMM_CALL8(EpiResGate, BR(WSP(f16_t, WS_XS), MODP(1, 2)), WSP(unsigned char, WS_OBUF), WSP(unsigned char, WS_WO1), 1024, 4, MT, 0, 0, F.vcu); }
             else { GEMM_CALL(EpiResGate, BR(WSP(f16_t, WS_XS), MODP(1, 2)), WSP(bf16_t, WS_OBUF), WSP(bf16_t, WS_WO1), 1024, 4, MT, 0, 0, F.vcu); } } else DED_CONV(TWE, TWF); SEAM(15); }
    PH(16) { norm_phase_moe(F, 1, 0, false); SEAM(16); }
    PH(17) { moe_tile_base(F, 0); const int nt_ = __builtin_amdgcn_readfirstlane(tbp[8]);
             if constexpr (UPM_FP8) { GEMM_CALL8(EpiSwiGLU8, BR(WSP(unsigned char, WS_ACT), FF), WSP(unsigned char, WS_ASORT), WSP(unsigned char, WS_WM13), 1024, 28, nt_, 2, 0, F.vcu); }
             else { GEMM_CALL(EpiSwiGLU8, BR(WSP(unsigned char, WS_ACT), FF), WSP(bf16_t, WS_ASORT), WSP(bf16_t, WS_WM13), 1024, 28, nt_, 2, 0, F.vcu); } TAIL(nt_ * 28, TWF, TWG); SEAM(17); }
    PH(18) { moe_tile_base(F, 0); const int nt_ = __builtin_amdgcn_readfirstlane(tbp[8]);
             DED_SPLIT(nt_ * 4); if (F.vcu < gc_) { const int gemm_g_ = gc_; GEMM_CALL8(EpiStore, BR(WSP(bf16_t, WS_Y), 1024, 0), WSP(unsigned char, WS_ACT), WSP(unsigned char, WS_WM2), FF, 4, nt_, 2, 1, F.vcu); } else DED_CONV(TWG, TWH); SEAM(18); }
    PH(19) { moe_tile_base(F, 0); norm_phase_dense(F, 2, 0, 2, false, (QKV_FP8 & 4) != 0); SEAM(19); }
    PH(20) { if constexpr (((FUSE_QKV >> 1) & 1) && (QKV_FP8 & 4)) { GEMM_CALL8(EpiQKV<64>, BR(WSP(bf16_t, WS_RAW), 1280, F.in[I_WIN_QG], F.in[I_WIN_KG], SC_64, WSP(float, WS_R64C), WSP(float, WS_R64S), 1024, 1152, XCH), WSP(unsigned char, WS_H), WSP(unsigned char, WS_WQKV2), 1024, 5, MT, 0, 0, F.vcu); }
             else if constexpr ((FUSE_QKV >> 1) & 1) { GEMM_CALL(EpiQKV<64>, BR(WSP(bf16_t, WS_RAW), 1280, F.in[I_WIN_QG], F.in[I_WIN_KG], SC_64, WSP(float, WS_R64C), WSP(float, WS_R64S), 1024, 1152, XCH), WSP(bf16_t, WS_H), WSP(bf16_t, WS_WQKV2), 1024, 5, MT, 0, 0, F.vcu); } else { GEMM_CALL(EpiStore, BR(WSP(bf16_t, WS_RAW), 1280, 0), WSP(bf16_t, WS_H), WSP(bf16_t, WS_WQKV2), 1024, 5, MT, 0, 0, F.vcu); } TAIL(MT * 5, TWH, TWI); SEAM(20); }
    PH(21) { if constexpr (!((FUSE_QKV >> 1) & 1)) { qk_pass<8>(F, WSP(bf16_t, WS_RAW), 1280, 16, 2, F.in[I_WIN_QG], F.in[I_WIN_KG], SC_64, WSP(float, WS_R64C), WSP(float, WS_R64S)); SEAM(21); } }
    PH(22) { const att::AttnP A{WSP(bf16_t, WS_RAW), WSP(bf16_t, WS_RAW) + 1024, WSP(bf16_t, WS_RAW) + 1152, WSP(bf16_t, WS_OBUF), F.in[I_WIN_SINK]};
             att::attn_phase<64, 64, true, ATT2_SD, 0, 1280, 1280, 1280, 1024, 16, 8, 8, 64, 64, 1, (WO_FP8 & 4) != 0>((LAS char*)lds, A, F.G, F.vcu); SEAM(22); }
    PH(23) { if constexpr ((WO_FP8 & 4) != 0) { DED_SPLIT(MT * 4); if (F.vcu < gc_) { const int gemm_g_ = gc_; const int gemm_sa_ = F8_SCL_W; GEMM_CALL8(EpiResGate, BR(WSP(f16_t, WS_XS), MODP(2, 2)), WSP(unsigned char, WS_OBUF), WSP(unsigned char, WS_WO2), 1024, 4, MT, 0, 0, F.vcu); } else DED_CONV(TWI, TWJ); }
             else { GEMM_CALL(EpiResGate, BR(WSP(f16_t, WS_XS), MODP(2, 2)), WSP(bf16_t, WS_OBUF), WSP(bf16_t, WS_WO2), 1024, 4, MT, 0, 0, F.vcu); TAIL(MT * 4, TWI, TWJ); } SEAM(23); }
    PH(24) { norm_phase_dense(F, 2, 1, 1, false); SEAM(24); }
    PH(25) { GEMM_CALL(EpiSwiGLU8, BR(WSP(unsigned char, WS_ACT), FF), WSP(bf16_t, WS_H), WSP(bf16_t, WS_WF13) + (size_t)7168 * 1024, 1024, 28, MT, 0, 0, F.vcu); TAIL(MT * 28, TWJ, TWK); SEAM(25); }
    PH(26) { DED_SPLIT(MT * 4); if (F.vcu < gc_) { const int gemm_g_ = gc_; GEMM_CALL8(EpiResGate, BR(WSP(f16_t, WS_XS), MODP(2, 5)), WSP(unsigned char, WS_ACT), WSP(unsigned char, WS_WF2) + (size_t)1024 * FF, FF, 4, MT, 0, 0, F.vcu); } else DED_CONV(TWK, TI_END); SEAM(26); }
    PH(27) { norm_phase_dense(F, 3, 0, 1, false, (QKV_FP8 & 8) != 0); SEAM(27); }
    PH(28) { if constexpr (((FUSE_QKV >> 2) & 1) && (QKV_FP8 & 8)) { GEMM_CALL8(EpiQKV<64>, BR(WSP(bf16_t, WS_RAW), 3072, F.in[I_DIFF_QG], F.in[I_DIFF_KG], SC_64, WSP(float, WS_R64C), WSP(float, WS_R64S), 1024, 2048, XCH), WSP(unsigned char, WS_H), WSP(unsigned char, WS_WQKV3), 1024, 12, MT, 0, 0, F.vcu); }
             else if constexpr ((FUSE_QKV >> 2) & 1) { GEMM_CALL(EpiQKV<64>, BR(WSP(bf16_t, WS_RAW), 3072, F.in[I_DIFF_QG], F.in[I_DIFF_KG], SC_64, WSP(float, WS_R64C), WSP(float, WS_R64S), 1024, 2048, XCH), WSP(bf16_t, WS_H), WSP(bf16_t, WS_WQKV3), 1024, 12, MT, 0, 0, F.vcu); } else { GEMM_CALL(EpiStore, BR(WSP(bf16_t, WS_RAW), 3072, 0), WSP(bf16_t, WS_H), WSP(bf16_t, WS_WQKV3), 1024, 12, MT, 0, 0, F.vcu); } SEAM(28); }
    PH(29) { if constexpr (!((FUSE_QKV >> 2) & 1)) { qk_pass<8>(F, WSP(bf16_t, WS_RAW), 3072, 16, 16, F.in[I_DIFF_QG], F.in[I_DIFF_KG], SC_64, WSP(float, WS_R64C), WSP(float, WS_R64S)); SEAM(29); } }
    PH(30) { const att::AttnP A{WSP(bf16_t, WS_RAW), WSP(bf16_t, WS_RAW) + 1024, WSP(bf16_t, WS_RAW) + 2048, WSP(bf16_t, WS_OBUF), nullptr};
             att::attn_phase<64, 128, false, ATT3_SD, 0, 3072, 3072, 3072, 2048, 16, 1, 2, 64, 128, 0>((LAS char*)lds, A, F.G, F.vcu); SEAM(30); }
    PH(31) { diff_combine(F); SEAM(31); }
    PH(32) { if constexpr ((WO_FP8 >> 3) & 1) { const int gemm_sa_ = F8_SCL_W; GEMM_CALL8(EpiResGate, BR(WSP(f16_t, WS_XS), MODP(3, 2)), WSP(unsigned char, WS_O2), WSP(unsigned char, WS_WO3), 1024, 4, 64, 1, 0, F.vcu); }
             else { GEMM_CALL(EpiResGate, BR(WSP(f16_t, WS_XS), MODP(3, 2)), WSP(bf16_t, WS_O2), WSP(bf16_t, WS_WO3), 1024, 4, 64, 1, 0, F.vcu); } SEAM(32); }
    PH(33) { norm_phase_moe(F, 3, 1, true); SEAM(33); }
    PH(34) { moe_tile_base(F, 1); const int nt_ = __builtin_amdgcn_readfirstlane(tbp[8]);
             if constexpr (UPM_FP8) { GEMM_CALL8(EpiSwiGLU8, BR(WSP(unsigned char, WS_ACT), FF), WSP(unsigned char, WS_ASORT), WSP(unsigned char, WS_WM13) + (size_t)NEXP * 7168 * 1024, 1024, 28, nt_, 2, 0, F.vcu); }
             else { GEMM_CALL(EpiSwiGLU8, BR(WSP(unsigned char, WS_ACT), FF), WSP(bf16_t, WS_ASORT), WSP(bf16_t, WS_WM13) + (size_t)NEXP * 7168 * 1024, 1024, 28, nt_, 2, 0, F.vcu); } SEAM(34); }
    PH(35) { moe_tile_base(F, 1); const int nt_ = __builtin_amdgcn_readfirstlane(tbp[8]);
             const int nun_ = nt_ * 4, lmain_ = (nun_ / F.G) * F.G, rem_ = nun_ - lmain_;
             if (OVF_SPLIT && rem_ > 0 && rem_ <= 128) {
                 GEMM_CALL_R8(EpiStore, BR(WSP(bf16_t, WS_Y), 1024, 0), WSP(unsigned char, WS_ACT), WSP(unsigned char, WS_WM2) + (size_t)NEXP * 1024 * FF, FF, FF, 4, nt_, 2, 1, F.vcu, 0, lmain_, 0);
                 GEMM_CALL_R8(EpiSlab, BR(WSP(float, WS_ASORT)), WSP(unsigned char, WS_ACT), WSP(unsigned char, WS_WM2) + (size_t)NEXP * 1024 * FF, FF, 512, 4, nt_, 2, 1, F.vcu, lmain_, nun_, 7);
             } else {
                 GEMM_CALL8(EpiStore, BR(WSP(bf16_t, WS_Y), 1024, 0), WSP(unsigned char, WS_ACT), WSP(unsigned char, WS_WM2) + (size_t)NEXP * 1024 * FF, FF, 4, nt_, 2, 1, F.vcu);
             }
             SEAM(35); }
    PH(36) { moe_tile_base(F, 1); final_phase(F, 3); }
#undef PH
#undef SEAM
}

extern "C" void kernel_launch(void* const* d_in, const int* in_sizes, int n_in, void* d_out, int out_size, void* d_ws, size_t ws_size, hipStream_t stream) {
    static int grid = 0;
    if (grid == 0) {
        if (n_in != N_IN || in_sizes[0] != NB * SEQ * D || out_size != NB * SEQ * D || ws_size < WS_END) {
            fprintf(stderr, "kernel_launch: shape mismatch: n_in %d in0 %d out %d ws %zu (need %zu); nothing launched\n", n_in, n_in > 0 ? in_sizes[0] : -1, out_size, ws_size, (size_t)WS_END); grid = -1; return; }
        int dev = 0, cus = 0;
        if (hipGetDevice(&dev) != hipSuccess || hipDeviceGetAttribute(&cus, hipDeviceAttributeMultiprocessorCount, dev) != hipSuccess) { fprintf(stderr, "kernel_launch: device query failed\n"); grid = -1; return; }
        if (hipFuncSetAttribute((const void*)mega_fwd, hipFuncAttributeMaxDynamicSharedMemorySize, LDS_BYTES) != hipSuccess) { fprintf(stderr, "kernel_launch: hipFuncSetAttribute failed\n"); grid = -1; return; }
        int per_cu = 0;
        if (hipOccupancyMaxActiveBlocksPerMultiprocessor(&per_cu, (const void*)mega_fwd, NWAVES * 64, LDS_BYTES) != hipSuccess || per_cu < 1) fprintf(stderr, "kernel_launch: note: occupancy query reports %d\n", per_cu);
        (void)hipGetLastError();
        grid = cus < 256 ? cus : 256;
        if (grid != 256) fprintf(stderr, "kernel_launch: warning: %d CUs; the phase programme assumes 256 workgroups\n", grid);
    }
    if (grid < 0) return;
    if (hipMemsetAsync((char*)d_ws + WS_CTL, 0, CTL_ZERO_BYTES, stream) != hipSuccess) { fprintf(stderr, "kernel_launch: memset failed\n"); return; }
    Params p{};
    for (int i = 0; i < N_IN; ++i) p.in[i] = (const float*)d_in[i];
    p.out = (float*)d_out; p.ws = (unsigned char*)d_ws;
#if MK_MULTI
    for (int ph = 0; ph < NPH; ++ph) { p.ph_lo = ph; p.ph_hi = ph + 1; hipLaunchKernelGGL(mega_fwd, dim3(grid), dim3(NWAVES * 64), LDS_BYTES, stream, p); }
#else
    p.ph_lo = 0; p.ph_hi = NPH;
    hipLaunchKernelGGL(mega_fwd, dim3(grid), dim3(NWAVES * 64), LDS_BYTES, stream, p);
#endif
    const hipError_t le = hipPeekAtLastError();
    if (le != hipSuccess) fprintf(stderr, "kernel_launch: launch failed: %s\n", hipGetErrorName(le));
}
```

```cpp
#include <hip/hip_runtime.h>
#include <cstdio>
#include <cstdint>

#define GAS __attribute__((address_space(1)))
#define LAS __attribute__((address_space(3)))
typedef unsigned short bf16_t;
typedef short bf16x8 __attribute__((ext_vector_type(8)));
typedef short s16x4 __attribute__((ext_vector_type(4)));
typedef float f32x4 __attribute__((ext_vector_type(4)));
typedef _Float16 f16_t;
typedef _Float16 f16x4 __attribute__((ext_vector_type(4)));
typedef _Float16 f16x8 __attribute__((ext_vector_type(8)));
typedef float f32x8 __attribute__((ext_vector_type(8)));
typedef float f32x2 __attribute__((ext_vector_type(2)));
typedef float f32x16 __attribute__((ext_vector_type(16)));
typedef unsigned u32x4 __attribute__((ext_vector_type(4)));
typedef unsigned u32x2 __attribute__((ext_vector_type(2)));

__device__ __forceinline__ unsigned cvt_pk_bf16(float lo, float hi) { unsigned r; asm volatile("v_cvt_pk_bf16_f32 %0, %1, %2" : "=v"(r) : "v"(lo), "v"(hi)); return r; }
__device__ __forceinline__ float bf_lo(unsigned w) { return __uint_as_float(w << 16); }
__device__ __forceinline__ float bf_hi(unsigned w) { return __uint_as_float(w & 0xffff0000u); }

typedef int v8i_t __attribute__((ext_vector_type(8)));
typedef int v4i_t __attribute__((ext_vector_type(4)));
__device__ __forceinline__ v8i_t cat8(bf16x8 lo, bf16x8 hi) { const v4i_t a = __builtin_bit_cast(v4i_t, lo), b = __builtin_bit_cast(v4i_t, hi); return __builtin_shufflevector(a, b, 0, 1, 2, 3, 4, 5, 6, 7); }
constexpr float F8_ACT_MUL = 8.0f, F8_W_MUL = 64.0f;
#define F8_SCL_A 124
#define F8_SCL_W 121
__device__ __forceinline__ unsigned pk4_fp8(float a, float b, float c, float d) { unsigned w = 0u; w = __builtin_amdgcn_cvt_pk_fp8_f32(a, b, w, false); w = __builtin_amdgcn_cvt_pk_fp8_f32(c, d, w, true); return w; }
__device__ __forceinline__ int opaque_tid() { int t = threadIdx.x; asm volatile("" : "+v"(t)); return t; }

namespace pg8 {
#define PG8_LAS __attribute__((address_space(3)))
constexpr int BM = 256, BK = 64, HALF = 128, HTB = HALF * BK * 2  , STAGE_BYTES = 8 * HTB;

__host__ __device__ __forceinline__ int lds_byte(int r, int c) { const int st = (r >> 4) * 2 + (c >> 5), rr = r & 15, cc = c & 31, ob = rr * 64 + cc * 2; return st * 1024 + (ob ^ (((ob >> 9) & 1) << 5)); }
__host__ __device__ __forceinline__ void stage_rc(int b, int& R, int& C) { const int st = b / 1024, sb = b % 1024, swz = sb ^ (((sb >> 9) & 1) << 5); R = (st >> 1) * 16 + swz / 64; C = (st & 1) * 32 + (swz % 64) / 2; }
__host__ __device__ __forceinline__ int perm32(int rho) { const int n = rho >> 4, i = rho & 15; return 8 * (i >> 2) + 4 * n + (i & 3); }

struct Unit { int pm, pn, om, on, kb, ks, ov; };
__device__ __forceinline__ bf16x8 emu8v(bf16x8 v) { u32x4 w = __builtin_bit_cast(u32x4, v); w.x = (w.x + 0x00080008u) & 0xFFF0FFF0u; w.y = (w.y + 0x00080008u) & 0xFFF0FFF0u; w.z = (w.z + 0x00080008u) & 0xFFF0FFF0u; w.w = (w.w + 0x00080008u) & 0xFFF0FFF0u; return __builtin_bit_cast(bf16x8, w); }
struct Gemm { const bf16_t* A; const bf16_t* Bt; int K, KL; int emu = 0; int sa = F8_SCL_A; };

#ifndef GROWS
#define GROWS 8
#endif
struct Sched {
    int nN, ntiles, G, c, mode, amode, KS, KL;
    const LAS int* tb;
    int lbase, lend, ovs;
    __device__ __forceinline__ bool next(int i, Unit& u) const {
        int L, kso = 0, ov = 0;
        if (ovs) { const int Lo = i * G + c; if (Lo >= (lend - lbase) * ovs) return false; ov = Lo / ovs; kso = Lo - ov * ovs; L = lbase + ov; }
        else { L = lbase + i * G + c; if (L >= lend) return false; }
        const int ksn = ovs ? 1 : KS;
        const int nig = GROWS * nN * ksn, gid = L / nig, fm = gid * GROWS, gsz = (ntiles - fm) < GROWS ? (ntiles - fm) : GROWS, rem = L - gid * nig;
        const int t = fm + rem % gsz, q = rem / gsz, ks = q / nN, pn = q - ks * nN;
        u.ks = ovs ? kso : ks; u.kb = u.ks * KL; u.ov = ov;
        if (mode == 0) { u.pm = t; u.pn = pn; u.om = t; u.on = pn; }
        else if (mode == 1) { const int tt = t + (t >> 3) + 1; u.pm = tt; u.pn = pn; u.om = tt; u.on = pn; }
        else { int e = 0;
#pragma unroll
            for (int k = 1; k < 8; ++k) e += (t >= __builtin_amdgcn_readfirstlane(tb[k])) ? 1 : 0;
            const int rt = t - __builtin_amdgcn_readfirstlane(tb[e]); u.pm = amode ? t : e * 72 + rt; u.pn = e * nN + pn; u.om = t; u.on = pn; }
        return true;
    }
    __device__ __forceinline__ void a_ready(const Unit&) const {}
    __device__ __forceinline__ void done(const Unit&) const {}
};

struct EpiStore {
    static constexpr bool PERM = true, AFTER_DRAIN = false, ALIGN = true;
    bf16_t* O; int ldc; size_t ks_stride;
    __device__ __forceinline__ void operator()(const f32x4 (&acc)[2][2][4][2], const Unit& u, int wr, int wc, int fr, int fq) const {
        const int row0 = u.om * BM + wr * 64 + fr, col0 = u.on * BM + wc * 32 + 8 * fq;
        bf16_t* Ok = O + (size_t)u.ks * ks_stride;
#pragma unroll
        for (int ai = 0; ai < 2; ++ai)
#pragma unroll
            for (int m = 0; m < 4; ++m) { bf16_t* rowp = Ok + (size_t)(row0 + ai * HALF + m * 16) * ldc + col0;
#pragma unroll
                for (int bj = 0; bj < 2; ++bj) { const f32x4 v0 = acc[ai][bj][m][0], v1 = acc[ai][bj][m][1];
                    u32x4 w; w.x = cvt_pk_bf16(v0[0], v0[1]); w.y = cvt_pk_bf16(v0[2], v0[3]); w.z = cvt_pk_bf16(v1[0], v1[1]); w.w = cvt_pk_bf16(v1[2], v1[3]);
                    *(u32x4*)(rowp + bj * HALF) = w; } }
    }
};
template <int HD> struct EpiQKV {
    static constexpr bool PERM = true, AFTER_DRAIN = false, ALIGN = true;
    bf16_t* O; int ldc; const float* qg; const float* kg; float qscale; const float* cs; const float* sn; int nq_cols, nqk_cols; PG8_LAS float* xch;
    __device__ __forceinline__ void operator()(const f32x4 (&acc)[2][2][4][2], const Unit& u, int wr, int wc, int fr, int fq) const {
        const int colt = u.on * BM; const bool nrm0 = colt < nqk_cols, nrm1 = colt + HALF < nqk_cols;
        const int b9 = u.om / 9, t9 = u.om - b9 * 9; const bool lat = t9 != 0;
        int p0 = (HD == 128) ? (16 * wc + 4 * fq) : (16 * (wc & 1) + 4 * fq);
        asm volatile("" : "+v"(p0));
        const bool rowf = (HD == 128) ? (wc < 2) : ((wc & 1) == 0);
        f32x4 tc[4], ts[4];
        f32x4 G1, G2; float SC = 1.0f;
        if (nrm0) {
            { const bool isq = colt < nq_cols; const float* g = isq ? qg : kg; SC = isq ? qscale : 1.0f;
                G1 = *(const f32x4*)(g + p0); G2 = *(const f32x4*)(g + p0 + HD / 2); }
#pragma unroll
            for (int ai = 0; ai < 2; ++ai) { float s[4][2];
#pragma unroll
                for (int m = 0; m < 4; ++m)
#pragma unroll
                    for (int bj = 0; bj < 2; ++bj) { const f32x4 a = acc[ai][bj][m][0], b = acc[ai][bj][m][1];
                        s[m][bj] = (a[0] * a[0] + a[1] * a[1]) + (a[2] * a[2] + a[3] * a[3]) + (b[0] * b[0] + b[1] * b[1]) + (b[2] * b[2] + b[3] * b[3]); }
#pragma unroll
                for (int m = 0; m < 4; ++m)
#pragma unroll
                    for (int bj = 0; bj < 2; ++bj) s[m][bj] += __shfl_xor(s[m][bj], 16);
#pragma unroll
                for (int m = 0; m < 4; ++m)
#pragma unroll
                    for (int bj = 0; bj < 2; ++bj) s[m][bj] += __shfl_xor(s[m][bj], 32);
                if (fq == 0) {
#pragma unroll
                    for (int m = 0; m < 4; ++m)
#pragma unroll
                        for (int bj = 0; bj < 2; ++bj) xch[((ai * 2 + bj) * 128 + wr * 64 + m * 16 + fr) * 4 + wc] = s[m][bj];
                } }
            if (lat) {
#pragma unroll
                for (int e = 0; e < 4; ++e) { const int tp = (t9 - 1) * 256 + (rowf ? (e & 1) * HALF + wr * 64 : e * 16 + fr);
                    const size_t to = (size_t)tp * (HD / 2) + p0; tc[e] = *(const f32x4*)(cs + to); ts[e] = *(const f32x4*)(sn + to); }
            }
            asm volatile("s_waitcnt lgkmcnt(0)" ::: "memory"); __builtin_amdgcn_s_barrier(); asm volatile("" ::: "memory");
        }
        const int row0 = u.om * BM + wr * 64 + fr, col0 = colt + wc * 32 + 8 * fq;
        float rsv[2][2][4];
        if (nrm0) {
#pragma unroll
            for (int bj = 0; bj < 2; ++bj)
#pragma unroll
                for (int ai = 0; ai < 2; ++ai)
#pragma unroll
                    for (int m = 0; m < 4; ++m) { const f32x4 pp = *(const PG8_LAS f32x4*)(xch + ((ai * 2 + bj) * 128 + wr * 64 + m * 16 + fr) * 4);
                        const float ss = (HD == 128) ? ((pp[0] + pp[1]) + (pp[2] + pp[3])) : ((wc < 2) ? (pp[0] + pp[1]) : (pp[2] + pp[3]));
                        rsv[bj][ai][m] = __builtin_amdgcn_rsqf(ss * (1.0f / HD) + 1e-6f) * SC; }
        }
#pragma unroll
        for (int bj = 0; bj < 2; ++bj) {
            const bool nrm = bj == 0 ? nrm0 : nrm1;
            if (nrm && rowf) {
#pragma unroll
                for (int ai = 0; ai < 2; ++ai)
#pragma unroll
                    for (int m = 0; m < 4; ++m) { bf16_t* rowp = O + (size_t)(row0 + ai * HALF + m * 16) * ldc + col0 + bj * HALF;
                        const f32x4 v0 = acc[ai][bj][m][0], v1 = acc[ai][bj][m][1];
                        const float rs = rsv[bj][ai][m];
                        const f32x4 g1 = G1 * rs, g2 = G2 * rs;
                        float x1[4] = {v0[0] * g1[0], v0[2] * g1[1], v1[0] * g1[2], v1[2] * g1[3]};
                        float x2[4] = {v0[1] * g2[0], v0[3] * g2[1], v1[1] * g2[2], v1[3] * g2[3]};
                        if (lat) { const f32x4 c = tc[ai], sv = ts[ai];
#pragma unroll
                            for (int i = 0; i < 4; ++i) { const float a = x1[i], b = x2[i]; x1[i] = a * c[i] - b * sv[i]; x2[i] = a * sv[i] + b * c[i]; } }
                        u32x4 w; w.x = cvt_pk_bf16(x1[0], x2[0]); w.y = cvt_pk_bf16(x1[1], x2[1]); w.z = cvt_pk_bf16(x1[2], x2[2]); w.w = cvt_pk_bf16(x1[3], x2[3]);
                        *(u32x4*)rowp = w; }
            } else if (nrm) {
#pragma unroll
                for (int ai = 0; ai < 2; ++ai)
#pragma unroll
                    for (int m = 0; m < 4; ++m) { bf16_t* rowp = O + (size_t)(row0 + ai * HALF + m * 16) * ldc + col0 + bj * HALF;
                        const f32x4 v0 = acc[ai][bj][m][0], v1 = acc[ai][bj][m][1];
                        const float rs = rsv[bj][ai][m];
                        const f32x4 g1 = G1 * rs, g2 = G2 * rs;
                        float x1[4] = {v0[0] * g1[0], v0[2] * g1[1], v1[0] * g1[2], v1[2] * g1[3]};
                        float x2[4] = {v0[1] * g2[0], v0[3] * g2[1], v1[1] * g2[2], v1[3] * g2[3]};
                        if (lat) { const f32x4 c = tc[m], sv = ts[m];
#pragma unroll
                            for (int i = 0; i < 4; ++i) { const float a = x1[i], b = x2[i]; x1[i] = a * c[i] - b * sv[i]; x2[i] = a * sv[i] + b * c[i]; } }
                        u32x4 w; w.x = cvt_pk_bf16(x1[0], x2[0]); w.y = cvt_pk_bf16(x1[1], x2[1]); w.z = cvt_pk_bf16(x1[2], x2[2]); w.w = cvt_pk_bf16(x1[3], x2[3]);
                        *(u32x4*)rowp = w; }
            } else {
#pragma unroll
                for (int ai = 0; ai < 2; ++ai)
#pragma unroll
                    for (int m = 0; m < 4; ++m) { bf16_t* rowp = O + (size_t)(row0 + ai * HALF + m * 16) * ldc + col0 + bj * HALF;
                        const f32x4 v0 = acc[ai][bj][m][0], v1 = acc[ai][bj][m][1];
                        u32x4 w; w.x = cvt_pk_bf16(v0[0], v0[1]); w.y = cvt_pk_bf16(v0[2], v0[3]); w.z = cvt_pk_bf16(v1[0], v1[1]); w.w = cvt_pk_bf16(v1[2], v1[3]);
                        *(u32x4*)rowp = w; }
            }
        }
    }
};
constexpr float SW_G = 1.4426950408889634f, SW_U = 8.0f / 1.4426950408889634f;
__device__ __forceinline__ float swiglu8(float gp, float up) { return fminf(fmaxf(gp * up * __builtin_amdgcn_rcpf(1.0f + __builtin_amdgcn_exp2f(-gp)), -448.f), 448.f); }
__device__ __forceinline__ float silu_mul(float g, float u) { return g * u * __builtin_amdgcn_rcpf(1.0f + __builtin_amdgcn_exp2f(-1.4426950408889634f * g)); }
struct EpiSlab {
    static constexpr bool PERM = false, AFTER_DRAIN = false, ALIGN = true;
    float* slab;
    __device__ __forceinline__ void operator()(const f32x4 (&acc)[2][2][4][2], const Unit& u, int wr, int wc, int fr, int fq) const {
        float* base = slab + (size_t)(u.ks * 128 + u.ov) * 65536 + (size_t)(wr * 64 + fr) * 256 + wc * 32 + 4 * fq;
#pragma unroll
        for (int ai = 0; ai < 2; ++ai)
#pragma unroll
            for (int m = 0; m < 4; ++m)
#pragma unroll
                for (int bj = 0; bj < 2; ++bj)
#pragma unroll
                    for (int n = 0; n < 2; ++n) *(f32x4*)(base + (size_t)(ai * HALF + m * 16) * 256 + bj * HALF + n * 16) = acc[ai][bj][m][n];
    }
};
#ifndef SWIGLU_ALIGN
#define SWIGLU_ALIGN true
#endif
struct EpiSwiGLU8 {
    static constexpr bool PERM = true, AFTER_DRAIN = false, ALIGN = true;
    unsigned char* O; int ldc;
    __device__ __forceinline__ void operator()(const f32x4 (&acc)[2][2][4][2], const Unit& u, int wr, int wc, int fr, int fq) const {
        const int row0 = u.om * BM + wr * 64 + fr, col0 = u.on * HALF + wc * 32 + 8 * fq;
#pragma unroll
        for (int ai = 0; ai < 2; ++ai)
#pragma unroll
            for (int m = 0; m < 4; ++m) { unsigned char* rowp = O + (size_t)(row0 + ai * HALF + m * 16) * ldc + col0;
                const f32x4 g0 = acc[ai][0][m][0], g1 = acc[ai][0][m][1], u0 = acc[ai][1][m][0], u1 = acc[ai][1][m][1];
                float v[8];
#pragma unroll
                for (int i = 0; i < 4; ++i) { v[i] = swiglu8(g0[i], u0[i]); v[4 + i] = swiglu8(g1[i], u1[i]); }
                u32x2 w; w.x = pk4_fp8(v[0], v[1], v[2], v[3]); w.y = pk4_fp8(v[4], v[5], v[6], v[7]);
                *(u32x2*)rowp = w; }
    }
};
#ifndef RESGATE_ALIGN
#define RESGATE_ALIGN false
#endif
struct EpiResGate {
    static constexpr bool PERM = true, AFTER_DRAIN = false, ALIGN = RESGATE_ALIGN;
    f16_t* X; const float* mod;
    __device__ __forceinline__ void operator()(const f32x4 (&acc)[2][2][4][2], const Unit& u, int wr, int wc, int fr, int fq) const {
        const int b = u.om / 9, mr = (u.om - b * 9 == 0) ? 8 : b;
        const float* gp = mod + (size_t)mr * 6144;
        const int row0 = u.om * BM + wr * 64 + fr, col0 = u.on * BM + wc * 32 + 8 * fq;
        f32x4 gv[2][2];
#pragma unroll
        for (int bj = 0; bj < 2; ++bj)
#pragma unroll
            for (int n = 0; n < 2; ++n) gv[bj][n] = *(const f32x4*)(gp + col0 + bj * HALF + n * 4);
#pragma unroll
        for (int ai = 0; ai < 2; ++ai)
#pragma unroll
            for (int m = 0; m < 4; ++m) { f16_t* rowp = X + (size_t)(row0 + ai * HALF + m * 16) * 1024 + col0;
#pragma unroll
                for (int bj = 0; bj < 2; ++bj) { f16x8* p = (f16x8*)(rowp + bj * HALF); const f32x8 x = __builtin_convertvector(*p, f32x8);
                    const f32x4 lo = (f32x4){x[0], x[1], x[2], x[3]} + gv[bj][0] * acc[ai][bj][m][0], hi = (f32x4){x[4], x[5], x[6], x[7]} + gv[bj][1] * acc[ai][bj][m][1];
                    *p = __builtin_convertvector((f32x8){lo[0], lo[1], lo[2], lo[3], hi[0], hi[1], hi[2], hi[3]}, f16x8); }
                if (m & 1) asm volatile("" ::: "memory"); }
    }
};

template <class Epi, class Sched, bool ALIGN_EPI = false, bool SP2 = false, bool F8 = false>
__device__ __forceinline__ void gemm_phase(PG8_LAS unsigned char* lds, const Gemm g, const Sched& S, const Epi& E) {
    const int tid = opaque_tid(), wid = __builtin_amdgcn_readfirstlane(tid >> 6), lane = tid & 63, wr = wid >> 2, wc = wid & 3, fr = lane & 15, fq = lane >> 4;
    const int RS = F8 ? g.K : 2 * g.K, nt = F8 ? g.KL / 128 : g.KL / BK;
    unsigned voffA[2], voffB[2];
#pragma unroll
    for (int i = 0; i < 2; ++i) { int R, C; stage_rc(tid * 16 + i * 8192, R, C); const int Rb = Epi::PERM ? ((R & ~31) + perm32(R & 31)) : R;
        voffA[i] = (unsigned)(R * RS + C * 2); voffB[i] = (unsigned)(Rb * RS + C * 2); }
    const size_t kstep = (size_t)(BK * 2);
    const size_t hstep = (size_t)HALF * RS;
    const size_t tstep = 2 * hstep;
    const unsigned ldsw = (unsigned)wid * 1024u;
    const int aoff = lds_byte(wr * 64 + fr, fq * 8), boff = lds_byte(wc * 32 + fr, fq * 8);
#define PG8_SA(b, h) (((b) * 2 + (h)) * HTB)
#define PG8_SB(b, h) ((4 + (b) * 2 + (h)) * HTB)
#define PG8_STAGE(bufoff, gbase, voff) do { _Pragma("unroll") for (int _i = 0; _i < 2; ++_i) \
        __builtin_amdgcn_global_load_lds((const unsigned*)((const char*)(gbase) + (voff)[_i]), (PG8_LAS unsigned*)(lds + (bufoff) + ldsw + _i * 8192), 16, 0, 0); } while (0)
#define PG8_LDA(dst, b, h) do { if constexpr (F8) { _Pragma("unroll") for (int m = 0; m < 4; ++m) dst##8[m] = cat8(*(const PG8_LAS bf16x8*)(lds + PG8_SA(b, h) + aoff + m * 2048), *(const PG8_LAS bf16x8*)(lds + PG8_SA(b, h) + aoff + m * 2048 + 1024)); } \
    else { _Pragma("unroll") for (int m = 0; m < 4; ++m) _Pragma("unroll") for (int k = 0; k < 2; ++k) dst[m][k] = *(const PG8_LAS bf16x8*)(lds + PG8_SA(b, h) + aoff + m * 2048 + k * 1024); } } while (0)
#define PG8_LDB(dst, b, h) do { if constexpr (F8) { _Pragma("unroll") for (int n = 0; n < 2; ++n) dst##8[n] = cat8(*(const PG8_LAS bf16x8*)(lds + PG8_SB(b, h) + boff + n * 2048), *(const PG8_LAS bf16x8*)(lds + PG8_SB(b, h) + boff + n * 2048 + 1024)); } \
    else { _Pragma("unroll") for (int n = 0; n < 2; ++n) _Pragma("unroll") for (int k = 0; k < 2; ++k) dst[n][k] = *(const PG8_LAS bf16x8*)(lds + PG8_SB(b, h) + boff + n * 2048 + k * 1024); } } while (0)
#define PG8_MMA(ai, bj, At, Bt, FST) do { __builtin_amdgcn_s_setprio(1); if constexpr (F8) { if (FST) { _Pragma("unroll") for (int m = 0; m < 4; ++m) _Pragma("unroll") for (int n = 0; n < 2; ++n) \
        asm volatile("v_mfma_scale_f32_16x16x128_f8f6f4 %0, %1, %2, 0, %3, %4 op_sel_hi:[0,0,0]" : "=&v"(acc[ai][bj][m][n]) : "v"(Bt##8[n]), "v"(At##8[m]), "v"(f8sw), "v"(f8sa)); } else { \
        _Pragma("unroll") for (int m = 0; m < 4; ++m) _Pragma("unroll") for (int n = 0; n < 2; ++n) \
        asm volatile("v_mfma_scale_f32_16x16x128_f8f6f4 %0, %1, %2, %0, %3, %4 op_sel_hi:[0,0,0]" : "+v"(acc[ai][bj][m][n]) : "v"(Bt##8[n]), "v"(At##8[m]), "v"(f8sw), "v"(f8sa)); } } else { \
        if (FST) { _Pragma("unroll") for (int m = 0; m < 4; ++m) _Pragma("unroll") for (int n = 0; n < 2; ++n) { \
            acc[ai][bj][m][n] = g.emu ? __builtin_amdgcn_mfma_f32_16x16x32_bf16(emu8v(Bt[n][0]), emu8v(At[m][0]), (f32x4){0.f, 0.f, 0.f, 0.f}, 0, 0, 0) : __builtin_amdgcn_mfma_f32_16x16x32_bf16(Bt[n][0], At[m][0], (f32x4){0.f, 0.f, 0.f, 0.f}, 0, 0, 0); \
            acc[ai][bj][m][n] = g.emu ? __builtin_amdgcn_mfma_f32_16x16x32_bf16(emu8v(Bt[n][1]), emu8v(At[m][1]), acc[ai][bj][m][n], 0, 0, 0) : __builtin_amdgcn_mfma_f32_16x16x32_bf16(Bt[n][1], At[m][1], acc[ai][bj][m][n], 0, 0, 0); } } else \
        _Pragma("unroll") for (int m = 0; m < 4; ++m) _Pragma("unroll") for (int n = 0; n < 2; ++n) _Pragma("unroll") for (int k = 0; k < 2; ++k) \
        acc[ai][bj][m][n] = g.emu ? __builtin_amdgcn_mfma_f32_16x16x32_bf16(emu8v(Bt[n][k]), emu8v(At[m][k]), acc[ai][bj][m][n], 0, 0, 0) : __builtin_amdgcn_mfma_f32_16x16x32_bf16(Bt[n][k], At[m][k], acc[ai][bj][m][n], 0, 0, 0); } __builtin_amdgcn_s_setprio(0); } while (0)
#define PG8_WAIT_V(n) asm volatile("s_waitcnt vmcnt(" #n ")" ::: "memory")
#define PG8_WAIT_L(n) asm volatile("s_waitcnt lgkmcnt(" #n ")" ::: "memory")
#define PG8_BAR __builtin_amdgcn_s_barrier()
#define PG8_SCHED __builtin_amdgcn_sched_barrier(0)
    Unit cur, nxt; int ui = 0;
    if (!S.next(0, cur)) return;
    f32x4 acc[2][2][4][2];
#pragma unroll
    for (int a = 0; a < 2; ++a)
#pragma unroll
        for (int b = 0; b < 2; ++b)
#pragma unroll
            for (int m = 0; m < 4; ++m)
#pragma unroll
                for (int n = 0; n < 2; ++n) acc[a][b][m][n] = (f32x4){0.f, 0.f, 0.f, 0.f};
    const int f8sw = F8_SCL_W, f8sa = g.sa;
    bf16x8 At[4][2], B0[2][2], B1[2][2]; v8i_t At8[4], B08[2], B18[2];
    const char* cA = (const char*)g.A + (size_t)cur.pm * tstep + cur.kb; const char* cB = (const char*)g.Bt + (size_t)cur.pn * tstep + cur.kb;
    S.a_ready(cur);
    if constexpr (SP2) {
        PG8_STAGE(PG8_SB(0, 0), cB, voffB); PG8_STAGE(PG8_SB(0, 1), cB + hstep, voffB); PG8_STAGE(PG8_SA(0, 0), cA, voffA); PG8_STAGE(PG8_SA(0, 1), cA + hstep, voffA);
        if (wr == 1) PG8_BAR;
        PG8_WAIT_V(2); PG8_BAR;
        PG8_STAGE(PG8_SB(1, 0), cB + kstep, voffB); PG8_STAGE(PG8_SA(1, 0), cA + kstep, voffA); PG8_STAGE(PG8_SB(1, 1), cB + hstep + kstep, voffB);
        PG8_WAIT_V(6); PG8_BAR;
    } else {
        PG8_STAGE(PG8_SB(0, 0), cB, voffB); PG8_STAGE(PG8_SA(0, 0), cA, voffA); PG8_STAGE(PG8_SB(0, 1), cB + hstep, voffB); PG8_STAGE(PG8_SA(0, 1), cA + hstep, voffA);
        if (wr == 1) PG8_BAR;
        PG8_WAIT_V(4); PG8_BAR;
        PG8_STAGE(PG8_SB(1, 0), cB + kstep, voffB); PG8_STAGE(PG8_SA(1, 0), cA + kstep, voffA); PG8_STAGE(PG8_SB(1, 1), cB + hstep + kstep, voffB);
        PG8_WAIT_V(6); PG8_BAR;
    }
    for (;;) {
        const bool has_next = S.next(ui + 1, nxt);
        const char* nA = has_next ? (const char*)g.A + (size_t)nxt.pm * tstep + nxt.kb : cA; const char* nB = has_next ? (const char*)g.Bt + (size_t)nxt.pn * tstep + nxt.kb : cB;
        for (int t = 0; t < nt; t += 2) {
            const bool last = (t == nt - 2); const bool first_ = (t == 0);
            const char* a1 = cA + (size_t)(t + 1) * kstep;
            const char* a2 = last ? nA : cA + (size_t)(t + 2) * kstep; const char* b2 = last ? nB : cB + (size_t)(t + 2) * kstep;
            const char* a3 = a2 + kstep; const char* b3 = b2 + kstep;
            if (last && has_next) S.a_ready(nxt);
            if constexpr (SP2) {
            PG8_LDB(B0, 0, 0); PG8_LDB(B1, 0, 1); PG8_SCHED; PG8_LDA(At, 0, 0); PG8_STAGE(PG8_SA(1, 1), a1 + hstep, voffA);
            PG8_WAIT_V(8); PG8_WAIT_L(0); PG8_BAR; PG8_MMA(0, 0, At, B0, first_); PG8_MMA(0, 1, At, B1, first_); PG8_BAR; PG8_SCHED;
            PG8_LDA(At, 0, 1); PG8_STAGE(PG8_SB(0, 0), b2, voffB); PG8_STAGE(PG8_SB(0, 1), b2 + hstep, voffB); PG8_STAGE(PG8_SA(0, 0), a2, voffA);
            PG8_WAIT_V(8); PG8_WAIT_L(0); PG8_BAR; PG8_MMA(1, 0, At, B0, first_); PG8_MMA(1, 1, At, B1, first_); PG8_BAR; PG8_SCHED;
            PG8_LDB(B0, 1, 0); PG8_LDB(B1, 1, 1); PG8_SCHED; PG8_LDA(At, 1, 0); PG8_STAGE(PG8_SA(0, 1), a2 + hstep, voffA);
            PG8_WAIT_V(8); PG8_WAIT_L(0); PG8_BAR; PG8_MMA(0, 0, At, B0, false); PG8_MMA(0, 1, At, B1, false); PG8_BAR; PG8_SCHED;
            PG8_LDA(At, 1, 1); PG8_STAGE(PG8_SB(1, 0), b3, voffB); PG8_STAGE(PG8_SB(1, 1), b3 + hstep, voffB); PG8_STAGE(PG8_SA(1, 0), a3, voffA);
            PG8_WAIT_V(8); PG8_WAIT_L(0); PG8_BAR; PG8_MMA(1, 0, At, B0, false); PG8_MMA(1, 1, At, B1, false); PG8_BAR; PG8_SCHED;
            } else {
            PG8_LDB(B0, 0, 0); PG8_SCHED; PG8_LDA(At, 0, 0); PG8_STAGE(PG8_SA(1, 1), a1 + hstep, voffA);
            PG8_WAIT_L(8); PG8_BAR; PG8_WAIT_L(0); PG8_MMA(0, 0, At, B0, first_); PG8_BAR; PG8_SCHED;
            PG8_LDB(B1, 0, 1); PG8_STAGE(PG8_SB(0, 0), b2, voffB);
            PG8_BAR; PG8_WAIT_L(0); PG8_MMA(0, 1, At, B1, first_); PG8_BAR;
            PG8_LDA(At, 0, 1); PG8_STAGE(PG8_SA(0, 0), a2, voffA);
            PG8_BAR; PG8_WAIT_L(0); PG8_MMA(1, 0, At, B0, first_); PG8_BAR; PG8_SCHED;
            PG8_STAGE(PG8_SB(0, 1), b2 + hstep, voffB);
            PG8_WAIT_V(6); PG8_BAR; PG8_MMA(1, 1, At, B1, first_); PG8_BAR;
            PG8_LDB(B0, 1, 0); PG8_SCHED; PG8_LDA(At, 1, 0); PG8_STAGE(PG8_SA(0, 1), a2 + hstep, voffA);
            PG8_WAIT_L(8); PG8_BAR; PG8_WAIT_L(0); PG8_MMA(0, 0, At, B0, false); PG8_BAR; PG8_SCHED;
            PG8_LDB(B1, 1, 1); PG8_STAGE(PG8_SB(1, 0), b3, voffB);
            PG8_BAR; PG8_WAIT_L(0); PG8_MMA(0, 1, At, B1, false); PG8_BAR;
            PG8_LDA(At, 1, 1); PG8_STAGE(PG8_SA(1, 0), a3, voffA);
            PG8_BAR; PG8_WAIT_L(0); PG8_MMA(1, 0, At, B0, false); PG8_BAR; PG8_SCHED;
            PG8_STAGE(PG8_SB(1, 1), b3 + hstep, voffB);
            PG8_WAIT_V(6); PG8_BAR; PG8_MMA(1, 1, At, B1, false); PG8_BAR;
            }
        }
        if constexpr (F8) asm volatile("s_nop 15\n\ts_nop 15" ::: "memory");
        if constexpr (ALIGN_EPI) { if (wr == 0) PG8_BAR; }
#ifdef EPI_DBL
        if constexpr (F8 && ALIGN_EPI) { E(acc, cur, wr, wc, fr, fq); asm volatile("" ::: "memory");
            _Pragma("unroll") for (int a = 0; a < 2; ++a) _Pragma("unroll") for (int b = 0; b < 2; ++b) _Pragma("unroll") for (int m = 0; m < 4; ++m) _Pragma("unroll") for (int n = 0; n < 2; ++n) asm volatile("" : "+v"(acc[a][b][m][n])); }
#endif
        if constexpr (!Epi::AFTER_DRAIN) { E(acc, cur, wr, wc, fr, fq); S.done(cur); }
        if (!has_next) break;
        if constexpr (false)
#pragma unroll
        for (int a = 0; a < 2; ++a)
#pragma unroll
            for (int b = 0; b < 2; ++b)
#pragma unroll
                for (int m = 0; m < 4; ++m)
#pragma unroll
                    for (int n = 0; n < 2; ++n) acc[a][b][m][n] = (f32x4){0.f, 0.f, 0.f, 0.f};
        cur = nxt; cA = nA; cB = nB; ++ui;
        if constexpr (ALIGN_EPI) { if (wr == 1) PG8_BAR; }
    }
    PG8_WAIT_V(0);
    if constexpr (!ALIGN_EPI) { if (wr == 0) PG8_BAR; }
    PG8_BAR;
    if constexpr (Epi::AFTER_DRAIN) { E.fused(acc, cur, wr, wc, fr, fq, lds, wid, lane); S.done(cur); }
#undef PG8_SA
#undef PG8_SB
#undef PG8_STAGE
#undef PG8_LDA
#undef PG8_LDB
#undef PG8_MMA
#undef PG8_WAIT_V
#undef PG8_WAIT_L
#undef PG8_BAR
#undef PG8_SCHED
}
}

#ifndef DBG_BREAK
#define DBG_BREAK 0
#endif
namespace att {
#ifndef OSTAGE
#define OSTAGE 1
#endif
constexpr int NW = 8, QBLK = 32, KVBLK = 64;
constexpr float THR_L2 = 11.5f;
#define SBAR() __builtin_amdgcn_sched_barrier(0)
__device__ __forceinline__ int crow(int r, int hi) { return (r & 3) + 8 * (r >> 2) + 4 * hi; }
template <int DQK> __device__ __forceinline__ int ksw(int row) { return (DQK == 128) ? (row & 15) : ((row >> 1) & 7); }
template <int DQK> __device__ __forceinline__ int kswz(int row, int colB) { return row * (DQK * 2) + (colB ^ (ksw<DQK>(row) << 4)); }
template <int DQK> constexpr int NKB = (DQK == 128) ? 8 : 4;
#define KADDR(kbarr, d0) ((DQK == 128) ? (kbarr)[(d0) & (NKB<DQK> - 1)] : (kbarr)[(d0) & 3] + ((d0) >> 2) * 128)
template <int DV> __device__ __forceinline__ int v_st(int k, int c) { const int kk = (k & ~0xC) | ((k & 4) << 1) | ((k & 8) >> 1); return ((kk >> 3) * (DV / 32) + (c >> 5)) * 512 + ((kk & 7) * 32 + (c & 31)) * 2; }
__device__ __forceinline__ int v_rd_base(int lane) { return ((lane & 3) << 3) | (((lane >> 2) & 3) << 6) | (((lane >> 4) & 1) << 5) | (((lane >> 5) & 1) << 8); }
template <int DV> constexpr int v_rd_off(int d0, int ks, int half) { return d0 * 512 + ks * (2 * (DV / 32) * 512) + half * ((DV / 32) * 512); }
template <int OFF> __device__ __forceinline__ s16x4 tr_read(int vb) {
    s16x4 r; asm volatile("ds_read_b64_tr_b16 %0, %1 offset:%2" : "=&v"(r) : "v"(vb), "i"(OFF) : "memory"); return r;
}
__device__ __forceinline__ void band_mask(f32x16& p0, f32x16& p1, int d  , int hi) {
#pragma unroll
    for (int r = 0; r < 16; ++r) { const int d0 = d + crow(r, hi), d1 = d0 + 32;
        if (d0 < -128 || d0 > 128) p0[r] = -1e30f; if (d1 < -128 || d1 > 128) p1[r] = -1e30f; }
}
__device__ __forceinline__ void partialSM(f32x16& p0, f32x16& p1, float& m_reg, float& mn, float& alpha) {
    float ma = fmaxf(p0[0], p0[1]), mb = fmaxf(p0[2], p0[3]), mc = fmaxf(p1[0], p1[1]), md = fmaxf(p1[2], p1[3]);
#pragma unroll
    for (int r = 4; r < 16; r += 4) { ma = fmaxf(fmaxf(ma, p0[r]), p0[r + 1]); mb = fmaxf(fmaxf(mb, p0[r + 2]), p0[r + 3]); mc = fmaxf(fmaxf(mc, p1[r]), p1[r + 1]); md = fmaxf(fmaxf(md, p1[r + 2]), p1[r + 3]); }
    float pmax = fmaxf(fmaxf(ma, mb), fmaxf(mc, md));
    { auto rr = __builtin_amdgcn_permlane32_swap(__float_as_uint(pmax), __float_as_uint(pmax), false, false);
      pmax = fmaxf(__uint_as_float(rr[0]), __uint_as_float(rr[1])); }
    if (__builtin_expect(__all(pmax - m_reg <= THR_L2), 1)) { mn = m_reg; alpha = 1.f; }
    else { mn = fmaxf(m_reg, pmax); alpha = __builtin_amdgcn_exp2f(m_reg - mn); m_reg = mn; }
#pragma unroll
    for (int r = 0; r < 16; ++r) p0[r] = p0[r] - mn;
#pragma unroll
    for (int r = 0; r < 16; ++r) p1[r] = p1[r] - mn;
#pragma unroll
    for (int r = 0; r < 16; ++r) p0[r] = __builtin_amdgcn_exp2f(p0[r]);
}
__device__ __forceinline__ void finishSM(f32x16& p0, f32x16& p1, float alpha, float& l_reg, bf16x8& pa0, bf16x8& pa1, bf16x8& pa2, bf16x8& pa3) {
#pragma unroll
    for (int r = 0; r < 16; ++r) p1[r] = __builtin_amdgcn_exp2f(p1[r]);
    float sa = p0[0] + p0[1], sb = p0[2] + p0[3], sc = p1[0] + p1[1], sd = p1[2] + p1[3];
#pragma unroll
    for (int r = 4; r < 16; r += 4) { sa += p0[r] + p0[r + 1]; sb += p0[r + 2] + p0[r + 3]; sc += p1[r] + p1[r + 1]; sd += p1[r + 2] + p1[r + 3]; }
    float ps = (sa + sb) + (sc + sd);
    { auto rr = __builtin_amdgcn_permlane32_swap(__float_as_uint(ps), __float_as_uint(ps), false, false);
      ps = __uint_as_float(rr[0]) + __uint_as_float(rr[1]); }
    l_reg = l_reg * alpha + ps;
#define PK4(P, BASE, OUT) do { unsigned a0 = cvt_pk_bf16(P[BASE + 0], P[BASE + 1]), a1 = cvt_pk_bf16(P[BASE + 2], P[BASE + 3]);   \
    unsigned b0 = cvt_pk_bf16(P[BASE + 4], P[BASE + 5]), b1 = cvt_pk_bf16(P[BASE + 6], P[BASE + 7]);                              \
    auto r0 = __builtin_amdgcn_permlane32_swap(a0, b0, false, false); auto r1 = __builtin_amdgcn_permlane32_swap(a1, b1, false, false); \
    u32x4 w = {r0[0], r1[0], r0[1], r1[1]}; OUT = *reinterpret_cast<bf16x8*>(&w); } while (0)
    PK4(p0, 0, pa0); PK4(p0, 8, pa1); PK4(p1, 0, pa2); PK4(p1, 8, pa3);
#undef PK4
}
template <int DQK, int QSP, int BOFF> __device__ __forceinline__ void qkt(f32x16& p0, f32x16& p1, const int (&kb)[NKB<DQK>], const bf16x8 (&qr)[DQK / 16 - QSP], const LAS char* qsp) {
    p0 = f32x16{}; p1 = f32x16{};
#pragma unroll
    for (int d0 = 0; d0 < DQK / 16; ++d0) {
        const bf16x8 b0 = *reinterpret_cast<const LAS bf16x8*>((uintptr_t)(unsigned)(KADDR(kb, d0) + BOFF));
        const bf16x8 b1 = *reinterpret_cast<const LAS bf16x8*>((uintptr_t)(unsigned)(KADDR(kb, d0) + BOFF + 32 * DQK * 2));
        bf16x8 qf;
        if constexpr (QSP > 0) { if (d0 >= DQK / 16 - QSP) qf = *reinterpret_cast<const volatile LAS bf16x8*>(qsp + (d0 - (DQK / 16 - QSP)) * 1024); else qf = qr[d0 < DQK / 16 - QSP ? d0 : 0]; }
        else qf = qr[d0];
        p0 = __builtin_amdgcn_mfma_f32_32x32x16_bf16(b0, qf, p0, 0, 0, 0);
        p1 = __builtin_amdgcn_mfma_f32_32x32x16_bf16(b1, qf, p1, 0, 0, 0); }
}
#ifndef PV_BUILTIN
#define PV_BUILTIN 1
#endif
typedef short v4i16_t __attribute__((ext_vector_type(4)));
template <int OFF> __device__ __forceinline__ s16x4 tr_read_b(int vb) {
    return __builtin_bit_cast(s16x4, __builtin_amdgcn_ds_read_tr16_b64_v4i16((LAS v4i16_t*)(uintptr_t)(unsigned)(vb + OFF)));
}
template <int DV, int D0, bool BI> __device__ __forceinline__ void pv_one(f32x16& od, int vb, bf16x8 pa0, bf16x8 pa1, bf16x8 pa2, bf16x8 pa3) {
  s16x4 l0, h0, l1, h1, l2, h2, l3, h3;
  if constexpr (BI && PV_BUILTIN) {
    l0 = tr_read_b<v_rd_off<DV>(D0, 0, 0)>(vb); h0 = tr_read_b<v_rd_off<DV>(D0, 0, 1)>(vb); l1 = tr_read_b<v_rd_off<DV>(D0, 1, 0)>(vb); h1 = tr_read_b<v_rd_off<DV>(D0, 1, 1)>(vb);
    l2 = tr_read_b<v_rd_off<DV>(D0, 2, 0)>(vb); h2 = tr_read_b<v_rd_off<DV>(D0, 2, 1)>(vb); l3 = tr_read_b<v_rd_off<DV>(D0, 3, 0)>(vb); h3 = tr_read_b<v_rd_off<DV>(D0, 3, 1)>(vb);
  } else {
    l0 = tr_read<v_rd_off<DV>(D0, 0, 0)>(vb); h0 = tr_read<v_rd_off<DV>(D0, 0, 1)>(vb); l1 = tr_read<v_rd_off<DV>(D0, 1, 0)>(vb); h1 = tr_read<v_rd_off<DV>(D0, 1, 1)>(vb);
    l2 = tr_read<v_rd_off<DV>(D0, 2, 0)>(vb); h2 = tr_read<v_rd_off<DV>(D0, 2, 1)>(vb); l3 = tr_read<v_rd_off<DV>(D0, 3, 0)>(vb); h3 = tr_read<v_rd_off<DV>(D0, 3, 1)>(vb);
    asm volatile("s_waitcnt lgkmcnt(0)" ::: "memory"); SBAR();
  }
#define PKV(L, H) (bf16x8){L[0], L[1], L[2], L[3], H[0], H[1], H[2], H[3]}
    od = __builtin_amdgcn_mfma_f32_32x32x16_bf16(pa0, PKV(l0, h0), od, 0, 0, 0);
    od = __builtin_amdgcn_mfma_f32_32x32x16_bf16(pa1, PKV(l1, h1), od, 0, 0, 0);
    od = __builtin_amdgcn_mfma_f32_32x32x16_bf16(pa2, PKV(l2, h2), od, 0, 0, 0);
    od = __builtin_amdgcn_mfma_f32_32x32x16_bf16(pa3, PKV(l3, h3), od, 0, 0, 0);
#undef PKV
}
template <int DV, bool BI = true> __device__ __forceinline__ void pv_all(f32x16 (&o)[DV / 32], int vb, bf16x8 pa0, bf16x8 pa1, bf16x8 pa2, bf16x8 pa3) {
    pv_one<DV, 0, BI>(o[0], vb, pa0, pa1, pa2, pa3); pv_one<DV, 1, BI>(o[1], vb, pa0, pa1, pa2, pa3);
    if constexpr (DV == 128) { pv_one<DV, 2, BI>(o[2], vb, pa0, pa1, pa2, pa3); pv_one<DV, 3, BI>(o[3], vb, pa0, pa1, pa2, pa3); }
}

template <int DQK, int DV, bool MASK, int SDEPTH, int QSP, int ldq, int ldk, int ldv, int ldo, bool O8 = false>
__device__ __forceinline__ void attn_unit(const bf16_t* __restrict__ Qb, const bf16_t* __restrict__ Kh, const bf16_t* __restrict__ Vh,
                                          bf16_t* __restrict__ Ob, int NT, int lo, float m_init, float l_init, int qpos0, LAS char* lds) {
    constexpr int SHM_K = KVBLK * DQK * 2, SHM_V = KVBLK * DV * 2, NKP = DQK / 64, NVP = DV / 64, LPT = NKP + NVP, ND0 = DQK / 16, NDV = DV / 32;
    const int tid = opaque_tid(), wid = tid >> 6, lane = tid & 63, r32 = lane & 31, hi = lane >> 5;
    LAS char* V_lds = lds; LAS char* K_lds = lds + 2 * SHM_V;
    LAS float* ws = (LAS float*)(lds + 2 * SHM_V + 2 * SHM_K) + wid * 64; LAS float* li_l = ws; LAS float* al_l = ws + 32;
    float m_reg = m_init, l_reg = l_init; f32x16 o[NDV]; bf16x8 qr[ND0 - QSP];
    LAS char* qsp = lds + 2 * SHM_V + 2 * SHM_K + 2048 + wid * (QSP * 1024) + lane * 16;
#pragma unroll
    for (int d = 0; d < NDV; ++d) o[d] = f32x16{};
    const bf16_t* Qw = Qb + (long)(wid * QBLK + r32) * ldq + hi * 8;
#pragma unroll
    for (int d0 = 0; d0 < ND0; ++d0) { const bf16x8 qv = *reinterpret_cast<const bf16x8*>(Qw + d0 * 16); if (d0 < ND0 - QSP) qr[d0 < ND0 - QSP ? d0 : 0] = qv; else *reinterpret_cast<LAS bf16x8*>(qsp + (d0 - (ND0 - QSP)) * 1024) = qv; }
    const int srow = tid >> 3, sc0 = (tid & 7) * 8;
    const int koff0 = srow * ldk + sc0, voff0 = srow * ldv + sc0, vst0 = v_st<DV>(srow, sc0);
    int kst[NKP];
#pragma unroll
    for (int q = 0; q < NKP; ++q) kst[q] = kswz<DQK>(srow, sc0 * 2 + 128 * q);
    const int vb0 = (int)(uintptr_t)V_lds + v_rd_base(lane);
    int kb[NKB<DQK>];
#pragma unroll
    for (int x = 0; x < NKB<DQK>; ++x) kb[x] = (int)(uintptr_t)K_lds + r32 * (DQK * 2) + ((x * 32 + hi * 16) ^ (ksw<DQK>(r32) << 4));
    struct { bf16x8 k[NKP], v[NVP]; } sr_[SDEPTH];
#define KT(j) ((j) < 4 ? (j) : (j) + lo)
#define SLOAD(i, j) do { const int kt_ = __builtin_amdgcn_readfirstlane(KT(j)); const bf16_t* Vt_ = Vh + (long)kt_ * (KVBLK * (long)ldv); const bf16_t* Kt_ = Kh + (long)kt_ * (KVBLK * (long)ldk); \
    _Pragma("unroll") for (int q_ = 0; q_ < NVP; ++q_) sr_[i].v[q_] = *reinterpret_cast<const bf16x8*>(Vt_ + voff0 + 64 * q_); \
    _Pragma("unroll") for (int q_ = 0; q_ < NKP; ++q_) sr_[i].k[q_] = *reinterpret_cast<const bf16x8*>(Kt_ + koff0 + 64 * q_); } while (0)
#define SWRITE(b, i) do { \
    _Pragma("unroll") for (int q_ = 0; q_ < NVP; ++q_) *(LAS bf16x8*)(V_lds + (b) * SHM_V + vst0 + 1024 * q_) = sr_[i].v[q_]; \
    _Pragma("unroll") for (int q_ = 0; q_ < NKP; ++q_) *(LAS bf16x8*)(K_lds + (b) * SHM_K + kst[q_]) = sr_[i].k[q_]; } while (0)
#define SWAIT() asm volatile("s_waitcnt vmcnt(%0)" :: "n"(SDEPTH == 2 ? LPT : 0) : "memory")
#define RESC(a) do { if (__any((a) < 1.f)) { if (hi == 0) al_l[r32] = (a); asm volatile("s_waitcnt lgkmcnt(0)" ::: "memory"); \
    _Pragma("unroll") for (int d = 0; d < NDV; ++d) _Pragma("unroll") for (int r = 0; r < 16; ++r) o[d][r] *= al_l[crow(r, hi)]; } } while (0)
#define MASKT(P0, P1, j) do { if constexpr (MASK && DBG_BREAK != 4) { if ((j) >= 4) band_mask(P0, P1, (KT(j) - 4) * KVBLK - (qpos0 + wid * QBLK + r32), hi); } } while (0)
    f32x16 pA0, pA1, pB0, pB1; float mnA, mnB, alA, alB; bf16x8 pa0, pa1, pa2, pa3;
    constexpr int SE = 0, SO = SDEPTH - 1;
    SLOAD(SE, 0); asm volatile("s_waitcnt vmcnt(0)" ::: "memory"); SWRITE(0, SE); __syncthreads();
    qkt<DQK, QSP, 0>(pA0, pA1, kb, qr, qsp); MASKT(pA0, pA1, 0); partialSM(pA0, pA1, m_reg, mnA, alA);
    SLOAD(SO, 1); if (SDEPTH == 2 && 2 < NT) SLOAD(SE, 2);
    SWAIT(); SWRITE(1, SO); __syncthreads();
    for (int j = 1; j + 1 < NT; j += 2) {
        SBAR(); qkt<DQK, QSP, SHM_K>(pB0, pB1, kb, qr, qsp); MASKT(pB0, pB1, j);
        finishSM(pA0, pA1, alA, l_reg, pa0, pa1, pa2, pa3); SBAR();
        SLOAD(SO, j + SDEPTH); SBAR();
        pv_all<DV, (DQK != 192)>(o, vb0, pa0, pa1, pa2, pa3); partialSM(pB0, pB1, m_reg, mnB, alB);
        __syncthreads(); SWAIT(); SWRITE(0, SE);
        RESC(alB); __syncthreads();
        SBAR(); qkt<DQK, QSP, 0>(pA0, pA1, kb, qr, qsp); MASKT(pA0, pA1, j + 1);
        finishSM(pB0, pB1, alB, l_reg, pa0, pa1, pa2, pa3); SBAR();
        if (SDEPTH == 1 || j + 3 < NT) SLOAD(SE, j + 1 + SDEPTH); SBAR();
        pv_all<DV, (DQK != 192)>(o, vb0 + SHM_V, pa0, pa1, pa2, pa3); partialSM(pA0, pA1, m_reg, mnA, alA);
        __syncthreads(); SWAIT(); SWRITE(1, SO);
        RESC(alA); __syncthreads();
    }
    SBAR(); qkt<DQK, QSP, SHM_K>(pB0, pB1, kb, qr, qsp); MASKT(pB0, pB1, NT - 1);
    finishSM(pA0, pA1, alA, l_reg, pa0, pa1, pa2, pa3); SBAR();
    pv_all<DV, (DQK != 192)>(o, vb0, pa0, pa1, pa2, pa3); partialSM(pB0, pB1, m_reg, mnB, alB);
    __syncthreads(); RESC(alB);
    finishSM(pB0, pB1, alB, l_reg, pa0, pa1, pa2, pa3); SBAR();
    pv_all<DV, (DQK != 192)>(o, vb0 + SHM_V, pa0, pa1, pa2, pa3);
    if (hi == 0) li_l[r32] = l_reg; asm volatile("s_waitcnt lgkmcnt(0)" ::: "memory");
    float rli[16];
#pragma unroll
    for (int r = 0; r < 16; ++r) rli[r] = __builtin_amdgcn_rcpf(li_l[crow(r, hi)]);
    if constexpr (O8) {
        unsigned char* Ow8 = (unsigned char*)Ob + (long)(wid * QBLK) * ldo;
        if constexpr (OSTAGE && DQK != 192) {
            LAS unsigned char* stg8 = (LAS unsigned char*)(lds + 2 * SHM_V + 2 * SHM_K + 2048) + wid * (QBLK * DV);
#pragma unroll
            for (int r = 0; r < 16; ++r) { const int orow = crow(r, hi);
#pragma unroll
                for (int d0 = 0; d0 < NDV; ++d0) { const float x = fminf(fmaxf(o[d0][r] * rli[r] * 64.0f, -448.f), 448.f); stg8[orow * DV + d0 * 32 + r32] = (unsigned char)(__builtin_amdgcn_cvt_pk_fp8_f32(x, x, 0, false) & 0xffu); } }
            asm volatile("s_waitcnt lgkmcnt(0)" ::: "memory");
#pragma unroll
            for (int i = 0; i < QBLK * DV / 16 / 64; ++i) { const int c = i * 64 + lane, row = c / (DV / 16), ch = c % (DV / 16);
                const u32x4 v = *(const LAS u32x4*)(stg8 + row * DV + ch * 16); *(u32x4*)(Ow8 + (long)row * ldo + ch * 16) = v; }
        } else {
#pragma unroll
            for (int r = 0; r < 16; ++r) { const int orow = crow(r, hi);
#pragma unroll
                for (int d0 = 0; d0 < NDV; ++d0) { const float x = fminf(fmaxf(o[d0][r] * rli[r] * 64.0f, -448.f), 448.f); Ow8[(long)orow * ldo + d0 * 32 + r32] = (unsigned char)(__builtin_amdgcn_cvt_pk_fp8_f32(x, x, 0, false) & 0xffu); } }
        }
    } else {
    bf16_t* Ow = Ob + (long)(wid * QBLK) * ldo;
    if constexpr (OSTAGE && DQK != 192) {
        LAS bf16_t* stg = (LAS bf16_t*)(lds + 2 * SHM_V + 2 * SHM_K + 2048) + wid * (QBLK * DV);
#pragma unroll
        for (int r = 0; r < 16; ++r) { const int orow = crow(r, hi);
#pragma unroll
            for (int d0 = 0; d0 < NDV; ++d0) stg[orow * DV + d0 * 32 + r32] = (bf16_t)(cvt_pk_bf16(o[d0][r] * rli[r], 0.f) & 0xffffu); }
        asm volatile("s_waitcnt lgkmcnt(0)" ::: "memory");
#pragma unroll
        for (int i = 0; i < QBLK * DV / 8 / 64; ++i) { const int c = i * 64 + lane, row = c / (DV / 8), ch = c % (DV / 8);
            const u32x4 v = *(const LAS u32x4*)(stg + row * DV + ch * 8); *(u32x4*)(Ow + (long)row * ldo + ch * 8) = v; }
    } else {
#pragma unroll
    for (int r = 0; r < 16; ++r) { const int orow = crow(r, hi);
#pragma unroll
        for (int d0 = 0; d0 < NDV; ++d0) Ow[(long)orow * ldo + d0 * 32 + r32] = (bf16_t)(cvt_pk_bf16(o[d0][r] * rli[r], 0.f) & 0xffffu); }
    }
    }
    __syncthreads();
#undef KT
#undef SLOAD
#undef SWRITE
#undef SWAIT
#undef RESC
#undef MASKT
}

template <int DQK, int QSP> __device__ __forceinline__ void qkt_rt(f32x16& p0, f32x16& p1, const int (&kb)[NKB<DQK>], int boff, const bf16x8 (&qr)[DQK / 16 - QSP], const LAS char* qsp) {
    p0 = f32x16{}; p1 = f32x16{};
    int kbb[NKB<DQK>];
#pragma unroll
    for (int x = 0; x < NKB<DQK>; ++x) kbb[x] = kb[x] + boff;
#pragma unroll
    for (int d0 = 0; d0 < DQK / 16; ++d0) {
        const bf16x8 b0 = *reinterpret_cast<const LAS bf16x8*>((uintptr_t)(unsigned)(KADDR(kbb, d0)));
        const bf16x8 b1 = *reinterpret_cast<const LAS bf16x8*>((uintptr_t)(unsigned)(KADDR(kbb, d0) + 32 * DQK * 2));
        bf16x8 qf;
        if constexpr (QSP > 0) { if (d0 >= DQK / 16 - QSP) qf = *reinterpret_cast<const volatile LAS bf16x8*>(qsp + (d0 - (DQK / 16 - QSP)) * 1024); else qf = qr[d0 < DQK / 16 - QSP ? d0 : 0]; }
        else qf = qr[d0];
        p0 = __builtin_amdgcn_mfma_f32_32x32x16_bf16(b0, qf, p0, 0, 0, 0);
        p1 = __builtin_amdgcn_mfma_f32_32x32x16_bf16(b1, qf, p1, 0, 0, 0); }
}
template <int DQK, int DV, bool MASK, int QSP, int ldq, int ldk, int ldv, int ldo>
__device__ __forceinline__ void attn_unit3(const bf16_t* __restrict__ Qb, const bf16_t* __restrict__ Kh, const bf16_t* __restrict__ Vh,
                                           bf16_t* __restrict__ Ob, int NT, int lo, float m_init, float l_init, int qpos0, LAS char* lds) {
    constexpr int SHM_K = KVBLK * DQK * 2, SHM_V = KVBLK * DV * 2, NKP = DQK / 64, NVP = DV / 64, ND0 = DQK / 16, NDV = DV / 32;
    const int tid = opaque_tid(), wid = tid >> 6, lane = tid & 63, r32 = lane & 31, hi = lane >> 5;
    LAS char* V_lds = lds; LAS char* K_lds = lds + 3 * SHM_V;
    LAS float* ws = (LAS float*)(lds + 3 * SHM_V + 3 * SHM_K) + wid * 64; LAS float* li_l = ws; LAS float* al_l = ws + 32;
    float m_reg = m_init, l_reg = l_init; f32x16 o[NDV]; bf16x8 qr[ND0 - QSP];
    LAS char* qsp = lds + 3 * SHM_V + 3 * SHM_K + 2048 + wid * (QSP * 1024) + lane * 16;
#pragma unroll
    for (int d = 0; d < NDV; ++d) o[d] = f32x16{};
    const bf16_t* Qw = Qb + (long)(wid * QBLK + r32) * ldq + hi * 8;
#pragma unroll
    for (int d0 = 0; d0 < ND0; ++d0) { const bf16x8 qv = *reinterpret_cast<const bf16x8*>(Qw + d0 * 16); if (d0 < ND0 - QSP) qr[d0 < ND0 - QSP ? d0 : 0] = qv; else *reinterpret_cast<LAS bf16x8*>(qsp + (d0 - (ND0 - QSP)) * 1024) = qv; }
    const int srow = tid >> 3, sc0 = (tid & 7) * 8;
    const int koff0 = srow * ldk + sc0, voff0 = srow * ldv + sc0, vst0 = (int)(uintptr_t)V_lds + v_st<DV>(srow, sc0);
    int kst[NKP];
#pragma unroll
    for (int q = 0; q < NKP; ++q) kst[q] = (int)(uintptr_t)K_lds + kswz<DQK>(srow, sc0 * 2 + 128 * q);
    const int vb0 = (int)(uintptr_t)V_lds + v_rd_base(lane);
    int kb[NKB<DQK>];
#pragma unroll
    for (int x = 0; x < NKB<DQK>; ++x) kb[x] = (int)(uintptr_t)K_lds + r32 * (DQK * 2) + ((x * 32 + hi * 16) ^ (ksw<DQK>(r32) << 4));
    bf16x8 sk[NKP], sv[NVP];
#define KT(j) ((j) < 4 ? (j) : (j) + lo)
#define SLOAD3(j) do { const int kt_ = __builtin_amdgcn_readfirstlane(KT(j)); const bf16_t* Vt_ = Vh + (long)kt_ * (KVBLK * (long)ldv); const bf16_t* Kt_ = Kh + (long)kt_ * (KVBLK * (long)ldk); \
    _Pragma("unroll") for (int q_ = 0; q_ < NVP; ++q_) sv[q_] = *reinterpret_cast<const bf16x8*>(Vt_ + voff0 + 64 * q_); \
    _Pragma("unroll") for (int q_ = 0; q_ < NKP; ++q_) sk[q_] = *reinterpret_cast<const bf16x8*>(Kt_ + koff0 + 64 * q_); } while (0)
#define SWRITE3(bi) do { \
    _Pragma("unroll") for (int q_ = 0; q_ < NVP; ++q_) *reinterpret_cast<LAS bf16x8*>((uintptr_t)(unsigned)(vst0 + (bi) * SHM_V + 1024 * q_)) = sv[q_]; \
    _Pragma("unroll") for (int q_ = 0; q_ < NKP; ++q_) *reinterpret_cast<LAS bf16x8*>((uintptr_t)(unsigned)(kst[q_] + (bi) * SHM_K)) = sk[q_]; } while (0)
#define RESC(a) do { if (__any((a) < 1.f)) { if (hi == 0) al_l[r32] = (a); asm volatile("s_waitcnt lgkmcnt(0)" ::: "memory"); \
    _Pragma("unroll") for (int d = 0; d < NDV; ++d) _Pragma("unroll") for (int r = 0; r < 16; ++r) o[d][r] *= al_l[crow(r, hi)]; } } while (0)
#define MASKT(P0, P1, j) do { if constexpr (MASK && DBG_BREAK != 4) { if ((j) >= 4) band_mask(P0, P1, (KT(j) - 4) * KVBLK - (qpos0 + wid * QBLK + r32), hi); } } while (0)
    f32x16 pA0, pA1, pB0, pB1; float mnA, mnB, alA, alB; bf16x8 pa0, pa1, pa2, pa3;
    int bp = 2, bc = 0, bn = 1;
#define ROT3() do { const int t_ = bp; bp = bc; bc = bn; bn = t_; } while (0)
#ifndef SGB
#define SGB 0
#endif
#define SGB_QK() do { if (SGB) { __builtin_amdgcn_sched_group_barrier(0x100, 2 * ND0, 0); _Pragma("unroll") for (int g_ = 0; g_ < 2 * ND0; ++g_) { __builtin_amdgcn_sched_group_barrier(0x008, 1, 0); __builtin_amdgcn_sched_group_barrier(0x002, 8, 0); } } } while (0)
#define SGB_PV() do { if (SGB) { __builtin_amdgcn_sched_group_barrier(0x100, 8, 0); \
        _Pragma("unroll") for (int g_ = 0; g_ < 4 * NDV - 4; ++g_) { __builtin_amdgcn_sched_group_barrier(0x008, 1, 0); __builtin_amdgcn_sched_group_barrier(0x100, 2, 0); __builtin_amdgcn_sched_group_barrier(0x002, 6, 0); } \
        _Pragma("unroll") for (int g_ = 0; g_ < 4; ++g_) { __builtin_amdgcn_sched_group_barrier(0x008, 1, 0); __builtin_amdgcn_sched_group_barrier(0x002, 6, 0); } } } while (0)
#define ITER(X0, X1, MNX, ALX, Y0, Y1, ALY, j) do { SBAR(); qkt_rt<DQK, QSP>(X0, X1, kb, bc * SHM_K, qr, qsp); MASKT(X0, X1, j); \
        finishSM(Y0, Y1, ALY, l_reg, pa0, pa1, pa2, pa3); SGB_QK(); SBAR(); \
        if ((j) + 1 < NT) { SWRITE3(bn); } if ((j) + 2 < NT) { SLOAD3((j) + 2); } SBAR(); \
        pv_all<DV>(o, vb0 + bp * SHM_V, pa0, pa1, pa2, pa3); partialSM(X0, X1, m_reg, MNX, ALX); SGB_PV(); SBAR(); \
        RESC(ALX); __syncthreads(); ROT3(); } while (0)
    SLOAD3(0); asm volatile("s_waitcnt vmcnt(0)" ::: "memory"); SWRITE3(0); SLOAD3(1); __syncthreads();
    qkt_rt<DQK, QSP>(pA0, pA1, kb, 0, qr, qsp); MASKT(pA0, pA1, 0); partialSM(pA0, pA1, m_reg, mnA, alA);
    SWRITE3(1); if (2 < NT) { SLOAD3(2); } __syncthreads();
    bp = 0; bc = 1; bn = 2;
    for (int j = 1; j + 1 < NT; j += 2) {
        ITER(pB0, pB1, mnB, alB, pA0, pA1, alA, j);
        ITER(pA0, pA1, mnA, alA, pB0, pB1, alB, j + 1);
    }
    ITER(pB0, pB1, mnB, alB, pA0, pA1, alA, NT - 1);
    finishSM(pB0, pB1, alB, l_reg, pa0, pa1, pa2, pa3); SBAR();
    pv_all<DV>(o, vb0 + bp * SHM_V, pa0, pa1, pa2, pa3);
    if (hi == 0) li_l[r32] = l_reg; asm volatile("s_waitcnt lgkmcnt(0)" ::: "memory");
    float rli[16];
#pragma unroll
    for (int r = 0; r < 16; ++r) rli[r] = __builtin_amdgcn_rcpf(li_l[crow(r, hi)]);
    bf16_t* Ow = Ob + (long)(wid * QBLK) * ldo;
    if constexpr (OSTAGE && DQK != 192) {
        LAS bf16_t* stg = (LAS bf16_t*)(lds + 3 * SHM_V + 3 * SHM_K + 2048) + wid * (QBLK * DV);
#pragma unroll
        for (int r = 0; r < 16; ++r) { const int orow = crow(r, hi);
#pragma unroll
            for (int d0 = 0; d0 < NDV; ++d0) stg[orow * DV + d0 * 32 + r32] = (bf16_t)(cvt_pk_bf16(o[d0][r] * rli[r], 0.f) & 0xffffu); }
        asm volatile("s_waitcnt lgkmcnt(0)" ::: "memory");
#pragma unroll
        for (int i = 0; i < QBLK * DV / 8 / 64; ++i) { const int c = i * 64 + lane, row = c / (DV / 8), ch = c % (DV / 8);
            const u32x4 v = *(const LAS u32x4*)(stg + row * DV + ch * 8); *(u32x4*)(Ow + (long)row * ldo + ch * 8) = v; }
    } else {
#pragma unroll
    for (int r = 0; r < 16; ++r) { const int orow = crow(r, hi);
#pragma unroll
        for (int d0 = 0; d0 < NDV; ++d0) Ow[(long)orow * ldo + d0 * 32 + r32] = (bf16_t)(cvt_pk_bf16(o[d0][r] * rli[r], 0.f) & 0xffffu); }
    }
    __syncthreads();
#undef KT
#undef SLOAD3
#undef SWRITE3
#undef RESC
#undef MASKT
#undef ROT3
#undef ITER
}

template <int DQK, int DV, bool MASK, int QSP, int ldq, int ldk, int ldv, int ldo>
__device__ __forceinline__ void attn_unit4(const bf16_t* __restrict__ Qb, const bf16_t* __restrict__ Kh, const bf16_t* __restrict__ Vh,
                                           bf16_t* __restrict__ Ob, int NT, int lo, float m_init, float l_init, int qpos0, LAS char* lds) {
    constexpr int SHM_K = KVBLK * DQK * 2, SHM_V = KVBLK * DV * 2, NKP = DQK / 64, NVP = DV / 64, ND0 = DQK / 16, NDV = DV / 32;
    const int tid = opaque_tid(), wid = tid >> 6, lane = tid & 63, r32 = lane & 31, hi = lane >> 5;
    LAS char* V_lds = lds; LAS char* K_lds = lds + 4 * SHM_V;
    LAS float* ws = (LAS float*)(lds + 4 * SHM_V + 4 * SHM_K) + wid * 64; LAS float* li_l = ws; LAS float* al_l = ws + 32;
    float m_reg = m_init, l_reg = l_init; f32x16 o[NDV]; bf16x8 qr[ND0 - QSP];
    LAS char* qsp = lds + 4 * SHM_V + 4 * SHM_K + 2048 + wid * (QSP * 1024) + lane * 16;
#pragma unroll
    for (int d = 0; d < NDV; ++d) o[d] = f32x16{};
    const bf16_t* Qw = Qb + (long)(wid * QBLK + r32) * ldq + hi * 8;
#pragma unroll
    for (int d0 = 0; d0 < ND0; ++d0) { const bf16x8 qv = *reinterpret_cast<const bf16x8*>(Qw + d0 * 16); if (d0 < ND0 - QSP) qr[d0 < ND0 - QSP ? d0 : 0] = qv; else *reinterpret_cast<LAS bf16x8*>(qsp + (d0 - (ND0 - QSP)) * 1024) = qv; }
    const int srow = tid >> 3, sc0 = (tid & 7) * 8;
    const int koff0 = srow * ldk + sc0, voff0 = srow * ldv + sc0, vst0 = (int)(uintptr_t)V_lds + v_st<DV>(srow, sc0);
    int kst[NKP];
#pragma unroll
    for (int q = 0; q < NKP; ++q) kst[q] = (int)(uintptr_t)K_lds + kswz<DQK>(srow, sc0 * 2 + 128 * q);
    const int vb0 = (int)(uintptr_t)V_lds + v_rd_base(lane);
    int kb[NKB<DQK>];
#pragma unroll
    for (int x = 0; x < NKB<DQK>; ++x) kb[x] = (int)(uintptr_t)K_lds + r32 * (DQK * 2) + ((x * 32 + hi * 16) ^ (ksw<DQK>(r32) << 4));
    bf16x8 sk[NKP], sv[NVP];
    bf16x8 kf[2 * ND0];
#define KT(j) ((j) < 4 ? (j) : (j) + lo)
#define SLOAD3(j) do { const int kt_ = __builtin_amdgcn_readfirstlane(KT(j)); const bf16_t* Vt_ = Vh + (long)kt_ * (KVBLK * (long)ldv); const bf16_t* Kt_ = Kh + (long)kt_ * (KVBLK * (long)ldk); \
    _Pragma("unroll") for (int q_ = 0; q_ < NVP; ++q_) sv[q_] = *reinterpret_cast<const bf16x8*>(Vt_ + voff0 + 64 * q_); \
    _Pragma("unroll") for (int q_ = 0; q_ < NKP; ++q_) sk[q_] = *reinterpret_cast<const bf16x8*>(Kt_ + koff0 + 64 * q_); } while (0)
#define SWRITE3(bi) do { \
    _Pragma("unroll") for (int q_ = 0; q_ < NVP; ++q_) *reinterpret_cast<LAS bf16x8*>((uintptr_t)(unsigned)(vst0 + (bi) * SHM_V + 1024 * q_)) = sv[q_]; \
    _Pragma("unroll") for (int q_ = 0; q_ < NKP; ++q_) *reinterpret_cast<LAS bf16x8*>((uintptr_t)(unsigned)(kst[q_] + (bi) * SHM_K)) = sk[q_]; } while (0)
#define RESC(a) do { if (__any((a) < 1.f)) { if (hi == 0) al_l[r32] = (a); asm volatile("s_waitcnt lgkmcnt(0)" ::: "memory"); \
    _Pragma("unroll") for (int d = 0; d < NDV; ++d) _Pragma("unroll") for (int r = 0; r < 16; ++r) o[d][r] *= al_l[crow(r, hi)]; } } while (0)
#define MASKT(P0, P1, j) do { if constexpr (MASK && DBG_BREAK != 4) { if ((j) >= 4) band_mask(P0, P1, (KT(j) - 4) * KVBLK - (qpos0 + wid * QBLK + r32), hi); } } while (0)
    f32x16 pA0, pA1, pB0, pB1; float mnA, mnB, alA, alB; bf16x8 pa0, pa1, pa2, pa3;
    static_assert(QSP == 0, "attn_unit4: Q fragments stay in registers");
    int bp = 0, bc = 1, bn = 2, bnn = 3;
#define ROT4() do { const int t_ = bp; bp = bc; bc = bn; bn = bnn; bnn = t_; } while (0)
#define KLOAD(bi) do { const int bo_ = (bi) * SHM_K; _Pragma("unroll") for (int d0 = 0; d0 < ND0; ++d0) { \
        kf[2 * d0] = *reinterpret_cast<const LAS bf16x8*>((uintptr_t)(unsigned)(KADDR(kb, d0) + bo_)); \
        kf[2 * d0 + 1] = *reinterpret_cast<const LAS bf16x8*>((uintptr_t)(unsigned)(KADDR(kb, d0) + bo_ + 32 * DQK * 2)); } } while (0)
#define QKREG(P0, P1) do { P0 = f32x16{}; P1 = f32x16{}; _Pragma("unroll") for (int d0 = 0; d0 < ND0; ++d0) { \
        P0 = __builtin_amdgcn_mfma_f32_32x32x16_bf16(kf[2 * d0], qr[d0], P0, 0, 0, 0); P1 = __builtin_amdgcn_mfma_f32_32x32x16_bf16(kf[2 * d0 + 1], qr[d0], P1, 0, 0, 0); } } while (0)
#define ITER(X0, X1, MNX, ALX, Y0, Y1, ALY, j) do { SBAR(); QKREG(X0, X1); MASKT(X0, X1, j); \
        finishSM(Y0, Y1, ALY, l_reg, pa0, pa1, pa2, pa3); SBAR(); \
        if ((j) + 1 < NT) { KLOAD(bn); } if ((j) + 2 < NT) { SWRITE3(bnn); } if ((j) + 3 < NT) { SLOAD3((j) + 3); } SBAR(); \
        pv_all<DV>(o, vb0 + bp * SHM_V, pa0, pa1, pa2, pa3); partialSM(X0, X1, m_reg, MNX, ALX); \
        RESC(ALX); __syncthreads(); ROT4(); } while (0)
    SLOAD3(0); asm volatile("s_waitcnt vmcnt(0)" ::: "memory"); SWRITE3(0); SLOAD3(1); asm volatile("s_waitcnt vmcnt(0)" ::: "memory"); SWRITE3(1); SLOAD3(2); __syncthreads();
    KLOAD(0); QKREG(pA0, pA1); MASKT(pA0, pA1, 0); partialSM(pA0, pA1, m_reg, mnA, alA);
    KLOAD(1); SWRITE3(2); SLOAD3(3); __syncthreads();
    for (int j = 1; j + 1 < NT; j += 2) {
        ITER(pB0, pB1, mnB, alB, pA0, pA1, alA, j);
        ITER(pA0, pA1, mnA, alA, pB0, pB1, alB, j + 1);
    }
    ITER(pB0, pB1, mnB, alB, pA0, pA1, alA, NT - 1);
    finishSM(pB0, pB1, alB, l_reg, pa0, pa1, pa2, pa3); SBAR();
    pv_all<DV>(o, vb0 + bp * SHM_V, pa0, pa1, pa2, pa3);
    if (hi == 0) li_l[r32] = l_reg; asm volatile("s_waitcnt lgkmcnt(0)" ::: "memory");
    float rli[16];
#pragma unroll
    for (int r = 0; r < 16; ++r) rli[r] = __builtin_amdgcn_rcpf(li_l[crow(r, hi)]);
    bf16_t* Ow = Ob + (long)(wid * QBLK) * ldo;
    if constexpr (OSTAGE && DQK != 192) {
        LAS bf16_t* stg = (LAS bf16_t*)(lds + 4 * SHM_V + 4 * SHM_K + 2048) + wid * (QBLK * DV);
#pragma unroll
        for (int r = 0; r < 16; ++r) { const int orow = crow(r, hi);
#pragma unroll
            for (int d0 = 0; d0 < NDV; ++d0) stg[orow * DV + d0 * 32 + r32] = (bf16_t)(cvt_pk_bf16(o[d0][r] * rli[r], 0.f) & 0xffffu); }
        asm volatile("s_waitcnt lgkmcnt(0)" ::: "memory");
#pragma unroll
        for (int i = 0; i < QBLK * DV / 8 / 64; ++i) { const int c = i * 64 + lane, row = c / (DV / 8), ch = c % (DV / 8);
            const u32x4 v = *(const LAS u32x4*)(stg + row * DV + ch * 8); *(u32x4*)(Ow + (long)row * ldo + ch * 8) = v; }
    } else {
#pragma unroll
    for (int r = 0; r < 16; ++r) { const int orow = crow(r, hi);
#pragma unroll
        for (int d0 = 0; d0 < NDV; ++d0) Ow[(long)orow * ldo + d0 * 32 + r32] = (bf16_t)(cvt_pk_bf16(o[d0][r] * rli[r], 0.f) & 0xffffu); }
    }
    __syncthreads();
#undef KT
#undef SLOAD3
#undef SWRITE3
#undef RESC
#undef MASKT
#undef ROT4
#undef KLOAD
#undef QKREG
#undef ITER
}

struct AttnP { const bf16_t* Q; const bf16_t* K; const bf16_t* V; bf16_t* O; const float* sink; };
template <int DQK, int DV, bool MASK, int SDEPTH, int QSP, int LDQ, int LDK, int LDV, int LDO, int H, int GQ, int GV, int KSTR, int VSTR, int DOCTX, bool O8 = false>
__device__ __forceinline__ void attn_phase(LAS char* lds, const AttnP& P, int G, int vcu) {
    constexpr int nheavy = 8 * H * 8, nlight = DOCTX ? 8 * H : 0;
    for (int it = vcu; it < nheavy + nlight; it += G) {
        int b, h, qb;
        if (it < nheavy) { qb = (it & 7) + 1; h = (it >> 3) % H; b = (it >> 3) / H; }
        else { const int i2 = it - nheavy; qb = 0; h = i2 % H; b = i2 / H; }
        const long r0 = (long)b * 2304;
        int NT, lo = 0;
        if (qb == 0) NT = 4;
        else if (MASK) { const int l0 = 4 * (qb - 1) - 2, h0 = 4 * (qb - 1) + 5; lo = l0 < 0 ? 0 : l0; const int hh = h0 > 31 ? 31 : h0; NT = 4 + hh - lo + 1; }
        else NT = 36;
        float m0 = -1e30f, l0f = 0.f;
        if (P.sink && DBG_BREAK != 3) { m0 = P.sink[h] * 1.4426950408889634f; l0f = 1.f; }
        if constexpr (SDEPTH == 4) attn_unit4<DQK, DV, MASK, QSP, LDQ, LDK, LDV, LDO>(P.Q + (r0 + qb * 256) * LDQ + h * DQK, P.K + r0 * LDK + (h / GQ) * KSTR, P.V + r0 * LDV + (h / GV) * VSTR,
                                 P.O + (r0 + qb * 256) * LDO + h * DV, NT, lo, m0, l0f, (qb - 1) * 256, lds);
        else if constexpr (SDEPTH == 3) attn_unit3<DQK, DV, MASK, QSP, LDQ, LDK, LDV, LDO>(P.Q + (r0 + qb * 256) * LDQ + h * DQK, P.K + r0 * LDK + (h / GQ) * KSTR, P.V + r0 * LDV + (h / GV) * VSTR,
                                 P.O + (r0 + qb * 256) * LDO + h * DV, NT, lo, m0, l0f, (qb - 1) * 256, lds);
        else attn_unit<DQK, DV, MASK, SDEPTH, QSP, LDQ, LDK, LDV, LDO, O8>(P.Q + (r0 + qb * 256) * LDQ + h * DQK, P.K + r0 * LDK + (h / GQ) * KSTR, P.V + r0 * LDV + (h / GV) * VSTR,
                                 O8 ? (bf16_t*)((unsigned char*)P.O + ((r0 + qb * 256) * LDO + h * DV)) : P.O + (r0 + qb * 256) * LDO + h * DV, NT, lo, m0, l0f, (qb - 1) * 256, lds);
    }
}
#undef SBAR
}

#ifndef DBG_BREAK
#define DBG_BREAK 0
#endif
#ifndef FUSE_QKV
#define FUSE_QKV 7
#endif
constexpr int NWAVES = 8;
constexpr int D = 1024, NB = 8, SEQ = 2048, CTXL = 256, RPB = 2304, M = NB * RPB  , MT = M / 256  , MLAT = NB * SEQ  ;
constexpr int FF = 3584, NEXP = 8, ECAP = M;
constexpr float EPS = 1e-6f, LOG2E = 1.4426950408889634f;
constexpr float SC_GQA = 0.12751743082459868f, SC_MLA = 0.10411754627697264f, SC_64 = 0.18033688011112042f;
constexpr float LAM_INIT = 0.5560582041556406f;
enum { I_X = 0, I_C, I_CTX, I_CCTX, I_ADAW, I_ADAB, I_NMIX, I_NFFN, I_GQA_WQKV, I_GQA_QG, I_GQA_KG, I_GQA_WO, I_MLA_WDOWN, I_MLA_QAG, I_MLA_KVAG, I_MLA_WUQ, I_MLA_WUKV, I_MLA_QG, I_MLA_KG, I_MLA_WO,
       I_WIN_WQKV, I_WIN_QG, I_WIN_KG, I_WIN_SINK, I_WIN_WO, I_DIFF_WQKV, I_DIFF_QG, I_DIFF_KG, I_DIFF_LAM, I_DIFF_SUBLN, I_DIFF_WO, I_FFN_W13, I_FFN_W2, I_MOE_ROUTER, I_MOE_W13, I_MOE_W2, N_IN };
constexpr size_t MiB = 1u << 20;
constexpr size_t WS_CTL = 0, CTL_ZERO_BYTES = 1 * MiB;
constexpr size_t WS_MOD = 1 * MiB;
constexpr size_t WS_R128C = 2 * MiB, WS_R128S = 2 * MiB + 512 * 1024;
constexpr size_t WS_R64C = 3 * MiB, WS_R64S = 3 * MiB + 256 * 1024;
constexpr size_t WS_TOKPOS = 4 * MiB, WS_TOKGATE = 4 * MiB + 256 * 1024;
constexpr size_t WS_WQKV0 = 8 * MiB, WS_WO0 = 11 * MiB, WS_WDOWN1 = 13 * MiB, WS_WUQ1 = 15 * MiB, WS_WUKV1 = 17 * MiB, WS_WO1 = 18 * MiB, WS_WQKV2 = 20 * MiB, WS_WO2 = 23 * MiB,
                 WS_WQKV3 = 25 * MiB, WS_WO3 = 31 * MiB, WS_WF13 = 34 * MiB, WS_WF2 = 62 * MiB, WS_WM13 = 76 * MiB, WS_WM2 = 300 * MiB;
constexpr size_t WS_XS = 412 * MiB, WS_H = 484 * MiB, WS_O2 = 520 * MiB, WS_OBUF = 556 * MiB, WS_ATT = 628 * MiB, WS_ACT = 928 * MiB, WS_Y = 1194 * MiB, WS_END = 1270 * MiB;
constexpr size_t WS_RAW = WS_ATT, WS_DN = WS_ATT, WS_CQN = WS_ATT + 32 * MiB, WS_CKVN = WS_ATT + 48 * MiB, WS_QRAW = WS_ATT + 64 * MiB, WS_KVRAW = WS_ATT + 120 * MiB, WS_KBUF = WS_ATT + 192 * MiB, WS_ASORT = WS_ATT;
constexpr int CW_BAR = 4096, CW_CNT = 8192, CW_CUR = 8448, CW_DONE = 8512;
constexpr int LDSCTL_OFF = 143360, LDS_BYTES = 147456;
constexpr int MI_BAR = 8, MI_TB = 16, MI_CNT = 32, MI_BASE = 40, MI_ENT = 64;

typedef GAS unsigned gu32;
#define RLX_AGENT __ATOMIC_RELAXED, __HIP_MEMORY_SCOPE_AGENT
#define LDS_WAIT() asm volatile("s_waitcnt lgkmcnt(0)" ::: "memory")
#define VM_WAIT() asm volatile("s_waitcnt vmcnt(0)" ::: "memory")

#define XB_TMO      128
#define XB_XCNT(j)  (256  + 64 * (j))
#define XB_XSUB(j)  (1280 + 64 * (j))
#define XB_XGEN(j)  (2304 + 64 * (j))
#define XB_TOP      3328
#define XB_TOPGEN   3392
#define XCD_BAR_WORDS 3456
#define XB_SPIN_CAP (1u << 22)
__device__ __forceinline__ unsigned xb_ld(unsigned* p)              { return __hip_atomic_load(p, __ATOMIC_RELAXED, __HIP_MEMORY_SCOPE_AGENT); }
__device__ __forceinline__ unsigned xb_add(unsigned* p, unsigned v) { return __hip_atomic_fetch_add(p, v, __ATOMIC_RELAXED, __HIP_MEMORY_SCOPE_AGENT); }
__device__ __forceinline__ unsigned xb_xcc_id() { return (unsigned)__builtin_amdgcn_s_getreg((3 << 11) | 20) & 0xFu; }
#define XB_SPIN(cond, bar) do { unsigned _sp = 0; while (cond) { __builtin_amdgcn_s_sleep(1); \
    if ((++_sp & 255u) == 0u) { if (xb_ld(&(bar)[XB_TMO])) break; if (_sp > XB_SPIN_CAP) { atomicAdd(&(bar)[XB_TMO], 1u); break; } } } } while (0)
struct XcdBarrier { unsigned* bar; unsigned x; volatile LAS unsigned* st; };
__device__ __forceinline__ XcdBarrier xcd_barrier_post(unsigned* bar, volatile LAS unsigned* st) {
    XcdBarrier b; b.bar = bar; b.x = xb_xcc_id(); b.st = st;
    if (threadIdx.x == 0) (void)xb_add(&bar[XB_XCNT(b.x)], 1u);
    return b;
}
__device__ __forceinline__ void xcd_barrier_complete(unsigned* bar, unsigned x, unsigned& nloc, unsigned& nx) {
    const unsigned G = gridDim.x * gridDim.y * gridDim.z;
    unsigned sum, cnt, mine, sp = 0u;
    for (;;) {
        sum = 0u; cnt = 0u; mine = 0u;
#pragma unroll
        for (unsigned j = 0; j < 16; ++j) { const unsigned c = xb_ld(&bar[XB_XCNT(j)]); sum += c; cnt += (c > 0u) ? 1u : 0u; mine = (j == x) ? c : mine; }
        if (sum == G) break;
        __builtin_amdgcn_s_sleep(1);
        if ((++sp & 255u) == 0u) { if (xb_ld(&bar[XB_TMO])) break; if (sp > XB_SPIN_CAP) { atomicAdd(&bar[XB_TMO], 1u); break; } }
    }
    nloc = mine > 0u ? mine : 1u; nx = cnt > 0u ? cnt : 1u;
}
__device__ __forceinline__ void xcd_barrier(const XcdBarrier& b) {
    asm volatile("s_waitcnt vmcnt(0)" ::: "memory");
    __syncthreads();
    if (threadIdx.x == 0) {
        unsigned* bar = b.bar;
        __builtin_amdgcn_s_waitcnt(0);
        unsigned nloc = b.st[0], nx = b.st[1];
        if (nloc == 0u) { xcd_barrier_complete(bar, b.x, nloc, nx); b.st[0] = nloc; b.st[1] = nx; }
        const unsigned old = xb_add(&bar[XB_XSUB(b.x)], 1u);
        const unsigned gen = old / nloc;
        if (old + 1u == (gen + 1u) * nloc) {
            __builtin_amdgcn_fence(__ATOMIC_RELEASE, "agent");
            asm volatile("s_waitcnt vmcnt(0)" ::: "memory");
            const unsigned og = xb_add(&bar[XB_TOP], 1u);
            const unsigned tg = og / nx;
            if (og + 1u == (tg + 1u) * nx) xb_add(&bar[XB_TOPGEN], 1u);
            else XB_SPIN(xb_ld(&bar[XB_TOPGEN]) == tg, bar);
            __builtin_amdgcn_fence(__ATOMIC_ACQUIRE, "agent");
            xb_add(&bar[XB_XGEN(b.x)], 1u);
            asm volatile("s_waitcnt vmcnt(0)" ::: "memory");
        } else {
            XB_SPIN(xb_ld(&bar[XB_XGEN(b.x)]) == gen, bar);
            __builtin_amdgcn_fence(__ATOMIC_ACQUIRE, "agent");
            asm volatile("s_waitcnt vmcnt(0)" ::: "memory");
        }
    }
    __syncthreads();
}

struct Params { const float* in[N_IN]; float* out; unsigned char* ws; int ph_lo, ph_hi; };
struct Frame {
    LAS unsigned char* lds; volatile LAS unsigned* MISC; gu32* ctl;
    int tid, lane, wave, vcu, G, gw, NGW;
    const float* const* in; float* out; unsigned char* ws;
};
#define WSP(T, off) ((T*)(F.ws + (off)))

__device__ __forceinline__ float wave_sum(float v) {
#pragma unroll
    for (int o = 1; o < 64; o <<= 1) v += __shfl_xor(v, o);
    return v;
}
__device__ __forceinline__ void ld8(const bf16_t* p, float (&v)[8]) { const u32x4 w = *(const u32x4*)p;
    v[0] = bf_lo(w.x); v[1] = bf_hi(w.x); v[2] = bf_lo(w.y); v[3] = bf_hi(w.y); v[4] = bf_lo(w.z); v[5] = bf_hi(w.z); v[6] = bf_lo(w.w); v[7] = bf_hi(w.w); }
__device__ __forceinline__ void st8(bf16_t* p, const float (&v)[8]) { u32x4 w; w.x = cvt_pk_bf16(v[0], v[1]); w.y = cvt_pk_bf16(v[2], v[3]); w.z = cvt_pk_bf16(v[4], v[5]); w.w = cvt_pk_bf16(v[6], v[7]); *(u32x4*)p = w; }
template <int LPG> __device__ __forceinline__ void seg_norm_rope(float (&v)[8], int lig, const float* gain, bool rope, const float* cs, const float* sn, float scale) {
    constexpr int HD = LPG * 8;
    float ss = 0.f;
#pragma unroll
    for (int i = 0; i < 8; ++i) ss += v[i] * v[i];
#pragma unroll
    for (int o = 1; o < LPG; o <<= 1) ss += __shfl_xor(ss, o);
    const float rstd = 1.0f / sqrtf(ss * (1.0f / HD) + EPS);
    const int e0 = lig * 8;
    const f32x4 g0 = *(const f32x4*)(gain + e0), g1 = *(const f32x4*)(gain + e0 + 4);
    v[0] *= rstd * g0[0]; v[1] *= rstd * g0[1]; v[2] *= rstd * g0[2]; v[3] *= rstd * g0[3]; v[4] *= rstd * g1[0]; v[5] *= rstd * g1[1]; v[6] *= rstd * g1[2]; v[7] *= rstd * g1[3];
    if (rope) {
        const bool hf = lig >= LPG / 2; const int p0 = e0 & (HD / 2 - 1);
        const f32x4 c0 = *(const f32x4*)(cs + p0), c1 = *(const f32x4*)(cs + p0 + 4), s0 = *(const f32x4*)(sn + p0), s1 = *(const f32x4*)(sn + p0 + 4);
        const float cc[8] = {c0[0], c0[1], c0[2], c0[3], c1[0], c1[1], c1[2], c1[3]}, sv[8] = {s0[0], s0[1], s0[2], s0[3], s1[0], s1[1], s1[2], s1[3]};
#pragma unroll
        for (int i = 0; i < 8; ++i) { const float py = __shfl_xor(v[i], LPG / 2); v[i] = hf ? (py * sv[i] + v[i] * cc[i]) : (v[i] * cc[i] - py * sv[i]); }
    }
#pragma unroll
    for (int i = 0; i < 8; ++i) v[i] *= scale;
}

#ifndef WO_FP8
#define WO_FP8 15
#endif
#ifndef QKV_FP8
#define QKV_FP8 15
#endif
#ifndef UPM_FP8
#define UPM_FP8 1
#endif
#ifndef CONV_KFAST
#define CONV_KFAST 1
#endif
struct TDesc { int in_idx, K, N, nmat, perm, item0; unsigned long long src_off, dst; };
#define TD_ITEMS(K, N, nmat) ((nmat) * ((K) / 64) * ((N) / 64))
constexpr int TE0 = 0, TE1 = TE0 + TD_ITEMS(1024, 1536, 1), TE2 = TE1 + TD_ITEMS(1024, 1024, 1), TE3 = TE2 + TD_ITEMS(1024, 7168, 1), TE4 = TE3 + TD_ITEMS(3584, 1024, 1),
              TE5 = TE4 + TD_ITEMS(1024, 704, 1), TE6 = TE5 + TD_ITEMS(384, 1536, 1), TE7 = TE6 + TD_ITEMS(256, 2048, 1), TE8 = TE7 + TD_ITEMS(1024, 1024, 1),
              TE9 = TE8 + TD_ITEMS(1024, 7168, 8), TE10 = TE9 + TD_ITEMS(3584, 1024, 8),
              TE11 = TE10 + TD_ITEMS(1024, 1280, 1), TE12 = TE11 + TD_ITEMS(1024, 1024, 1), TE13 = TE12 + TD_ITEMS(1024, 7168, 1), TE14 = TE13 + TD_ITEMS(3584, 1024, 1),
              TE15 = TE14 + TD_ITEMS(1024, 3072, 1), TE16 = TE15 + TD_ITEMS(1024, 1024, 1), TE17 = TE16 + TD_ITEMS(1024, 7168, 8), TI_END = TE17 + TD_ITEMS(3584, 1024, 8);
constexpr int N_TD = 18;
constexpr int TI_PRO = TE4;
constexpr int TWA = TI_PRO + 1200, TWB = TWA + 3600, TWC = TWB + 500, TWD = TWC + 12800, TWE = TWD + 600, TWF = TE10  ,
              TWG = TWF + 3000, TWH = TWG + 9000, TWI = TWH + 2400, TWJ = TWI + 3600, TWK = TWJ + 500;
static_assert(TWB > TE8 && TWE < TWF && TWG > TE12 && TWH > TE14 && TWK < TI_END, "conversion windows");
__constant__ TDesc g_td[N_TD] = {
    {I_GQA_WQKV, 1024, 1536, 1, ((FUSE_QKV & 1) ? 2 : 0) | ((QKV_FP8 & 1) ? 8 : 0), TE0, 0ull, WS_WQKV0}, {I_GQA_WO, 1024, 1024, 1, (WO_FP8 & 1) ? 8 : 0, TE1, 0ull, WS_WO0}, {I_FFN_W13, 1024, 7168, 1, 1, TE2, 0ull, WS_WF13}, {I_FFN_W2, 3584, 1024, 1, 8, TE3, 0ull, WS_WF2},
    {I_MLA_WDOWN, 1024, 704, 1, (QKV_FP8 & 2) ? 8 : 0, TE4, 0ull, WS_WDOWN1}, {I_MLA_WUQ, 384, 1536, 1, 0, TE5, 0ull, WS_WUQ1}, {I_MLA_WUKV, 256, 2048, 1, 0, TE6, 0ull, WS_WUKV1}, {I_MLA_WO, 1024, 1024, 1, (WO_FP8 & 2) ? 8 : 0, TE7, 0ull, WS_WO1},
    {I_MOE_W13, 1024, 7168, 8, UPM_FP8 ? 9 : 1, TE8, 0ull, WS_WM13}, {I_MOE_W2, 3584, 1024, 8, 8, TE9, 0ull, WS_WM2},
    {I_WIN_WQKV, 1024, 1280, 1, ((FUSE_QKV & 2) ? 3 : 0) | ((QKV_FP8 & 4) ? 8 : 0), TE10, 0ull, WS_WQKV2}, {I_WIN_WO, 1024, 1024, 1, (WO_FP8 & 4) ? 8 : 0, TE11, 0ull, WS_WO2},
    {I_FFN_W13, 1024, 7168, 1, 1, TE12, (unsigned long long)1024 * 7168, WS_WF13 + (size_t)7168 * 1024 * 2}, {I_FFN_W2, 3584, 1024, 1, 8, TE13, (unsigned long long)3584 * 1024, WS_WF2 + (size_t)1024 * 3584},
    {I_DIFF_WQKV, 1024, 3072, 1, ((FUSE_QKV & 4) ? 4 : 0) | ((QKV_FP8 & 8) ? 8 : 0), TE14, 0ull, WS_WQKV3}, {I_DIFF_WO, 1024, 1024, 1, (WO_FP8 & 8) ? 8 : 0, TE15, 0ull, WS_WO3},
    {I_MOE_W13, 1024, 7168, 8, UPM_FP8 ? 9 : 1, TE16, (unsigned long long)8 * 1024 * 7168, WS_WM13 + (size_t)8 * 7168 * 1024 * (UPM_FP8 ? 1 : 2)}, {I_MOE_W2, 3584, 1024, 8, 8, TE17, (unsigned long long)8 * 3584 * 1024, WS_WM2 + (size_t)8 * 1024 * 3584} };

__device__ __forceinline__ void p0_transpose_item(const float* W, int K, int N, int perm, bf16_t* WT, LAS float* scr, int kb, int nb, int lane) {
    const int k0 = 64 * kb, n0 = 64 * nb;
    const float* wp = W + (size_t)(k0 + (lane >> 4)) * N + n0 + (lane & 15) * 4;
    f32x4 x[16];
#pragma unroll
    for (int i = 0; i < 16; ++i) x[i] = __builtin_nontemporal_load((const f32x4*)(wp + (size_t)(4 * i) * N));
    LAS float* s0 = scr + (lane >> 4) * 65 + (lane & 15) * 4;
#pragma unroll
    for (int i = 0; i < 16; ++i) { LAS float* s = s0 + (4 * i) * 65; s[0] = x[i][0]; s[1] = x[i][1]; s[2] = x[i][2]; s[3] = x[i][3]; }
    LDS_WAIT(); asm volatile("" ::: "memory");
    const int c = lane & 7;
    const int rmap = perm & 7;
#pragma unroll 2
    for (int j = 0; j < 8; ++j) { const int n = (lane >> 3) + 8 * j; const LAS float* s = scr + (8 * c) * 65 + n;
        int nn = n0 + n;
        float ws = 1.0f;
        if (rmap == 1) { const int half = nn >= FF ? 1 : 0; nn -= half * FF; nn = (nn >> 7) * 256 + half * 128 + (nn & 127); ws = half ? pg8::SW_U : pg8::SW_G; }
        else if (rmap >= 2) { const int hd = rmap == 2 ? 128 : 64, lim = rmap == 2 ? 1280 : (rmap == 3 ? 1152 : 2048);
            if (nn < lim) { const int h = nn / hd, d = nn - h * hd; nn = h * hd + (d < hd / 2 ? 2 * d : 2 * (d - hd / 2) + 1); } }
        if (perm & 8) { float v[8];
#pragma unroll
            for (int q = 0; q < 8; ++q) v[q] = fminf(fmaxf(F8_W_MUL * ws * s[q * 65], -448.f), 448.f);
            u32x2 o; o.x = pk4_fp8(v[0], v[1], v[2], v[3]); o.y = pk4_fp8(v[4], v[5], v[6], v[7]);
            __builtin_nontemporal_store(o, (u32x2*)((unsigned char*)WT + (size_t)nn * K + k0 + 8 * c)); }
        else { u32x4 o; o.x = cvt_pk_bf16(ws * s[0 * 65], ws * s[1 * 65]); o.y = cvt_pk_bf16(ws * s[2 * 65], ws * s[3 * 65]); o.z = cvt_pk_bf16(ws * s[4 * 65], ws * s[5 * 65]); o.w = cvt_pk_bf16(ws * s[6 * 65], ws * s[7 * 65]);
            __builtin_nontemporal_store(o, (u32x4*)(WT + (size_t)nn * K + k0 + 8 * c)); } }
    LDS_WAIT(); asm volatile("" ::: "memory");
}
__device__ __forceinline__ void sincos_d(double a, double& s, double& c) {
    const double TWO_PI = 6.283185307179586476925286766559, INV_TWO_PI = 0.15915494309189533576888376337251;
    const double n = __builtin_rint(a * INV_TWO_PI); const double r = a - n * TWO_PI, r2 = r * r;
    double ts = 1.0, tc = 1.0;
#pragma unroll
    for (int k = 15; k >= 1; --k) { ts = 1.0 - ts * r2 / (double)((2 * k) * (2 * k + 1)); tc = 1.0 - tc * r2 / (double)((2 * k - 1) * (2 * k)); }
    s = r * ts; c = tc;
}
__device__ __forceinline__ void convert_one(const Frame& F, int it) {
    LAS float* scr = (LAS float*)(F.lds + F.wave * 16640);
    int d = 0;
#pragma unroll
    for (int k = 1; k < N_TD; ++k) d += (it >= g_td[k].item0) ? 1 : 0;
    const int K = g_td[d].K, N = g_td[d].N, perm = g_td[d].perm; int r = it - g_td[d].item0;
    const int nblk = N / 64, kblk = K / 64, per = kblk * nblk, mat = r / per; r -= mat * per;
#if CONV_KFAST
    const int nb = r / kblk, kb = r - nb * kblk;
#else
    const int kb = r / nblk, nb = r - kb * nblk;
#endif
    const float* W = F.in[g_td[d].in_idx] + g_td[d].src_off + (size_t)mat * K * N; bf16_t* WT = (bf16_t*)(F.ws + g_td[d].dst + (size_t)mat * K * N * ((perm & 8) ? 1 : 2));
    p0_transpose_item(W, K, N, perm, WT, scr, kb, nb, F.lane);
}
__device__ __forceinline__ void convert_items(const Frame& F, int lo, int hi, int rank, int nworkers) {
    for (int it = lo + rank * NWAVES + F.wave; it < hi; it += nworkers * NWAVES) convert_one(F, it);
}
__device__ __forceinline__ int convert_claim(const Frame& F) {
    unsigned v = 0u; if (F.lane == 0) v = __hip_atomic_fetch_add(F.ctl + CW_CUR, 2u, RLX_AGENT);
    return TI_PRO + (int)__builtin_amdgcn_readfirstlane(v);
}
__device__ __forceinline__ void tail_convert(const Frame& F, int rem, int phase) {
    if (rem == 0) return;
    gu32* done = F.ctl + CW_DONE + 64 * phase;
    if (F.vcu < rem) { if (F.tid == 0) __hip_atomic_fetch_add(done, 1u, RLX_AGENT); return; }
    for (;;) {
        const int it = convert_claim(F);
        if (it >= TI_END) break;
        const unsigned dn = __hip_atomic_load(done, RLX_AGENT);
        convert_one(F, it); if (it + 1 < TI_END) convert_one(F, it + 1);
        if ((int)__builtin_amdgcn_readfirstlane(dn) >= rem) break;
    }
}
__device__ __forceinline__ void convert_catch_up(const Frame& F, int need) {
    for (;;) {
        if ((int)__builtin_amdgcn_readfirstlane(__hip_atomic_load(F.ctl + CW_CUR, RLX_AGENT)) + TI_PRO >= need) break;
        const int it = convert_claim(F);
        if (it >= TI_END) break;
        convert_one(F, it); if (it + 1 < TI_END) convert_one(F, it + 1);
    }
}
__device__ __forceinline__ void mod_tasks(const Frame& F, int tlo, int thi, int rank, int nworkers) {
    LAS float* sl = (LAS float*)F.lds;
    LAS float* red = (LAS float*)(F.lds + 40960);
    if (tlo + rank >= thi) return;
    for (int i = F.tid; i < 9 * 1024; i += NWAVES * 64) { const float cv = (i < 8192) ? F.in[I_C][i] : F.in[I_CCTX][i - 8192]; sl[i] = cv / (1.0f + __expf(-cv)); }
    __syncthreads();
    for (int task = tlo + rank; task < thi; task += nworkers) {
        const int li = task / 96, cg = task % 96, col = cg * 64 + F.lane;
        const float* wp = F.in[I_ADAW] + ((size_t)li * 1024 + F.wave * 128) * 6144 + col;
        float acc[9];
#pragma unroll
        for (int r = 0; r < 9; ++r) acc[r] = 0.f;
        for (int k0 = 0; k0 < 128; k0 += 32) { float wv[32];
#pragma unroll
            for (int k = 0; k < 32; ++k) wv[k] = __builtin_nontemporal_load(wp + (size_t)(k0 + k) * 6144);
#pragma unroll
            for (int k = 0; k < 32; ++k)
#pragma unroll
                for (int r = 0; r < 9; ++r) acc[r] += sl[r * 1024 + F.wave * 128 + k0 + k] * wv[k]; }
#pragma unroll
        for (int r = 0; r < 9; ++r) red[(F.wave * 9 + r) * 64 + F.lane] = acc[r];
        __syncthreads();
        for (int idx = F.tid; idx < 576; idx += NWAVES * 64) { float s = 0.f;
#pragma unroll
            for (int w = 0; w < 8; ++w) s += red[w * 576 + idx];
            const int r = idx >> 6, cc = cg * 64 + (idx & 63);
            WSP(float, WS_MOD)[((size_t)li * 9 + r) * 6144 + cc] = s + F.in[I_ADAB][li * 6144 + cc]; }
        __syncthreads();
    }
}
__device__ __forceinline__ void p0_prologue(const Frame& F) {
    mod_tasks(F, 0, 384, F.vcu, F.G);
    for (int idx = blockIdx.x * (NWAVES * 64) + F.tid; idx < 2048 * 96; idx += F.G * NWAVES * 64) {
        int t, p, Q; float *co, *so;
        if (idx < 2048 * 64) { t = idx >> 6; p = idx & 63; Q = 32; co = WSP(float, WS_R128C) + idx; so = WSP(float, WS_R128S) + idx; }
        else { const int i2 = idx - 2048 * 64; t = i2 >> 5; p = i2 & 31; Q = 16; co = WSP(float, WS_R64C) + i2; so = WSP(float, WS_R64S) + i2; }
        const int pos = p < Q ? (t >> 6) : (t & 63), kf = p < Q ? p : p - Q;
        const float inv = (float)exp2(-(double)kf / (double)Q * 13.287712379549449);
        const float ang = (float)pos * inv;
        double s, c; sincos_d((double)ang, s, c); *co = (float)c; *so = (float)s;
    }
    for (int idx = blockIdx.x * (NWAVES * 64) + F.tid; idx < 64 * 1024 / 8; idx += F.G * NWAVES * 64) *(u32x4*)(WSP(bf16_t, WS_WDOWN1) + (size_t)704 * 1024 + (size_t)idx * 8) = (u32x4){0u, 0u, 0u, 0u};
    __syncthreads();
    convert_items(F, 0, TI_PRO, F.vcu, F.G);
}

struct RowCtx { int R, b, j, isctx, mr; };
__device__ __forceinline__ RowCtx row_ctx(int idx, bool latent_only) { RowCtx c; c.R = latent_only ? (idx >> 11) * RPB + CTXL + (idx & 2047) : idx; c.b = c.R / RPB; c.j = c.R - c.b * RPB; c.isctx = c.j < CTXL; c.mr = c.isctx ? 8 : c.b; return c; }
__device__ __forceinline__ void norm_row(const Frame& F, const RowCtx& rc, int layer, int which, int src_mode, f32x4 (&v)[4]) {
    const int lane = F.lane;
    f16_t* xs = WSP(f16_t, WS_XS) + (size_t)rc.R * D;
    if (src_mode == 0) { const float* src = rc.isctx ? F.in[I_CTX] + ((size_t)rc.b * CTXL + rc.j) * D : F.in[I_X] + ((size_t)rc.b * SEQ + rc.j - CTXL) * D;
#pragma unroll
        for (int jj = 0; jj < 4; ++jj) v[jj] = *((const f32x4*)src + lane + 64 * jj); }
    else {
#pragma unroll
        for (int jj = 0; jj < 4; ++jj) v[jj] = __builtin_convertvector(*((const f16x4*)xs + lane + 64 * jj), f32x4); }
    if (src_mode == 2) {
        const LAS int* tb = (const LAS int*)(F.MISC + MI_TB);
        const int p0 = WSP(int, WS_TOKPOS)[rc.R * 2], p1 = WSP(int, WS_TOKPOS)[rc.R * 2 + 1]; const float g0 = WSP(float, WS_TOKGATE)[rc.R * 2], g1 = WSP(float, WS_TOKGATE)[rc.R * 2 + 1];
        const int e0 = p0 / ECAP, e1 = p1 / ECAP; const size_t r0 = (size_t)tb[e0] * 256 + (p0 - e0 * ECAP), r1 = (size_t)tb[e1] * 256 + (p1 - e1 * ECAP);
        const bf16_t* y0 = WSP(bf16_t, WS_Y) + r0 * D; const bf16_t* y1 = WSP(bf16_t, WS_Y) + r1 * D;
        const float* gf = WSP(float, WS_MOD) + ((size_t)(layer - 1) * 9 + rc.mr) * 6144 + 5 * 1024;
#pragma unroll
        for (int jj = 0; jj < 4; ++jj) { const int col = 4 * lane + 256 * jj; const u32x2 a = *(const u32x2*)(y0 + col), bq = *(const u32x2*)(y1 + col); const f32x4 g = *(const f32x4*)(gf + col);
            v[jj][0] += g[0] * (g0 * bf_lo(a.x) + g1 * bf_lo(bq.x)); v[jj][1] += g[1] * (g0 * bf_hi(a.x) + g1 * bf_hi(bq.x));
            v[jj][2] += g[2] * (g0 * bf_lo(a.y) + g1 * bf_lo(bq.y)); v[jj][3] += g[3] * (g0 * bf_hi(a.y) + g1 * bf_hi(bq.y)); }
    }
    if (src_mode != 1) {
#pragma unroll
        for (int jj = 0; jj < 4; ++jj) *((f16x4*)xs + lane + 64 * jj) = __builtin_convertvector(v[jj], f16x4);
    }
    float ss = 0.f;
#pragma unroll
    for (int jj = 0; jj < 4; ++jj) ss += (v[jj][0] * v[jj][0] + v[jj][1] * v[jj][1]) + (v[jj][2] * v[jj][2] + v[jj][3] * v[jj][3]);
    const float rstd = 1.0f / sqrtf(wave_sum(ss) * (1.0f / D) + EPS);
    const float* gn = F.in[which ? I_NFFN : I_NMIX] + layer * D;
    const float* md = WSP(float, WS_MOD) + ((size_t)layer * 9 + rc.mr) * 6144 + (which ? 3 : 0) * 1024;
#pragma unroll
    for (int jj = 0; jj < 4; ++jj) { const int col = 4 * lane + 256 * jj; const f32x4 g = *(const f32x4*)(gn + col), sh = *(const f32x4*)(md + col), sc = *(const f32x4*)(md + 1024 + col);
        v[jj] = v[jj] * rstd * g * (sc + 1.0f) + sh; }
}
__device__ __forceinline__ void store_row_bf16(bf16_t* dst, const f32x4 (&v)[4], int lane) {
#pragma unroll
    for (int jj = 0; jj < 4; ++jj) { u32x2 w; w.x = cvt_pk_bf16(v[jj][0], v[jj][1]); w.y = cvt_pk_bf16(v[jj][2], v[jj][3]); *((u32x2*)dst + lane + 64 * jj) = w; }
}
__device__ __forceinline__ void store_row_fp8(unsigned char* dst, const f32x4 (&v)[4], int lane) {
#pragma unroll
    for (int jj = 0; jj < 4; ++jj) { float c[4];
#pragma unroll
        for (int i = 0; i < 4; ++i) c[i] = fminf(fmaxf(F8_ACT_MUL * v[jj][i], -448.f), 448.f);
        *((unsigned*)dst + lane + 64 * jj) = pk4_fp8(c[0], c[1], c[2], c[3]); }
}
__device__ __forceinline__ void moe_tile_base(const Frame& F, int j) {
    if (F.tid == 0) { int acc = 0;
        for (int e = 0; e < NEXP; ++e) { F.MISC[MI_TB + e] = (unsigned)acc; acc += (int)((__hip_atomic_load(F.ctl + CW_CNT + 64 * j + e, RLX_AGENT) + 255u) >> 8); }
        F.MISC[MI_TB + 8] = (unsigned)acc; }
    __syncthreads();
}
__device__ __forceinline__ void norm_phase_dense(const Frame& F, int layer, int which, int src_mode, bool latent_only, bool fp8out = false) {
    const int nrows = latent_only ? MLAT : M;
    for (int idx = F.gw; idx < nrows; idx += F.NGW) { const RowCtx rc = row_ctx(idx, latent_only); f32x4 v[4]; norm_row(F, rc, layer, which, src_mode, v);
        if (fp8out) store_row_fp8(WSP(unsigned char, WS_H) + (size_t)rc.R * D, v, F.lane); else store_row_bf16(WSP(bf16_t, WS_H) + (size_t)rc.R * D, v, F.lane); }
}
__device__ __forceinline__ void norm_phase_moe(const Frame& F, int layer, int j, bool latent_only) {
    LAS float* rt = (LAS float*)F.lds;
    const float* rw = F.in[I_MOE_ROUTER] + (size_t)j * D * NEXP;
    for (int i = F.tid; i < D * NEXP; i += NWAVES * 64) rt[(i & 7) * D + (i >> 3)] = rw[i];
    if (F.tid < 8) F.MISC[MI_CNT + F.tid] = 0u;
    __syncthreads();
    const int nrows = latent_only ? MLAT : M; const int lane = F.lane;
    constexpr int RC = 8;
    f32x4 vs[RC][4];
#define MOE_ROUTE(V, KK, RCX) do { float lg[NEXP]; \
        _Pragma("unroll") for (int e = 0; e < NEXP; ++e) { float s_ = 0.f; \
            _Pragma("unroll") for (int jj = 0; jj < 4; ++jj) { const f32x4 r4 = *(const LAS f32x4*)(rt + e * D + 4 * lane + 256 * jj); s_ += (V[jj][0] * r4[0] + V[jj][1] * r4[1]) + (V[jj][2] * r4[2] + V[jj][3] * r4[3]); } \
            lg[e] = wave_sum(s_); } \
        float b1 = lg[0]; int i1 = 0; \
        _Pragma("unroll") for (int e = 1; e < NEXP; ++e) if (lg[e] > b1) { b1 = lg[e]; i1 = e; } \
        float b2 = -3.0e38f; int i2 = 0; \
        _Pragma("unroll") for (int e = 0; e < NEXP; ++e) if (e != i1 && lg[e] > b2) { b2 = lg[e]; i2 = e; } \
        const float g1 = 1.0f / (1.0f + __expf(b2 - b1)), g2 = 1.0f - g1; \
        if (lane == 0) { \
            const unsigned r1 = __hip_atomic_fetch_add((LAS unsigned*)(F.MISC + MI_CNT + i1), 1u, __ATOMIC_RELAXED, __HIP_MEMORY_SCOPE_WORKGROUP); \
            const unsigned r2 = __hip_atomic_fetch_add((LAS unsigned*)(F.MISC + MI_CNT + i2), 1u, __ATOMIC_RELAXED, __HIP_MEMORY_SCOPE_WORKGROUP); \
            volatile LAS unsigned* ent = F.MISC + MI_ENT + (F.wave * 16 + (KK)) * 4; ent[0] = (unsigned)i1; ent[1] = r1; ent[2] = (unsigned)i2; ent[3] = r2; \
            WSP(float, WS_TOKGATE)[(RCX).R * 2] = g1; WSP(float, WS_TOKGATE)[(RCX).R * 2 + 1] = g2; } } while (0)
#pragma unroll
    for (int k = 0; k < RC; ++k) { const int idx = F.gw + k * F.NGW;
        if (idx < nrows) { const RowCtx rc = row_ctx(idx, latent_only); norm_row(F, rc, layer, 1, 1, vs[k]); MOE_ROUTE(vs[k], k, rc); } }
    for (int k = RC, idx = F.gw + RC * F.NGW; idx < nrows; idx += F.NGW, ++k) {
        const RowCtx rc = row_ctx(idx, latent_only); f32x4 v[4]; norm_row(F, rc, layer, 1, 1, v); MOE_ROUTE(v, k, rc); }
#undef MOE_ROUTE
    LDS_WAIT(); __syncthreads();
    if (F.tid < 8) F.MISC[MI_BASE + F.tid] = __hip_atomic_fetch_add(F.ctl + CW_CNT + 64 * j + F.tid, F.MISC[MI_CNT + F.tid], RLX_AGENT);
    __syncthreads();
#define MOE_SCATTER(V, KK, RCX) do { volatile LAS unsigned* ent = F.MISC + MI_ENT + (F.wave * 16 + (KK)) * 4; \
        const int i1 = (int)ent[0], i2 = (int)ent[2]; const int q1 = i1 * ECAP + (int)(F.MISC[MI_BASE + i1] + ent[1]), q2 = i2 * ECAP + (int)(F.MISC[MI_BASE + i2] + ent[3]); \
        if (UPM_FP8) { store_row_fp8(WSP(unsigned char, WS_ASORT) + (size_t)q1 * D, V, lane); store_row_fp8(WSP(unsigned char, WS_ASORT) + (size_t)q2 * D, V, lane); } \
        else { store_row_bf16(WSP(bf16_t, WS_ASORT) + (size_t)q1 * D, V, lane); store_row_bf16(WSP(bf16_t, WS_ASORT) + (size_t)q2 * D, V, lane); } \
        if (lane == 0) { WSP(int, WS_TOKPOS)[(RCX).R * 2] = q1; WSP(int, WS_TOKPOS)[(RCX).R * 2 + 1] = q2; } } while (0)
#pragma unroll
    for (int k = 0; k < RC; ++k) { const int idx = F.gw + k * F.NGW;
        if (idx < nrows) { const RowCtx rc = row_ctx(idx, latent_only); MOE_SCATTER(vs[k], k, rc); } }
    for (int k = RC, idx = F.gw + RC * F.NGW; idx < nrows; idx += F.NGW, ++k) {
        const RowCtx rc = row_ctx(idx, latent_only); f32x4 v[4]; norm_row(F, rc, layer, 1, 1, v); MOE_SCATTER(v, k, rc); }
#undef MOE_SCATTER
}
#ifndef OVF_SPLIT
#define OVF_SPLIT 1
#endif
__device__ __forceinline__ void final_phase(const Frame& F, int layer) {
    const LAS int* tb = (const LAS int*)(F.MISC + MI_TB); const int lane = F.lane;
    const int nt = tb[8], nun = nt * 4, lmain = (nun / F.G) * F.G, remu = nun - lmain; const bool ovon = OVF_SPLIT && remu > 0 && remu <= 128;
    const float* slab = WSP(float, WS_ASORT);
    for (int idx = F.gw; idx < MLAT; idx += F.NGW) {
        const RowCtx rc = row_ctx(idx, true);
        const f16_t* xs = WSP(f16_t, WS_XS) + (size_t)rc.R * D; float* o = F.out + (size_t)idx * D;
        const int p0 = WSP(int, WS_TOKPOS)[rc.R * 2], p1 = WSP(int, WS_TOKPOS)[rc.R * 2 + 1]; const float g0 = WSP(float, WS_TOKGATE)[rc.R * 2], g1 = WSP(float, WS_TOKGATE)[rc.R * 2 + 1];
        const int e0 = p0 / ECAP, e1 = p1 / ECAP; const int r0 = tb[e0] * 256 + (p0 - e0 * ECAP), r1 = tb[e1] * 256 + (p1 - e1 * ECAP);
        const float* gf = WSP(float, WS_MOD) + ((size_t)layer * 9 + rc.mr) * 6144 + 5 * 1024;
#pragma unroll
        for (int jj = 0; jj < 4; ++jj) { const int col = 4 * lane + 256 * jj; f32x4 x = __builtin_convertvector(*(const f16x4*)(xs + col), f32x4); const f32x4 g = *(const f32x4*)(gf + col);
            f32x4 ya, yb;
#pragma unroll
            for (int w = 0; w < 2; ++w) { const int r = w ? r1 : r0; const int t = r >> 8, gid = t >> 3, fm = gid * 8, gsz = (nt - fm) < 8 ? (nt - fm) : 8, L = gid * 32 + jj * gsz + (t - fm);
                f32x4 y;
                if (ovon && L >= lmain) { const float* sp = slab + (size_t)(L - lmain) * 65536 + (size_t)(r & 255) * 256 + 4 * lane; y = *(const f32x4*)sp;
#pragma unroll
                    for (int ks = 1; ks < 7; ++ks) y += *(const f32x4*)(sp + (size_t)ks * 128 * 65536); }
                else { const u32x2 a = *(const u32x2*)(WSP(bf16_t, WS_Y) + (size_t)r * D + col); y = (f32x4){bf_lo(a.x), bf_hi(a.x), bf_lo(a.y), bf_hi(a.y)}; }
                if (w) yb = y; else ya = y; }
            x += g * (ya * g0 + yb * g1);
            *(f32x4*)(o + col) = x; }
    }
}

template <int LPG> __device__ __forceinline__ void qk_pass(const Frame& F, bf16_t* raw, int ld, int NQ, int NK, const float* qg, const float* kg, float qscale, const float* rc_, const float* rs_) {
    constexpr int HD = LPG * 8; const int nel = (NQ + NK) * HD; const int lane = F.lane, lig = lane & (LPG - 1);
    for (int R = F.gw; R < M; R += F.NGW) {
        const int j = R % RPB; const bool rope = (j >= CTXL) && !((DBG_BREAK == 1 && LPG == 16) || (DBG_BREAK == 2 && LPG == 8)); const int pos = rope ? j - CTXL : 0;
        const float* cs = rc_ + (size_t)pos * (HD / 2); const float* sn = rs_ + (size_t)pos * (HD / 2);
        bf16_t* rowp = raw + (size_t)R * ld;
        for (int c0 = 0; c0 < nel; c0 += 512) {
            const int col = c0 + 8 * lane; const bool act = col < nel; const int seg = col / HD; const bool isq = seg < NQ;
            float v[8];
            if (act) ld8(rowp + col, v); else {
#pragma unroll
                for (int i = 0; i < 8; ++i) v[i] = 0.f; }
            seg_norm_rope<LPG>(v, lig, isq ? qg : kg, rope, cs, sn, isq ? qscale : 1.0f);
            if (act) st8(rowp + col, v);
        }
    }
}
__device__ __forceinline__ void mla_pb2(const Frame& F) {
    const int lane = F.lane;
    const bf16_t* dn = WSP(bf16_t, WS_DN); bf16_t* cqn = WSP(bf16_t, WS_CQN); bf16_t* ckvn = WSP(bf16_t, WS_CKVN); bf16_t* kbuf = WSP(bf16_t, WS_KBUF);
    for (int R = F.gw; R < M; R += F.NGW) {
        const int j = R % RPB; const bool rope = (j >= CTXL) && (DBG_BREAK != 6); const int pos = rope ? j - CTXL : 0;
        const bf16_t* rowp = dn + (size_t)R * 768; float v[8];
        {
            const bool act = lane < 48; if (act) ld8(rowp + 8 * lane, v); else {
#pragma unroll
                for (int i = 0; i < 8; ++i) v[i] = 0.f; }
            float ss = 0.f;
#pragma unroll
            for (int i = 0; i < 8; ++i) ss += v[i] * v[i];
            const float rstd = 1.0f / sqrtf(wave_sum(ss) * (1.0f / 384.0f) + EPS);
            if (act) { const float* g = F.in[I_MLA_QAG] + 8 * lane;
#pragma unroll
                for (int i = 0; i < 8; ++i) v[i] *= rstd * g[i];
                st8(cqn + (size_t)R * 384 + 8 * lane, v); }
        }
        {
            const bool act = lane < 32; if (act) ld8(rowp + 384 + 8 * lane, v); else {
#pragma unroll
                for (int i = 0; i < 8; ++i) v[i] = 0.f; }
            float ss = 0.f;
#pragma unroll
            for (int i = 0; i < 8; ++i) ss += v[i] * v[i];
            const float rstd = 1.0f / sqrtf(wave_sum(ss) * (1.0f / 256.0f) + EPS);
            if (act) { const float* g = F.in[I_MLA_KVAG] + 8 * lane;
#pragma unroll
                for (int i = 0; i < 8; ++i) v[i] *= rstd * g[i];
                st8(ckvn + (size_t)R * 256 + 8 * lane, v); }
        }
        {
            const bool act = lane < 8; if (act) ld8(rowp + 640 + 8 * lane, v); else {
#pragma unroll
                for (int i = 0; i < 8; ++i) v[i] = 0.f; }
            seg_norm_rope<8>(v, lane & 7, F.in[I_MLA_KG] + 128, rope, WSP(float, WS_R64C) + (size_t)pos * 32, WSP(float, WS_R64S) + (size_t)pos * 32, 1.0f);
            if (act) {
#pragma unroll
                for (int h = 0; h < 8; ++h) st8(kbuf + (size_t)R * 1536 + h * 192 + 128 + 8 * lane, v); }
        }
    }
}
__device__ __forceinline__ void mla_pc(const Frame& F) {
    const int lane = F.lane;
    bf16_t* qraw = WSP(bf16_t, WS_QRAW); const bf16_t* kvraw = WSP(bf16_t, WS_KVRAW); bf16_t* kbuf = WSP(bf16_t, WS_KBUF);
    for (int R = F.gw; R < M; R += F.NGW) {
        const int j = R % RPB; const bool rope = (j >= CTXL) && (DBG_BREAK != 6); const int pos = rope ? j - CTXL : 0; float v[8];
#pragma unroll
        for (int p = 0; p < 2; ++p) { const int head = 4 * p + (lane >> 4), e0 = 8 * (lane & 15);
            bf16_t* q = qraw + (size_t)R * 1536 + head * 192 + e0; ld8(q, v);
            seg_norm_rope<16>(v, lane & 15, F.in[I_MLA_QG], false, nullptr, nullptr, SC_MLA); st8(q, v);
            ld8(kvraw + (size_t)R * 2048 + head * 256 + e0, v);
            seg_norm_rope<16>(v, lane & 15, F.in[I_MLA_KG], false, nullptr, nullptr, 1.0f); st8(kbuf + (size_t)R * 1536 + head * 192 + e0, v); }
        { const int head = lane >> 3, e0 = 8 * (lane & 7);
            bf16_t* q = qraw + (size_t)R * 1536 + head * 192 + 128 + e0; ld8(q, v);
            seg_norm_rope<8>(v, lane & 7, F.in[I_MLA_QG] + 128, rope, WSP(float, WS_R64C) + (size_t)pos * 32, WSP(float, WS_R64S) + (size_t)pos * 32, SC_MLA); st8(q, v); }
    }
}
__device__ __forceinline__ void diff_combine(const Frame& F) {
    const int lane = F.lane; const float* lp = F.in[I_DIFF_LAM];
    const float lam = (DBG_BREAK == 5) ? LAM_INIT : __expf(wave_sum(lp[lane] * lp[64 + lane])) - __expf(wave_sum(lp[128 + lane] * lp[192 + lane])) + LAM_INIT;
    const bf16_t* ob = WSP(bf16_t, WS_OBUF); bf16_t* o2 = WSP(bf16_t, WS_O2);
    for (int idx = F.gw; idx < MLAT; idx += F.NGW) {
        const int R = (idx >> 11) * RPB + CTXL + (idx & 2047);
#pragma unroll
        for (int p = 0; p < 2; ++p) { const int head = 4 * p + (lane >> 4), e0 = 8 * (lane & 15); float a[8], b[8];
            ld8(ob + (size_t)R * 2048 + (2 * head) * 128 + e0, a); ld8(ob + (size_t)R * 2048 + (2 * head + 1) * 128 + e0, b);
#pragma unroll
            for (int i = 0; i < 8; ++i) a[i] -= lam * b[i];
            seg_norm_rope<16>(a, lane & 15, F.in[I_DIFF_SUBLN], false, nullptr, nullptr, 1.0f - LAM_INIT);
            if (WO_FP8 & 8) { float c[8];
#pragma unroll
                for (int i = 0; i < 8; ++i) c[i] = fminf(fmaxf(F8_W_MUL * a[i], -448.f), 448.f);
                u32x2 w; w.x = pk4_fp8(c[0], c[1], c[2], c[3]); w.y = pk4_fp8(c[4], c[5], c[6], c[7]); *(u32x2*)((unsigned char*)o2 + (size_t)R * D + head * 128 + e0) = w; }
            else st8(o2 + (size_t)R * D + head * 128 + e0, a); }
    }
}

#ifndef MK_MULTI
#define MK_MULTI 0
#endif
constexpr int NPH = 37;
#ifndef DOWN_FP8
#define DOWN_FP8 1
#endif
#ifndef OVF_SPLIT
#define OVF_SPLIT 1
#endif
#ifndef FUSE_QKV
#define FUSE_QKV 7
#endif
#ifndef ATT0_SD
#define ATT0_SD 1
#endif
#ifndef ATT0_QSP
#define ATT0_QSP 0
#endif
#ifndef ATT2_SD
#define ATT2_SD 2
#endif
#ifndef ATT3_SD
#define ATT3_SD 3
#endif
#ifndef ATT1_SD
#define ATT1_SD 1
#endif
#ifndef ATT1_QSP
#define ATT1_QSP 4
#endif
__global__ void __launch_bounds__(NWAVES * 64, 2) mega_fwd(Params P) {
    extern __shared__ __attribute__((aligned(16))) unsigned char lds_raw[];
    Frame F;
    F.lds = (LAS unsigned char*)lds_raw; F.MISC = (volatile LAS unsigned*)(F.lds + LDSCTL_OFF);
    F.tid = threadIdx.x; F.lane = F.tid & 63; F.wave = __builtin_amdgcn_readfirstlane(F.tid >> 6);
    F.G = gridDim.x; { const int bx = blockIdx.x; F.vcu = (F.G % 8 == 0) ? (bx % 8) * (F.G / 8) + bx / 8 : bx; }
    F.gw = F.vcu * NWAVES + F.wave; F.NGW = F.G * NWAVES;
    F.in = P.in; F.out = P.out; F.ws = P.ws; F.ctl = (gu32*)(P.ws + WS_CTL);
    for (int u = F.tid; u < (LDS_BYTES - LDSCTL_OFF) / 4; u += NWAVES * 64) ((LAS unsigned*)(F.lds + LDSCTL_OFF))[u] = 0u;
    __syncthreads();
    const int lo = P.ph_lo, hi = P.ph_hi;
    XcdBarrier bar = xcd_barrier_post((unsigned*)(F.ctl + CW_BAR), F.MISC + MI_BAR);
    LAS unsigned char* const lds = F.lds;
    const int gemm_sa_ = F8_SCL_A;
    const int gemm_g_ = F.G;
    const LAS int* const tbp = (const LAS int*)(F.MISC + MI_TB);
#ifndef ONLY_PH
#define ONLY_PH -1
#endif
#ifndef EMU_MASK
#define EMU_MASK 0ull
#endif
#ifndef DBL_MASK
#define DBL_MASK 0ull
#endif
#define PH(k) F.tid = opaque_tid(); F.lane = F.tid & 63; if ((ONLY_PH < 0 || ONLY_PH == (k)) && lo <= (k) && (k) < hi) for (int rep_ = 0, emu_ = (int)(((unsigned long long)(EMU_MASK) >> (k)) & 1ull); rep_ < 1 + (int)(((unsigned long long)(DBL_MASK) >> (k)) & 1ull); ++rep_)
#ifndef SEAM_REP
#define SEAM_REP 1
#endif
#define SEAM(k) do { if ((k) + 1 < hi) for (int sr_ = 0; sr_ < SEAM_REP; ++sr_) xcd_barrier(bar); } while (0)
#define GEMM_CALL_KS(EPI, EINIT, APTR, BPTR, KK, KSPLIT, NN, NTILES, MODE, AMODE, CIDX) do { const pg8::Gemm g_{(const bf16_t*)(APTR), (const bf16_t*)(BPTR), (KK), (KK) / (KSPLIT), emu_}; \
        const pg8::Sched S_{(NN), (NTILES), gemm_g_, (CIDX), (MODE), (AMODE), (KSPLIT), 2 * (KK) / (KSPLIT), tbp, 0, (NTILES) * (NN) * (KSPLIT), 0}; const pg8::EPI E_ EINIT; pg8::gemm_phase<pg8::EPI, pg8::Sched, pg8::EPI::ALIGN, true>(lds, g_, S_, E_); } while (0)
#define GEMM_CALL(EPI, EINIT, APTR, BPTR, KK, NN, NTILES, MODE, AMODE, CIDX) do { const pg8::Gemm g_{(const bf16_t*)(APTR), (const bf16_t*)(BPTR), (KK), (KK), emu_}; \
        const pg8::Sched S_{(NN), (NTILES), gemm_g_, (CIDX), (MODE), (AMODE), 1, 2 * (KK), tbp, 0, (NTILES) * (NN), 0}; const pg8::EPI E_ EINIT; pg8::gemm_phase<pg8::EPI, pg8::Sched, pg8::EPI::ALIGN, true>(lds, g_, S_, E_); } while (0)
#define GEMM_CALL_R(EPI, EINIT, APTR, BPTR, KK, KLOOP, NN, NTILES, MODE, AMODE, CIDX, LBASE, LEND, OVS) do { const pg8::Gemm g_{(const bf16_t*)(APTR), (const bf16_t*)(BPTR), (KK), (KLOOP)}; \
        const pg8::Sched S_{(NN), (NTILES), gemm_g_, (CIDX), (MODE), (AMODE), 1, 2 * (KLOOP), tbp, (LBASE), (LEND), (OVS)}; const pg8::EPI E_ EINIT; pg8::gemm_phase<pg8::EPI, pg8::Sched, pg8::EPI::ALIGN, true>(lds, g_, S_, E_); } while (0)
#define GEMM_CALL_R8(EPI, EINIT, APTR, BPTR, KK, KLOOP, NN, NTILES, MODE, AMODE, CIDX, LBASE, LEND, OVS) do { const pg8::Gemm g_{(const bf16_t*)(APTR), (const bf16_t*)(BPTR), (KK), (KLOOP), 0, gemm_sa_}; \
        const pg8::Sched S_{(NN), (NTILES), gemm_g_, (CIDX), (MODE), (AMODE), 1, (KLOOP), tbp, (LBASE), (LEND), (OVS)}; const pg8::EPI E_ EINIT; pg8::gemm_phase<pg8::EPI, pg8::Sched, pg8::EPI::ALIGN, true, true>(lds, g_, S_, E_); } while (0)
#define GEMM_CALL8(EPI, EINIT, APTR, BPTR, KK, NN, NTILES, MODE, AMODE, CIDX) do { const pg8::Gemm g_{(const bf16_t*)(APTR), (const bf16_t*)(BPTR), (KK), (KK), 0, gemm_sa_}; \
        const pg8::Sched S_{(NN), (NTILES), gemm_g_, (CIDX), (MODE), (AMODE), 1, (KK), tbp, 0, (NTILES) * (NN), 0}; const pg8::EPI E_ EINIT; pg8::gemm_phase<pg8::EPI, pg8::Sched, pg8::EPI::ALIGN, true, true>(lds, g_, S_, E_); } while (0)
#define MODP(layer, chunk) (WSP(float, WS_MOD) + (size_t)(layer) * 9 * 6144 + (chunk) * 1024)
#define BR(...) {__VA_ARGS__}
#define XCH ((LAS float*)(lds + 131072))
#ifndef CONV_REP
#define CONV_REP 1
#endif
#define TAIL_MOD(nunits, tlo, thi, ilo, ihi) do { const int rem_ = (nunits) % F.G; if (rem_ != 0 && F.vcu >= rem_) { mod_tasks(F, (tlo), (thi), F.vcu - rem_, F.G - rem_); __syncthreads(); convert_items(F, (ilo), (ihi), F.vcu - rem_, F.G - rem_); } } while (0)
#define TAIL(nunits, ilo, ihi) for (int cr_ = 0; cr_ < CONV_REP; ++cr_) do { const int rem_ = (nunits) % F.G; if (rem_ == 0) convert_items(F, (ilo), (ihi), F.vcu, F.G); else if (F.vcu >= rem_) convert_items(F, (ilo), (ihi), F.vcu - rem_, F.G - rem_); } while (0)

#define DED_SPLIT(nunits) const int r_ = ((nunits) + F.G - 1) / F.G, gc_ = r_ > 0 ? ((nunits) + r_ - 1) / r_ : F.G
#define DED_CONV(ilo, ihi) convert_items(F, (ilo), (ihi), F.vcu - gc_, F.G - gc_)
    PH(0) { p0_prologue(F); SEAM(0); }
    PH(1) { norm_phase_dense(F, 0, 0, 0, false, (QKV_FP8 & 1) != 0); SEAM(1); }
    PH(2) { if constexpr (((FUSE_QKV >> 0) & 1) && (QKV_FP8 & 1)) { GEMM_CALL8(EpiQKV<128>, BR(WSP(bf16_t, WS_RAW), 1536, F.in[I_GQA_QG], F.in[I_GQA_KG], SC_GQA, WSP(float, WS_R128C), WSP(float, WS_R128S), 1024, 1280, XCH), WSP(unsigned char, WS_H), WSP(unsigned char, WS_WQKV0), 1024, 6, MT, 0, 0, F.vcu); }
            else if constexpr ((FUSE_QKV >> 0) & 1) { GEMM_CALL(EpiQKV<128>, BR(WSP(bf16_t, WS_RAW), 1536, F.in[I_GQA_QG], F.in[I_GQA_KG], SC_GQA, WSP(float, WS_R128C), WSP(float, WS_R128S), 1024, 1280, XCH), WSP(bf16_t, WS_H), WSP(bf16_t, WS_WQKV0), 1024, 6, MT, 0, 0, F.vcu); } else { GEMM_CALL(EpiStore, BR(WSP(bf16_t, WS_RAW), 1536, 0), WSP(bf16_t, WS_H), WSP(bf16_t, WS_WQKV0), 1024, 6, MT, 0, 0, F.vcu); } TAIL(MT * 6, TI_PRO, TWA); SEAM(2); }
    PH(3) { if constexpr (!((FUSE_QKV >> 0) & 1)) { qk_pass<16>(F, WSP(bf16_t, WS_RAW), 1536, 8, 2, F.in[I_GQA_QG], F.in[I_GQA_KG], SC_GQA, WSP(float, WS_R128C), WSP(float, WS_R128S)); SEAM(3); } }
    PH(4) { const att::AttnP A{WSP(bf16_t, WS_RAW), WSP(bf16_t, WS_RAW) + 1024, WSP(bf16_t, WS_RAW) + 1280, WSP(bf16_t, WS_OBUF), nullptr};
            att::attn_phase<128, 128, false, ATT0_SD, ATT0_QSP, 1536, 1536, 1536, 1024, 8, 4, 4, 128, 128, 1, (WO_FP8 & 1) != 0>((LAS char*)lds, A, F.G, F.vcu); SEAM(4); }
    PH(5) { if constexpr ((WO_FP8 & 1) != 0) { DED_SPLIT(MT * 4); if (F.vcu < gc_) { const int gemm_g_ = gc_; const int gemm_sa_ = F8_SCL_W; GEMM_CALL8(EpiResGate, BR(WSP(f16_t, WS_XS), MODP(0, 2)), WSP(unsigned char, WS_OBUF), WSP(unsigned char, WS_WO0), 1024, 4, MT, 0, 0, F.vcu); } else DED_CONV(TWA, TWB); }
            else { GEMM_CALL(EpiResGate, BR(WSP(f16_t, WS_XS), MODP(0, 2)), WSP(bf16_t, WS_OBUF), WSP(bf16_t, WS_WO0), 1024, 4, MT, 0, 0, F.vcu); TAIL(MT * 4, TWA, TWB); } SEAM(5); }
    PH(6) { norm_phase_dense(F, 0, 1, 1, false); SEAM(6); }
    PH(7) { GEMM_CALL(EpiSwiGLU8, BR(WSP(unsigned char, WS_ACT), FF), WSP(bf16_t, WS_H), WSP(bf16_t, WS_WF13), 1024, 28, MT, 0, 0, F.vcu); TAIL(MT * 28, TWB, TWC); SEAM(7); }
    PH(8) { DED_SPLIT(MT * 4); if (F.vcu < gc_) { const int gemm_g_ = gc_; GEMM_CALL8(EpiResGate, BR(WSP(f16_t, WS_XS), MODP(0, 5)), WSP(unsigned char, WS_ACT), WSP(unsigned char, WS_WF2), FF, 4, MT, 0, 0, F.vcu); } else DED_CONV(TWC, TWD); SEAM(8); }
    PH(9) { norm_phase_dense(F, 1, 0, 1, false, (QKV_FP8 & 2) != 0); SEAM(9); }
    PH(10) { if constexpr ((QKV_FP8 & 2) != 0) { GEMM_CALL8(EpiStore, BR(WSP(bf16_t, WS_DN), 768, 0), WSP(unsigned char, WS_H), WSP(unsigned char, WS_WDOWN1), 1024, 3, MT, 0, 0, F.vcu); }
             else { GEMM_CALL(EpiStore, BR(WSP(bf16_t, WS_DN), 768, 0), WSP(bf16_t, WS_H), WSP(bf16_t, WS_WDOWN1), 1024, 3, MT, 0, 0, F.vcu); } TAIL(MT * 3, TWD, TWE); SEAM(10); }
    PH(11) { mla_pb2(F); SEAM(11); }
    PH(12) { GEMM_CALL(EpiStore, BR(WSP(bf16_t, WS_QRAW), 1536, 0), WSP(bf16_t, WS_CQN), WSP(bf16_t, WS_WUQ1), 384, 6, MT, 0, 0, F.vcu);
             GEMM_CALL(EpiStore, BR(WSP(bf16_t, WS_KVRAW), 2048, 0), WSP(bf16_t, WS_CKVN), WSP(bf16_t, WS_WUKV1), 256, 8, MT, 0, 0, F.G - 1 - F.vcu); SEAM(12); }
    PH(13) { mla_pc(F); SEAM(13); }
    PH(14) { const att::AttnP A{WSP(bf16_t, WS_QRAW), WSP(bf16_t, WS_KBUF), WSP(bf16_t, WS_KVRAW) + 128, WSP(bf16_t, WS_OBUF), nullptr};
             att::attn_phase<192, 128, false, ATT1_SD, ATT1_QSP, 1536, 1536, 2048, 1024, 8, 1, 1, 192, 256, 1, (WO_FP8 & 2) != 0>((LAS char*)lds, A, F.G, F.vcu); SEAM(14); }
    PH(15) { DED_SPLIT(MT * 4); if (F.vcu < gc_) { const int gemm_g_ = gc_; if constexpr ((WO_FP8 & 2) != 0) { const int gemm_sa_ = F8_SCL_W; GEMM_CALL8(EpiResGate, BR(WSP(f16_t, WS_XS), MODP(1, 2)), WSP(unsigned char, WS_OBUF), WSP(unsigned char, WS_WO1), 1024, 4, MT, 0, 0, F.vcu); }
             else { GEMM_CALL(EpiResGate, BR(WSP(f16_t, WS_XS), MODP(1, 2)), WSP(bf16_t, WS_OBUF), WSP(bf16_t, WS_WO1), 1024, 4, MT, 0, 0, F.vcu); } } else DED_CONV(TWE, TWF); SEAM(15); }
    PH(16) { norm_phase_moe(F, 1, 0, false); SEAM(16); }
    PH(17) { moe_tile_base(F, 0); const int nt_ = __builtin_amdgcn_readfirstlane(tbp[8]);
             if constexpr (UPM_FP8) { GEMM_CALL8(EpiSwiGLU8, BR(WSP(unsigned char, WS_ACT), FF), WSP(unsigned char, WS_ASORT), WSP(unsigned char, WS_WM13), 1024, 28, nt_, 2, 0, F.vcu); }
             else { GEMM_CALL(EpiSwiGLU8, BR(WSP(unsigned char, WS_ACT), FF), WSP(bf16_t, WS_ASORT), WSP(bf16_t, WS_WM13), 1024, 28, nt_, 2, 0, F.vcu); } TAIL(nt_ * 28, TWF, TWG); SEAM(17); }
    PH(18) { moe_tile_base(F, 0); const int nt_ = __builtin_amdgcn_readfirstlane(tbp[8]);
             DED_SPLIT(nt_ * 4); if (F.vcu < gc_) { const int gemm_g_ = gc_; GEMM_CALL8(EpiStore, BR(WSP(bf16_t, WS_Y), 1024, 0), WSP(unsigned char, WS_ACT), WSP(unsigned char, WS_WM2), FF, 4, nt_, 2, 1, F.vcu); } else DED_CONV(TWG, TWH); SEAM(18); }
    PH(19) { moe_tile_base(F, 0); norm_phase_dense(F, 2, 0, 2, false, (QKV_FP8 & 4) != 0); SEAM(19); }
    PH(20) { if constexpr (((FUSE_QKV >> 1) & 1) && (QKV_FP8 & 4)) { GEMM_CALL8(EpiQKV<64>, BR(WSP(bf16_t, WS_RAW), 1280, F.in[I_WIN_QG], F.in[I_WIN_KG], SC_64, WSP(float, WS_R64C), WSP(float, WS_R64S), 1024, 1152, XCH), WSP(unsigned char, WS_H), WSP(unsigned char, WS_WQKV2), 1024, 5, MT, 0, 0, F.vcu); }
             else if constexpr ((FUSE_QKV >> 1) & 1) { GEMM_CALL(EpiQKV<64>, BR(WSP(bf16_t, WS_RAW), 1280, F.in[I_WIN_QG], F.in[I_WIN_KG], SC_64, WSP(float, WS_R64C), WSP(float, WS_R64S), 1024, 1152, XCH), WSP(bf16_t, WS_H), WSP(bf16_t, WS_WQKV2), 1024, 5, MT, 0, 0, F.vcu); } else { GEMM_CALL(EpiStore, BR(WSP(bf16_t, WS_RAW), 1280, 0), WSP(bf16_t, WS_H), WSP(bf16_t, WS_WQKV2), 1024, 5, MT, 0, 0, F.vcu); } TAIL(MT * 5, TWH, TWI); SEAM(20); }
    PH(21) { if constexpr (!((FUSE_QKV >> 1) & 1)) { qk_pass<8>(F, WSP(bf16_t, WS_RAW), 1280, 16, 2, F.in[I_WIN_QG], F.in[I_WIN_KG], SC_64, WSP(float, WS_R64C), WSP(float, WS_R64S)); SEAM(21); } }
    PH(22) { const att::AttnP A{WSP(bf16_t, WS_RAW), WSP(bf16_t, WS_RAW) + 1024, WSP(bf16_t, WS_RAW) + 1152, WSP(bf16_t, WS_OBUF), F.in[I_WIN_SINK]};
             att::attn_phase<64, 64, true, ATT2_SD, 0, 1280, 1280, 1280, 1024, 16, 8, 8, 64, 64, 1, (WO_FP8 & 4) != 0>((LAS char*)lds, A, F.G, F.vcu); SEAM(22); }
    PH(23) { if constexpr ((WO_FP8 & 4) != 0) { DED_SPLIT(MT * 4); if (F.vcu < gc_) { const int gemm_g_ = gc_; const int gemm_sa_ = F8_SCL_W; GEMM_CALL8(EpiResGate, BR(WSP(f16_t, WS_XS), MODP(2, 2)), WSP(unsigned char, WS_OBUF), WSP(unsigned char, WS_WO2), 1024, 4, MT, 0, 0, F.vcu); } else DED_CONV(TWI, TWJ); }
             else { GEMM_CALL(EpiResGate, BR(WSP(f16_t, WS_XS), MODP(2, 2)), WSP(bf16_t, WS_OBUF), WSP(bf16_t, WS_WO2), 1024, 4, MT, 0, 0, F.vcu); TAIL(MT * 4, TWI, TWJ); } SEAM(23); }
    PH(24) { norm_phase_dense(F, 2, 1, 1, false); SEAM(24); }
    PH(25) { GEMM_CALL(EpiSwiGLU8, BR(WSP(unsigned char, WS_ACT), FF), WSP(bf16_t, WS_H), WSP(bf16_t, WS_WF13) + (size_t)7168 * 1024, 1024, 28, MT, 0, 0, F.vcu); TAIL(MT * 28, TWJ, TWK); SEAM(25); }
    PH(26) { DED_SPLIT(MT * 4); if (F.vcu < gc_) { const int gemm_g_ = gc_; GEMM_CALL8(EpiResGate, BR(WSP(f16_t, WS_XS), MODP(2, 5)), WSP(unsigned char, WS_ACT), WSP(unsigned char, WS_WF2) + (size_t)1024 * FF, FF, 4, MT, 0, 0, F.vcu); } else DED_CONV(TWK, TI_END); SEAM(26); }
    PH(27) { norm_phase_dense(F, 3, 0, 1, false, (QKV_FP8 & 8) != 0); SEAM(27); }
    PH(28) { if constexpr (((FUSE_QKV >> 2) & 1) && (QKV_FP8 & 8)) { GEMM_CALL8(EpiQKV<64>, BR(WSP(bf16_t, WS_RAW), 3072, F.in[I_DIFF_QG], F.in[I_DIFF_KG], SC_64, WSP(float, WS_R64C), WSP(float, WS_R64S), 1024, 2048, XCH), WSP(unsigned char, WS_H), WSP(unsigned char, WS_WQKV3), 1024, 12, MT, 0, 0, F.vcu); }
             else if constexpr ((FUSE_QKV >> 2) & 1) { GEMM_CALL(EpiQKV<64>, BR(WSP(bf16_t, WS_RAW), 3072, F.in[I_DIFF_QG], F.in[I_DIFF_KG], SC_64, WSP(float, WS_R64C), WSP(float, WS_R64S), 1024, 2048, XCH), WSP(bf16_t, WS_H), WSP(bf16_t, WS_WQKV3), 1024, 12, MT, 0, 0, F.vcu); } else { GEMM_CALL(EpiStore, BR(WSP(bf16_t, WS_RAW), 3072, 0), WSP(bf16_t, WS_H), WSP(bf16_t, WS_WQKV3), 1024, 12, MT, 0, 0, F.vcu); } SEAM(28); }
    PH(29) { if constexpr (!((FUSE_QKV >> 2) & 1)) { qk_pass<8>(F, WSP(bf16_t, WS_RAW), 3072, 16, 16, F.in[I_DIFF_QG], F.in[I_DIFF_KG], SC_64, WSP(float, WS_R64C), WSP(float, WS_R64S)); SEAM(29); } }
    PH(30) { const att::AttnP A{WSP(bf16_t, WS_RAW), WSP(bf16_t, WS_RAW) + 1024, WSP(bf16_t, WS_RAW) + 2048, WSP(bf16_t, WS_OBUF), nullptr};
             att::attn_phase<64, 128, false, ATT3_SD, 0, 3072, 3072, 3072, 2048, 16, 1, 2, 64, 128, 0>((LAS char*)lds, A, F.G, F.vcu); SEAM(30); }
    PH(31) { diff_combine(F); SEAM(31); }
    PH(32) { if constexpr ((WO_FP8 >> 3) & 1) { const int gemm_sa_ = F8_SCL_W; GEMM_CALL8(EpiResGate, BR(WSP(f16_t, WS_XS), MODP(3, 2)), WSP(unsigned char, WS_O2), WSP(unsigned char, WS_WO3), 1024, 4, 64, 1, 0, F.vcu); }
             else { GEMM_CALL(EpiResGate, BR(WSP(f16_t, WS_XS), MODP(3, 2)), WSP(bf16_t, WS_O2), WSP(bf16_t, WS_WO3), 1024, 4, 64, 1, 0, F.vcu); } SEAM(32); }
    PH(33) { norm_phase_moe(F, 3, 1, true); SEAM(33); }
    PH(34) { moe_tile_base(F, 1); const int nt_ = __builtin_amdgcn_readfirstlane(tbp[8]);
             if constexpr (UPM_FP8) { GEMM_CALL8(EpiSwiGLU8, BR(WSP(unsigned char, WS_ACT), FF), WSP(unsigned char, WS_ASORT), WSP(unsigned char, WS_WM13) + (size_t)NEXP * 7168 * 1024, 1024, 28, nt_, 2, 0, F.vcu); }
             else { GEMM_CALL(EpiSwiGLU8, BR(WSP(unsigned char, WS_ACT), FF), WSP(bf16_t, WS_ASORT), WSP(bf16_t, WS_WM13) + (size_t)NEXP * 7168 * 1024, 1024, 28, nt_, 2, 0, F.vcu); } SEAM(34); }
    PH(35) { moe_tile_base(F, 1); const int nt_ = __builtin_amdgcn_readfirstlane(tbp[8]);
             const int nun_ = nt_ * 4, lmain_ = (nun_ / F.G) * F.G, rem_ = nun_ - lmain_;
             if (OVF_SPLIT && rem_ > 0 && rem_ <= 128) {
                 GEMM_CALL_R8(EpiStore, BR(WSP(bf16_t, WS_Y), 1024, 0), WSP(unsigned char, WS_ACT), WSP(unsigned char, WS_WM2) + (size_t)NEXP * 1024 * FF, FF, FF, 4, nt_, 2, 1, F.vcu, 0, lmain_, 0);
                 GEMM_CALL_R8(EpiSlab, BR(WSP(float, WS_ASORT)), WSP(unsigned char, WS_ACT), WSP(unsigned char, WS_WM2) + (size_t)NEXP * 1024 * FF, FF, 512, 4, nt_, 2, 1, F.vcu, lmain_, nun_, 7);
             } else {
                 GEMM_CALL8(EpiStore, BR(WSP(bf16_t, WS_Y), 1024, 0), WSP(unsigned char, WS_ACT), WSP(unsigned char, WS_WM2) + (size_t)NEXP * 1024 * FF, FF, 4, nt_, 2, 1, F.vcu);
             }
             SEAM(35); }
    PH(36) { moe_tile_base(F, 1); final_phase(F, 3); }
#undef PH
#undef SEAM
}

extern "C" void kernel_launch(void* const* d_in, const int* in_sizes, int n_in, void* d_out, int out_size, void* d_ws, size_t ws_size, hipStream_t stream) {
    static int grid = 0;
    if (grid == 0) {
        if (n_in != N_IN || in_sizes[0] != NB * SEQ * D || out_size != NB * SEQ * D || ws_size < WS_END) {
            fprintf(stderr, "kernel_launch: shape mismatch: n_in %d in0 %d out %d ws %zu (need %zu); nothing launched\n", n_in, n_in > 0 ? in_sizes[0] : -1, out_size, ws_size, (size_t)WS_END); grid = -1; return; }
        int dev = 0, cus = 0;
        if (hipGetDevice(&dev) != hipSuccess || hipDeviceGetAttribute(&cus, hipDeviceAttributeMultiprocessorCount, dev) != hipSuccess) { fprintf(stderr, "kernel_launch: device query failed\n"); grid = -1; return; }
        if (hipFuncSetAttribute((const void*)mega_fwd, hipFuncAttributeMaxDynamicSharedMemorySize, LDS_BYTES) != hipSuccess) { fprintf(stderr, "kernel_launch: hipFuncSetAttribute failed\n"); grid = -1; return; }
        int per_cu = 0;
        if (hipOccupancyMaxActiveBlocksPerMultiprocessor(&per_cu, (const void*)mega_fwd, NWAVES * 64, LDS_BYTES) != hipSuccess || per_cu < 1) fprintf(stderr, "kernel_launch: note: occupancy query reports %d\n", per_cu);
        (void)hipGetLastError();
        grid = cus < 256 ? cus : 256;
        if (grid != 256) fprintf(stderr, "kernel_launch: warning: %d CUs; the phase programme assumes 256 workgroups\n", grid);
    }
    if (grid < 0) return;
    if (hipMemsetAsync((char*)d_ws + WS_CTL, 0, CTL_ZERO_BYTES, stream) != hipSuccess) { fprintf(stderr, "kernel_launch: memset failed\n"); return; }
    Params p{};
    for (int i = 0; i < N_IN; ++i) p.in[i] = (const float*)d_in[i];
    p.out = (float*)d_out; p.ws = (unsigned char*)d_ws;
#if MK_MULTI
    for (int ph = 0; ph < NPH; ++ph) { p.ph_lo = ph; p.ph_hi = ph + 1; hipLaunchKernelGGL(mega_fwd, dim3(grid), dim3(NWAVES * 64), LDS_BYTES, stream, p); }
#else
    p.ph_lo = 0; p.ph_hi = NPH;
    hipLaunchKernelGGL(mega_fwd, dim3(grid), dim3(NWAVES * 64), LDS_BYTES, stream, p);
#endif
    const hipError_t le = hipPeekAtLastError();
    if (le != hipSuccess) fprintf(stderr, "kernel_launch: launch failed: %s\n", hipGetErrorName(le));
}
```
